# Optimizing an MI355X kernel written in HIP

```python
import math
import functools
import jax
import jax.numpy as jnp
from jax import lax
import numpy as np

D_MODEL = 1024
BATCH = 8
SEQ = 4096
DEPTH = 2

GRID_W = 64
CTX_LEN = 256
NORM_EPS = 1e-6

S5_WIDTH = D_MODEL // 4
S5_GROUP = 16
S5_GROUPS = S5_WIDTH // S5_GROUP
S5_STATE = 64
S5_MIN_STEP = 1e-3
S5_MAX_STEP = 1e-1
RW_WIDTH = D_MODEL // 2
RW_HEAD = 64
RW_HEADS = RW_WIDTH // RW_HEAD
RW_DECAY_LORA = 64
RW_ICLR_LORA = 64
RW_GATE_LORA = 128
RW_GN_EPS = 64e-5
HY_WIDTH = D_MODEL // 4
HY_ORDER = 2
HY_POS_DIM = 33
HY_FILTER_HIDDEN = 64
HY_DECAY_TARGET = 1e-2
HY_DECAY_PCT_SHORT = 0.3
HY_DECAY_PCT_LONG = 1.5
SHORT_CONV = 3
N_BRANCH = 3
FFN_HIDDEN = 2816
N_EXPERTS = 8
TOP_K = 2
EXPERT_HIDDEN = 3584
MOE_BLOCK = 256
IN_S5 = S5_WIDTH
IN_RW = 3 * RW_WIDTH
IN_LORA = 2 * RW_DECAY_LORA + 2 * RW_ICLR_LORA + RW_GATE_LORA
IN_HY = (HY_ORDER + 1) * HY_WIDTH
IN_GATE = N_BRANCH * D_MODEL
IN_COLS = IN_S5 + IN_RW + IN_LORA + IN_HY + IN_GATE
N_DENSE = (DEPTH + 1) // 2
N_MOE = DEPTH // 2

kernel_name = 'hybrid_s5_rwkv7_hyena_moe_flow_block'


def rms_norm(x, gain):
    xf = x.astype(jnp.float32)
    y = xf * lax.rsqrt(jnp.mean(xf * xf, axis=-1, keepdims=True) + NORM_EPS)
    return (y * gain.astype(jnp.float32)).astype(x.dtype)


def short_conv(x, w, b=None):
    half = SHORT_CONV // 2
    n = x.shape[1]
    xp = jnp.pad(x, ((0, 0), (half, half), (0, 0)))
    y = sum(xp[:, j:j + n] * w[j] for j in range(SHORT_CONV))
    return y if b is None else y + b


def latent_short_conv(x, w, b=None):
    bsz, n_tok, ch = x.shape
    rows = n_tok // GRID_W
    y = short_conv(x.reshape(bsz * rows, GRID_W, ch), w, b)
    return y.reshape(bsz, n_tok, ch)


def s5_discretise(lam_re, lam_im, log_step, b_re, b_im):
    lr = lam_re.astype(jnp.float32)
    li = lam_im.astype(jnp.float32)
    step = jnp.exp(log_step.astype(jnp.float32))[:, None]
    mag = jnp.exp(lr * step)
    ang = li * step
    ab_re, ab_im = mag * jnp.cos(ang), mag * jnp.sin(ang)
    den = lr * lr + li * li
    nr, ni = ab_re - 1.0, ab_im
    q_re = (nr * lr + ni * li) / den
    q_im = (ni * lr - nr * li) / den
    br, bi = b_re.astype(jnp.float32), b_im.astype(jnp.float32)
    bb_re = q_re[..., None] * br - q_im[..., None] * bi
    bb_im = q_re[..., None] * bi + q_im[..., None] * br
    return ab_re, ab_im, bb_re, bb_im


def _complex_affine_combine(e1, e2):
    a1r, a1i, b1r, b1i = e1
    a2r, a2i, b2r, b2i = e2
    return (a2r * a1r - a2i * a1i,
            a2r * a1i + a2i * a1r,
            a2r * b1r - a2i * b1i + b2r,
            a2r * b1i + a2i * b1r + b2i)


def s5_scan(u, ab_re, ab_im, bb_re, bb_im, h0_re, h0_im):
    n = u.shape[1]
    bu_re = jnp.einsum('blgi,gpi->blgp', u, bb_re)
    bu_im = jnp.einsum('blgi,gpi->blgp', u, bb_im)
    bu_re = bu_re.at[:, 0].add(ab_re * h0_re - ab_im * h0_im)
    bu_im = bu_im.at[:, 0].add(ab_re * h0_im + ab_im * h0_re)
    a_re = jnp.broadcast_to(ab_re, (1, n) + ab_re.shape)
    a_im = jnp.broadcast_to(ab_im, (1, n) + ab_im.shape)
    _, _, h_re, h_im = lax.associative_scan(_complex_affine_combine, (a_re, a_im, bu_re, bu_im), axis=1)
    return h_re, h_im


def s5_branch(u, p, init, with_output):
    bsz, n, _ = u.shape
    ug = u.astype(jnp.float32).reshape(bsz, n, S5_GROUPS, S5_GROUP)
    finals, outs = [], []
    for d in range(2):
        ab_re, ab_im, bb_re, bb_im = s5_discretise(p['s5_lam_re'][d], p['s5_lam_im'][d], p['s5_log_step'][d],
                                                   p['s5_b_re'][d], p['s5_b_im'][d])
        u_d = ug if d == 0 else ug[:, ::-1]
        h_re, h_im = s5_scan(u_d, ab_re, ab_im, bb_re, bb_im, init[d][0], init[d][1])
        finals.append((h_re[:, -1], h_im[:, -1]))
        if with_output:
            y_d = (jnp.einsum('blgp,gip->blgi', h_re, p['s5_c_re'][d].astype(jnp.float32))
                   - jnp.einsum('blgp,gip->blgi', h_im, p['s5_c_im'][d].astype(jnp.float32)))
            outs.append(y_d if d == 0 else y_d[:, ::-1])
    if not with_output:
        return None, finals
    y = (outs[0] + outs[1]).reshape(bsz, n, S5_WIDTH) + p['s5_d'] * ug.reshape(bsz, n, S5_WIDTH)
    y = jax.nn.gelu(y, approximate=False)
    return y * jax.nn.sigmoid(y @ p['s5_glu_w']), finals


def rwkv_scan(r, w, k, v, a, b, s0, with_output):
    def step(s, inp):
        r_t, w_t, k_t, v_t, a_t, b_t = inp
        sa = jnp.einsum('bhvk,bhk->bhv', s, a_t)
        s = s * w_t[:, :, None, :] + sa[..., None] * b_t[:, :, None, :] + v_t[..., None] * k_t[:, :, None, :]
        y_t = jnp.einsum('bhvk,bhk->bhv', s, r_t) if with_output else None
        return s, y_t
    xs = tuple(jnp.swapaxes(t, 0, 1) for t in (r, w, k, v, a, b))
    s_fin, ys = lax.scan(step, s0, xs)
    return (jnp.swapaxes(ys, 0, 1) if with_output else None), s_fin


def rwkv_branch(rkv, lora, p, init, with_output):
    bsz, n, _ = rkv.shape

    def heads(t):
        return t.reshape(bsz, n, RW_HEADS, RW_HEAD)

    r, k, v = jnp.split(rkv.astype(jnp.float32), 3, axis=-1)
    lora = lora.astype(jnp.float32)
    c1 = RW_DECAY_LORA
    c2 = 2 * RW_DECAY_LORA
    c3 = c2 + RW_ICLR_LORA
    c4 = c3 + RW_ICLR_LORA
    w_lo = (lora[..., :c1], lora[..., c1:c2])
    a_lo = (lora[..., c2:c3], lora[..., c3:c4])
    kk = heads(k * p['rw_kk'])
    kk = kk * lax.rsqrt(jnp.maximum(jnp.sum(kk * kk, axis=-1, keepdims=True), 1e-24))
    rh, vh = heads(r), heads(v)
    finals, wkv, bonus = [], 0.0, 0.0
    for d in range(2):
        w_log = -jax.nn.softplus(-(p['rw_w0'][d] + jnp.tanh(w_lo[d]) @ p['rw_w2'][d])) - 0.5
        decay = jnp.exp(-jnp.exp(w_log))
        a = jax.nn.sigmoid(p['rw_a0'][d] + a_lo[d] @ p['rw_a2'][d])
        kd = heads(k * (1.0 + (a - 1.0) * p['rw_ka']))
        seq = (rh, heads(decay), kd, vh, -kk, kk * heads(a))
        if d == 1:
            seq = tuple(t[:, ::-1] for t in seq)
        ys, s_fin = rwkv_scan(*seq, init[d], with_output)
        finals.append(s_fin)
        if with_output:
            wkv = wkv + (ys if d == 0 else ys[:, ::-1])
            bonus = bonus + jnp.sum(heads(r * p['rw_rk']) * kd, axis=-1, keepdims=True) * vh
    if not with_output:
        return None, finals
    mu = jnp.mean(wkv, axis=-1, keepdims=True)
    var = jnp.mean(jnp.square(wkv - mu), axis=-1, keepdims=True)
    o = ((wkv - mu) * lax.rsqrt(var + RW_GN_EPS)).reshape(bsz, n, RW_WIDTH) * p['rw_ln_w'] + p['rw_ln_b']
    o = o + bonus.reshape(bsz, n, RW_WIDTH)
    g = jax.nn.sigmoid(lora[..., c4:]) @ p['rw_g2']
    return o * g, finals


def hyena_filter_spectra(n_tok, p):
    bands = (HY_POS_DIM - 1) // 2
    t = jnp.linspace(0.0, 1.0, n_tok, dtype=jnp.float32)[:, None]
    w = (2.0 * math.pi / n_tok) * jnp.arange(n_tok, dtype=jnp.float32)[:, None]
    f = jnp.linspace(1e-4, bands - 1, bands, dtype=jnp.float32)[None, :]
    feats = jnp.concatenate([t, jnp.cos(f * w), -jnp.sin(f * w)], axis=-1)
    h = jnp.sin(p['hy_f_freq1'] * (feats @ p['hy_f_w1'] + p['hy_f_b1']))
    h = jnp.sin(p['hy_f_freq2'] * (h @ p['hy_f_w2'] + p['hy_f_b2']))
    h = (h @ p['hy_f_w3']).astype(jnp.float32).reshape(n_tok, HY_ORDER, 2, HY_WIDTH)
    rates = jnp.abs(jnp.linspace(math.log(HY_DECAY_TARGET) / HY_DECAY_PCT_SHORT,
                                 math.log(HY_DECAY_TARGET) / HY_DECAY_PCT_LONG, HY_WIDTH, dtype=jnp.float32))
    h = h * jnp.exp(-t * rates)[:, None, None, :]
    h_fwd, h_bwd = h[:, :, 0], h[:, :, 1]
    filt = jnp.concatenate([h_fwd, jnp.zeros_like(h_fwd[:1]), h_bwd[:0:-1]], axis=0)
    return jnp.fft.rfft(filt, axis=0)


def long_conv(z, k_spec, bias):
    n = z.shape[1]
    z_spec = jnp.fft.rfft(z, n=2 * n, axis=1)
    y = jnp.fft.irfft(z_spec * k_spec[None], n=2 * n, axis=1)[:, :n]
    return y + z * bias


def hyena_branch(streams, p):
    n = streams.shape[1]
    v, x1, x2 = jnp.split(streams.astype(jnp.float32), 3, axis=-1)
    k_spec = hyena_filter_spectra(n, p)
    z = v
    for o, gate in enumerate((x1, x2)):
        z = gate * long_conv(z, k_spec[:, o], p['hy_bias'][o])
    return z


def merge_branches(y_s5, y_rw, y_hy, gates, p):
    g_s5, g_rw, g_hy = jnp.split(jax.nn.sigmoid(gates.astype(jnp.float32)), N_BRANCH, axis=-1)
    m = g_s5 * (y_s5 @ p['br_s5']) + g_rw * (y_rw @ p['br_rw']) + g_hy * (y_hy @ p['br_hy'])
    return m @ p['out_w']


def token_mixer(h_lat, h_ctx, p, with_ctx_out):
    bsz = h_lat.shape[0]
    cuts = [IN_S5, IN_S5 + IN_RW, IN_S5 + IN_RW + IN_LORA, IN_S5 + IN_RW + IN_LORA + IN_HY]
    ctx_cols = IN_COLS if with_ctx_out else cuts[2]
    u_l, rkv_l, lora_l, hy_l, gate_l = jnp.split(h_lat @ p['in_w'], cuts, axis=-1)
    ctx_parts = jnp.split(h_ctx @ p['in_w'][:, :ctx_cols], cuts if with_ctx_out else cuts[:2], axis=-1)
    zs = jnp.zeros((bsz, S5_GROUPS, S5_STATE), jnp.float32)
    zr = jnp.zeros((bsz, RW_HEADS, RW_HEAD, RW_HEAD), jnp.float32)
    s5_c, s5_state = s5_branch(ctx_parts[0], p, ((zs, zs), (zs, zs)), with_ctx_out)
    rw_c, rw_state = rwkv_branch(short_conv(ctx_parts[1], p['rw_conv_w']), ctx_parts[2], p, (zr, zr), with_ctx_out)
    s5_l, _ = s5_branch(u_l, p, s5_state, True)
    rw_l, _ = rwkv_branch(latent_short_conv(rkv_l, p['rw_conv_w']), lora_l, p, rw_state, True)
    hy_lat = hyena_branch(latent_short_conv(hy_l, p['hy_conv_w'], p['hy_conv_b']), p)
    y_lat = merge_branches(s5_l, rw_l, hy_lat, gate_l, p).astype(h_lat.dtype)
    if not with_ctx_out:
        return y_lat, None
    hy_ctx = hyena_branch(short_conv(ctx_parts[3], p['hy_conv_w'], p['hy_conv_b']), p)
    y_ctx = merge_branches(s5_c, rw_c, hy_ctx, ctx_parts[4], p).astype(h_ctx.dtype)
    return y_lat, y_ctx


def swiglu(h, wg, wu, wd):
    return (jax.nn.silu(h @ wg) * (h @ wu)) @ wd


def moe_swiglu(h, router_w, wg, wu, wd):
    d_model = h.shape[-1]
    tok = h.reshape(-1, d_model)
    n = tok.shape[0]
    n_assign = n * TOP_K
    logits = (tok @ router_w).astype(jnp.float32)
    top_logit, top_e = lax.top_k(logits, TOP_K)
    gate = jax.nn.softmax(top_logit, axis=-1).reshape(-1)
    flat_e = top_e.reshape(-1)
    order = jnp.argsort(flat_e)
    sorted_e = flat_e[order]
    sizes = jnp.zeros((N_EXPERTS,), jnp.int32).at[flat_e].add(1)
    padded = (sizes + MOE_BLOCK - 1) // MOE_BLOCK * MOE_BLOCK
    pad_end = jnp.cumsum(padded)
    pad_start = pad_end - padded
    grp_start = jnp.cumsum(sizes) - sizes
    slot = pad_start[sorted_e] + jnp.arange(n_assign, dtype=jnp.int32) - grp_start[sorted_e]
    n_blocks = -(-n_assign // MOE_BLOCK) + N_EXPERTS
    cap = n_blocks * MOE_BLOCK
    slot_tok = jnp.full((cap,), n, jnp.int32).at[slot].set((order // TOP_K).astype(jnp.int32))
    slot_gate = jnp.zeros((cap,), jnp.float32).at[slot].set(gate[order])
    block_start = jnp.arange(n_blocks, dtype=jnp.int32) * MOE_BLOCK
    block_e = jnp.minimum(jnp.sum(block_start[:, None] >= pad_end[None, :], axis=1), N_EXPERTS - 1)
    tok_pad = jnp.concatenate([tok, jnp.zeros((1, d_model), tok.dtype)], axis=0)
    xb = tok_pad[slot_tok].reshape(n_blocks, MOE_BLOCK, d_model)

    def expert_block(args):
        x_blk, e = args
        return (jax.nn.silu(x_blk @ wg[e]) * (x_blk @ wu[e])) @ wd[e]

    yb = lax.map(expert_block, (xb, block_e)).reshape(cap, d_model)
    yb = yb * slot_gate[:, None].astype(yb.dtype)
    out = jax.ops.segment_sum(yb, slot_tok, num_segments=n + 1)[:n]
    return out.reshape(h.shape)


def setup_inputs(seed: int = 0) -> dict:
    key = jax.random.key(seed)
    counter = [0]

    def nk():
        counter[0] += 1
        return jax.random.fold_in(key, counter[0])

    def nrm(shape, scale=1.0):
        return scale * jax.random.normal(nk(), shape, jnp.float32)

    L, D = DEPTH, D_MODEL
    G, P, GC = S5_GROUPS, S5_STATE, S5_GROUP
    W, R, RG = RW_WIDTH, RW_DECAY_LORA, RW_GATE_LORA
    HW, HH = HY_WIDTH, HY_FILTER_HIDDEN
    inp = {}
    inp['x'] = nrm((BATCH, SEQ, D))
    inp['c'] = nrm((BATCH, D))
    inp['ctx'] = nrm((BATCH, CTX_LEN, D))
    inp['c_ctx'] = nrm((D,))
    inp['mod_w'] = nrm((L, D, 6 * D), 0.5 * D ** -0.5)
    inp['mod_b'] = nrm((L, 6 * D), 0.02)
    inp['norm_g'] = 1.0 + nrm((L, 4, D), 0.02)
    inp['in_w'] = nrm((L, D, IN_COLS), D ** -0.5)
    inp['s5_lam_re'] = -0.5 + nrm((L, 2, G, P), 0.01)
    inp['s5_lam_im'] = math.pi * jnp.arange(P, dtype=jnp.float32) + nrm((L, 2, G, P), 0.01)
    inp['s5_log_step'] = jax.random.uniform(nk(), (L, 2, G), jnp.float32, math.log(S5_MIN_STEP), math.log(S5_MAX_STEP))
    inp['s5_b_re'] = nrm((L, 2, G, P, GC), (2 * GC) ** -0.5)
    inp['s5_b_im'] = nrm((L, 2, G, P, GC), (2 * GC) ** -0.5)
    inp['s5_c_re'] = nrm((L, 2, G, GC, P), (2 * P) ** -0.5)
    inp['s5_c_im'] = nrm((L, 2, G, GC, P), (2 * P) ** -0.5)
    inp['s5_d'] = nrm((L, S5_WIDTH), 0.5)
    inp['s5_glu_w'] = nrm((L, S5_WIDTH, S5_WIDTH), S5_WIDTH ** -0.5)
    inp['rw_conv_w'] = nrm((L, SHORT_CONV, IN_RW), 0.3).at[:, SHORT_CONV // 2].add(1.0)
    inp['rw_w0'] = -6.5 + 5.0 * jnp.linspace(0.0, 1.0, W, dtype=jnp.float32) ** 1.5 + nrm((L, 2, W), 0.1)
    inp['rw_w2'] = nrm((L, 2, R, W), 0.5 * R ** -0.5)
    inp['rw_a0'] = nrm((L, 2, W), 0.1)
    inp['rw_a2'] = nrm((L, 2, RW_ICLR_LORA, W), 0.5 * RW_ICLR_LORA ** -0.5)
    inp['rw_g2'] = nrm((L, RG, W), RG ** -0.5)
    inp['rw_kk'] = 0.85 + nrm((L, W), 0.02)
    inp['rw_ka'] = 1.0 + nrm((L, W), 0.02)
    inp['rw_rk'] = nrm((L, W), 0.1)
    inp['rw_ln_w'] = 1.0 + nrm((L, W), 0.02)
    inp['rw_ln_b'] = nrm((L, W), 0.02)
    inp['hy_conv_w'] = nrm((L, SHORT_CONV, IN_HY), 0.3).at[:, SHORT_CONV // 2].add(1.0)
    inp['hy_conv_b'] = nrm((L, IN_HY), 0.02)
    inp['hy_f_w1'] = nrm((L, HY_POS_DIM, HH), HY_POS_DIM ** -0.5)
    inp['hy_f_b1'] = nrm((L, HH), 0.1)
    inp['hy_f_freq1'] = 1.0 + nrm((L, HH), 0.02)
    inp['hy_f_w2'] = nrm((L, HH, HH), HH ** -0.5)
    inp['hy_f_b2'] = nrm((L, HH), 0.1)
    inp['hy_f_freq2'] = 1.0 + nrm((L, HH), 0.02)
    inp['hy_f_w3'] = nrm((L, HH, HY_ORDER * 2 * HW), 0.1 * HH ** -0.5)
    inp['hy_bias'] = nrm((L, HY_ORDER, HW), 0.5)
    inp['br_s5'] = nrm((L, S5_WIDTH, D), S5_WIDTH ** -0.5)
    inp['br_rw'] = nrm((L, RW_WIDTH, D), RW_WIDTH ** -0.5)
    inp['br_hy'] = nrm((L, HY_WIDTH, D), HY_WIDTH ** -0.5)
    inp['out_w'] = nrm((L, D, D), D ** -0.5)
    inp['ffn_wg'] = nrm((N_DENSE, D, FFN_HIDDEN), D ** -0.5)
    inp['ffn_wu'] = nrm((N_DENSE, D, FFN_HIDDEN), D ** -0.5)
    inp['ffn_wd'] = nrm((N_DENSE, FFN_HIDDEN, D), FFN_HIDDEN ** -0.5)
    inp['moe_router'] = nrm((N_MOE, D, N_EXPERTS), D ** -0.5)
    inp['moe_wg'] = nrm((N_MOE, N_EXPERTS, D, EXPERT_HIDDEN), D ** -0.5)
    inp['moe_wu'] = nrm((N_MOE, N_EXPERTS, D, EXPERT_HIDDEN), D ** -0.5)
    inp['moe_wd'] = nrm((N_MOE, N_EXPERTS, EXPERT_HIDDEN, D), EXPERT_HIDDEN ** -0.5)
    return inp


def reference(x, c, ctx, c_ctx, mod_w, mod_b, norm_g, in_w,
              s5_lam_re, s5_lam_im, s5_log_step, s5_b_re, s5_b_im, s5_c_re, s5_c_im, s5_d, s5_glu_w,
              rw_conv_w, rw_w0, rw_w2, rw_a0, rw_a2, rw_g2, rw_kk, rw_ka, rw_rk, rw_ln_w, rw_ln_b,
              hy_conv_w, hy_conv_b, hy_f_w1, hy_f_b1, hy_f_freq1, hy_f_w2, hy_f_b2, hy_f_freq2, hy_f_w3, hy_bias,
              br_s5, br_rw, br_hy, out_w, ffn_wg, ffn_wu, ffn_wd, moe_router, moe_wg, moe_wu, moe_wd):
    silu_c = jax.nn.silu(c)
    silu_cc = jax.nn.silu(c_ctx)
    for i in range(DEPTH):
        last = i == DEPTH - 1
        p = {
            'in_w': in_w[i],
            's5_lam_re': s5_lam_re[i], 's5_lam_im': s5_lam_im[i], 's5_log_step': s5_log_step[i],
            's5_b_re': s5_b_re[i], 's5_b_im': s5_b_im[i], 's5_c_re': s5_c_re[i], 's5_c_im': s5_c_im[i],
            's5_d': s5_d[i], 's5_glu_w': s5_glu_w[i],
            'rw_conv_w': rw_conv_w[i], 'rw_w0': rw_w0[i], 'rw_w2': rw_w2[i], 'rw_a0': rw_a0[i], 'rw_a2': rw_a2[i],
            'rw_g2': rw_g2[i], 'rw_kk': rw_kk[i], 'rw_ka': rw_ka[i], 'rw_rk': rw_rk[i],
            'rw_ln_w': rw_ln_w[i], 'rw_ln_b': rw_ln_b[i],
            'hy_conv_w': hy_conv_w[i], 'hy_conv_b': hy_conv_b[i], 'hy_f_w1': hy_f_w1[i], 'hy_f_b1': hy_f_b1[i],
            'hy_f_freq1': hy_f_freq1[i], 'hy_f_w2': hy_f_w2[i], 'hy_f_b2': hy_f_b2[i], 'hy_f_freq2': hy_f_freq2[i],
            'hy_f_w3': hy_f_w3[i], 'hy_bias': hy_bias[i],
            'br_s5': br_s5[i], 'br_rw': br_rw[i], 'br_hy': br_hy[i], 'out_w': out_w[i],
        }
        if i % 2 == 0:
            ffn = functools.partial(swiglu, wg=ffn_wg[i // 2], wu=ffn_wu[i // 2], wd=ffn_wd[i // 2])
        else:
            ffn = functools.partial(moe_swiglu, router_w=moe_router[i // 2], wg=moe_wg[i // 2],
                                    wu=moe_wu[i // 2], wd=moe_wd[i // 2])
        ml = jnp.split((silu_c @ mod_w[i] + mod_b[i])[:, None, :], 6, axis=-1)
        mc = jnp.split(silu_cc @ mod_w[i] + mod_b[i], 6, axis=-1)
        g_pre_m, g_post_m, g_pre_f, g_post_f = norm_g[i]
        h_l = rms_norm(x, g_pre_m) * (1 + ml[1]) + ml[0]
        h_c = rms_norm(ctx, g_pre_m) * (1 + mc[1]) + mc[0]
        y_l, y_c = token_mixer(h_l, h_c, p, not last)
        x = x + ml[2] * rms_norm(y_l, g_post_m)
        x = x + ml[5] * rms_norm(ffn(rms_norm(x, g_pre_f) * (1 + ml[4]) + ml[3]), g_post_f)
        if not last:
            ctx = ctx + mc[2] * rms_norm(y_c, g_post_m)
            ctx = ctx + mc[5] * rms_norm(ffn(rms_norm(ctx, g_pre_f) * (1 + mc[4]) + mc[3]), g_post_f)
    return x
```

```cpp
#include <hip/hip_runtime.h>
#include <cstdio>
#include <cstdint>

#define LAS __attribute__((address_space(3)))
typedef unsigned short bf16_t;
typedef short bf16x8 __attribute__((ext_vector_type(8)));
typedef float f32x4 __attribute__((ext_vector_type(4)));
typedef float f32x2 __attribute__((ext_vector_type(2)));
typedef unsigned u32x4 __attribute__((ext_vector_type(4)));
typedef unsigned u32x2 __attribute__((ext_vector_type(2)));

__device__ __forceinline__ float bf2f(unsigned b) { return __uint_as_float(b << 16); }
__device__ __forceinline__ float bflo(unsigned w) { return __uint_as_float(w << 16); }
__device__ __forceinline__ float bfhi(unsigned w) { return __uint_as_float(w & 0xffff0000u); }
typedef __bf16 bf16v2_t __attribute__((ext_vector_type(2)));
__device__ __forceinline__ unsigned cvt_pk_bf16(float lo, float hi) { const f32x2 v = {lo, hi}; return __builtin_bit_cast(unsigned, __builtin_convertvector(v, bf16v2_t)); }
typedef int i32x8 __attribute__((ext_vector_type(8)));
typedef int i32x4 __attribute__((ext_vector_type(4)));
__device__ __forceinline__ float clamp8(float x) { return __builtin_amdgcn_fmed3f(x, -448.f, 448.f); }
__device__ __forceinline__ unsigned cvt4_fp8(float a, float b, float c, float d, float s) {
    int p = __builtin_amdgcn_cvt_pk_fp8_f32(clamp8(a * s), clamp8(b * s), 0, false); p = __builtin_amdgcn_cvt_pk_fp8_f32(clamp8(c * s), clamp8(d * s), p, true); return (unsigned)p; }
__device__ __forceinline__ i32x8 cat8(const bf16x8 lo, const bf16x8 hi) { const i32x4 a = __builtin_bit_cast(i32x4, lo), b = __builtin_bit_cast(i32x4, hi); return __builtin_shufflevector(a, b, 0, 1, 2, 3, 4, 5, 6, 7); }
__device__ __forceinline__ bf16_t f2bf(float f) { return (bf16_t)(cvt_pk_bf16(f, 0.f) & 0xffffu); }
__device__ __forceinline__ float sigmoidf_(float x) { return __builtin_amdgcn_rcpf(1.0f + __expf(-x)); }
__device__ __forceinline__ float tanhf_(float x) { const float e = __expf(2.0f * x); return 1.0f - 2.0f * __builtin_amdgcn_rcpf(e + 1.0f); }
__device__ __forceinline__ int fresh_lane() { int l; asm volatile("v_mbcnt_lo_u32_b32 %0, -1, 0\n\tv_mbcnt_hi_u32_b32 %0, -1, %0" : "=v"(l)); return l; }
template <int CTRL> __device__ __forceinline__ float dpp_f(float v) { return __int_as_float(__builtin_amdgcn_update_dpp(0, __float_as_int(v), CTRL, 0xf, 0xf, true)); }
__device__ __forceinline__ float red8(float v) { v += dpp_f<0xB1>(v); v += dpp_f<0x4E>(v); v += dpp_f<0x141>(v); return v; }
__device__ __forceinline__ float wave_sum(float v) {
    v = red8(v); v += dpp_f<0x140>(v);
    v += __int_as_float(__builtin_amdgcn_ds_swizzle(__float_as_int(v), 0x401F));
    return __int_as_float(__builtin_amdgcn_readlane(__float_as_int(v), 0)) + __int_as_float(__builtin_amdgcn_readlane(__float_as_int(v), 32));
}

__device__ __forceinline__ u32x4 pack8(const f32x4 v0, const f32x4 v1) { u32x4 w; w.x = cvt_pk_bf16(v0[0], v0[1]); w.y = cvt_pk_bf16(v0[2], v0[3]); w.z = cvt_pk_bf16(v1[0], v1[1]); w.w = cvt_pk_bf16(v1[2], v1[3]); return w; }
__device__ __forceinline__ void unpack8(const u32x4 w, f32x4& v0, f32x4& v1) { v0 = (f32x4){bflo(w.x), bfhi(w.x), bflo(w.y), bfhi(w.y)}; v1 = (f32x4){bflo(w.z), bfhi(w.z), bflo(w.w), bfhi(w.w)}; }
template <int ACT> __device__ __forceinline__ f32x4 act4(f32x4 v) {
    if (ACT == 1) { for (int j = 0; j < 4; ++j) v[j] = tanhf_(v[j]); }
    if (ACT == 2) { for (int j = 0; j < 4; ++j) v[j] = sigmoidf_(v[j]); }
    return v; }


namespace pg8 {
constexpr int BM = 256, BK = 64, HALF = 128, HTB = HALF * BK * 2, STAGE_BYTES = 8 * HTB, NXCD = 8, WGM = 8;
__host__ __device__ __forceinline__ int lds_byte(int r, int c) { const int st = (r >> 4) * 2 + (c >> 5), rr = r & 15, cc = c & 31, ob = rr * 64 + cc * 2; return st * 1024 + (ob ^ (((ob >> 9) & 1) << 5)); }
__host__ __device__ __forceinline__ void stage_rc(int b, int& R, int& C) { const int st = b / 1024, sb = b % 1024, swz = sb ^ (((sb >> 9) & 1) << 5); R = (st >> 1) * 16 + swz / 64; C = (st & 1) * 32 + (swz % 64) / 2; }
__host__ __device__ __forceinline__ int perm32(int rho) { const int n = rho >> 4, i = rho & 15; return 8 * (i >> 2) + 4 * n + (i & 3); }

struct Unit { int pm, pn; };
struct Gemm { const bf16_t* A; const bf16_t* Bt; int M, N, K; };

struct StaticOrder {
    int nM, nN, nwg, G, c;
    __device__ void init(int M, int N, int G_, int c_) { nM = M / BM; nN = N / BM; nwg = nM * nN; G = G_; c = c_; }
    __device__ bool next(int i, Unit& u) const {
        const long L = (long)i * G + c; if (L >= nwg) return false;
        int wgid = (int)L; { const int q = nwg / NXCD, r = nwg % NXCD, xcd = wgid % NXCD, off = wgid / NXCD; wgid = (xcd < r ? xcd * (q + 1) : r * (q + 1) + (xcd - r) * q) + off; }
        const int nig = WGM * nN, gid = wgid / nig, fm = gid * WGM, gsz = (nM - fm) < WGM ? (nM - fm) : WGM;
        u.pm = fm + ((wgid % nig) % gsz); u.pn = (wgid % nig) / gsz; return true;
    }
    __device__ __forceinline__ size_t boff(const Unit&) const { return 0; }
    __device__ __forceinline__ void a_ready(const Unit&) const {}
    __device__ __forceinline__ void done(const Unit&) const {}
};
struct MoeOrder : StaticOrder {
    int pe[8]; size_t estride;
    __device__ __forceinline__ size_t boff(const Unit& u) const { const int r = u.pm * BM; int e = 0;
#pragma unroll
        for (int j = 0; j < 8; ++j) e += (r >= pe[j]) ? 1 : 0;
        e = e > 7 ? 7 : e; return (size_t)e * estride; }
};

template <class Epi, class Sched, bool F8 = false, bool ALIGN_EPI = true, bool SP2 = true>
__device__ __forceinline__ void gemm_phase(LAS unsigned char* lds, const Gemm g, const Sched& S, const Epi& E, int wave_s) {
    const int wid = wave_s, lane = fresh_lane(), tid = wid * 64 + lane, wr = wid >> 2, wc = wid & 3, fr = lane & 15, fq = lane >> 4;
    const int K = g.K, nt = K / BK;
    unsigned voffA[2], voffB[2];
#pragma unroll
    for (int i = 0; i < 2; ++i) { int R, C; stage_rc(tid * 16 + i * 8192, R, C); const int Rb = Epi::PERM ? ((R & ~31) + perm32(R & 31)) : R;
        voffA[i] = (unsigned)(R * K + C) * 2u; voffB[i] = (unsigned)(Rb * K + C) * 2u; }
    const size_t kstep = (size_t)(BK * 2);
    const size_t hstep = (size_t)HALF * K * 2;
    const size_t tstep = 2 * hstep;
    const unsigned ldsw = (unsigned)wid * 1024u;
    const int aoff = lds_byte(wr * 64 + fr, fq * 8), boff = lds_byte(wc * 32 + fr, fq * 8);
#define PG8_SA(b, h) (((b) * 2 + (h)) * HTB)
#define PG8_SB(b, h) ((4 + (b) * 2 + (h)) * HTB)
#define PG8_STAGE(bufoff, gbase, voff) do { _Pragma("unroll") for (int _i = 0; _i < 2; ++_i) { unsigned _vo = (voff)[_i]; if constexpr (F8 || Epi::PERM) asm volatile("" : "+v"(_vo)); \
        __builtin_amdgcn_global_load_lds((const unsigned*)((const char*)(gbase) + _vo), (LAS unsigned*)(lds + (bufoff) + ldsw + _i * 8192), 16, 0, 0); } } while (0)
#define PG8_LDA(dst, b, h) do { _Pragma("unroll") for (int m = 0; m < 4; ++m) _Pragma("unroll") for (int k = 0; k < 2; ++k) dst[m][k] = *(const LAS bf16x8*)(lds + PG8_SA(b, h) + aoff + m * 2048 + k * 1024); } while (0)
#define PG8_LDB(dst, b, h) do { _Pragma("unroll") for (int n = 0; n < 2; ++n) _Pragma("unroll") for (int k = 0; k < 2; ++k) dst[n][k] = *(const LAS bf16x8*)(lds + PG8_SB(b, h) + boff + n * 2048 + k * 1024); } while (0)
#define PG8_MMA(ai, bj, At, Bt) do { __builtin_amdgcn_s_setprio(1); _Pragma("unroll") for (int m = 0; m < 4; ++m) _Pragma("unroll") for (int n = 0; n < 2; ++n) { \
        if constexpr (F8) { const i32x8 _b = cat8(Bt[n][0], Bt[n][1]), _a = cat8(At[m][0], At[m][1]); asm volatile("v_mfma_f32_16x16x128_f8f6f4 %0, %1, %2, %0" : "+v"(acc[ai][bj][m][n]) : "v"(_b), "v"(_a)); } \
        else { _Pragma("unroll") for (int k = 0; k < 2; ++k) acc[ai][bj][m][n] = __builtin_amdgcn_mfma_f32_16x16x32_bf16(Bt[n][k], At[m][k], acc[ai][bj][m][n], 0, 0, 0); } } __builtin_amdgcn_s_setprio(0); } while (0)
#define PG8_WAIT_V(n) asm volatile("s_waitcnt vmcnt(" #n ")" ::: "memory")
#define PG8_WAIT_L(n) asm volatile("s_waitcnt lgkmcnt(" #n ")" ::: "memory")
#define PG8_BAR __builtin_amdgcn_s_barrier()
#define PG8_SCHED __builtin_amdgcn_sched_barrier(0)
    Unit cur, nxt; int ui = 0;
    if (!S.next(0, cur)) return;
    f32x4 acc[2][2][4][2];
    float zf = 0.f; if constexpr (F8) asm volatile("" : "+v"(zf));
#pragma unroll
    for (int a = 0; a < 2; ++a)
#pragma unroll
        for (int b = 0; b < 2; ++b)
#pragma unroll
            for (int m = 0; m < 4; ++m)
#pragma unroll
                for (int n = 0; n < 2; ++n) acc[a][b][m][n] = (f32x4){zf, zf, zf, zf};
    bf16x8 At[4][2], B0[2][2], B1[2][2];
    const char* cA = (const char*)g.A + (size_t)cur.pm * tstep; const char* cB = (const char*)g.Bt + S.boff(cur) + (size_t)cur.pn * tstep;
    S.a_ready(cur);
    if constexpr (SP2) {
        PG8_STAGE(PG8_SB(0, 0), cB, voffB); PG8_STAGE(PG8_SB(0, 1), cB + hstep, voffB); PG8_STAGE(PG8_SA(0, 0), cA, voffA); PG8_STAGE(PG8_SA(0, 1), cA + hstep, voffA);
        if (wr == 1) PG8_BAR;
        PG8_WAIT_V(2); PG8_BAR;
        PG8_STAGE(PG8_SB(1, 0), cB + kstep, voffB); PG8_STAGE(PG8_SA(1, 0), cA + kstep, voffA); PG8_STAGE(PG8_SB(1, 1), cB + hstep + kstep, voffB);
        PG8_WAIT_V(6); PG8_BAR;
    } else {
        PG8_STAGE(PG8_SB(0, 0), cB, voffB); PG8_STAGE(PG8_SA(0, 0), cA, voffA); PG8_STAGE(PG8_SB(0, 1), cB + hstep, voffB); PG8_STAGE(PG8_SA(0, 1), cA + hstep, voffA);
        if (wr == 1) PG8_BAR;
        PG8_WAIT_V(4); PG8_BAR;
        PG8_STAGE(PG8_SB(1, 0), cB + kstep, voffB); PG8_STAGE(PG8_SA(1, 0), cA + kstep, voffA); PG8_STAGE(PG8_SB(1, 1), cB + hstep + kstep, voffB);
        PG8_WAIT_V(6); PG8_BAR;
    }
    for (;;) {
        const bool has_next = S.next(ui + 1, nxt);
        const char* nA = has_next ? (const char*)g.A + (size_t)nxt.pm * tstep : cA; const char* nB = has_next ? (const char*)g.Bt + S.boff(nxt) + (size_t)nxt.pn * tstep : cB;
        for (int t = 0; t < nt; t += 2) {
            const bool last = (t == nt - 2);
            const char* a1 = cA + (size_t)(t + 1) * kstep;
            const char* a2 = last ? nA : cA + (size_t)(t + 2) * kstep; const char* b2 = last ? nB : cB + (size_t)(t + 2) * kstep;
            const char* a3 = a2 + kstep; const char* b3 = b2 + kstep;
            if (last && has_next) S.a_ready(nxt);
            if constexpr (SP2) {
            PG8_LDB(B0, 0, 0); PG8_LDB(B1, 0, 1); PG8_SCHED; PG8_LDA(At, 0, 0); PG8_STAGE(PG8_SA(1, 1), a1 + hstep, voffA);
            PG8_WAIT_V(8); PG8_WAIT_L(0); PG8_BAR; PG8_MMA(0, 0, At, B0); PG8_MMA(0, 1, At, B1); PG8_BAR; PG8_SCHED;
            PG8_LDA(At, 0, 1); PG8_STAGE(PG8_SB(0, 0), b2, voffB); PG8_STAGE(PG8_SB(0, 1), b2 + hstep, voffB); PG8_STAGE(PG8_SA(0, 0), a2, voffA);
            PG8_WAIT_V(8); PG8_WAIT_L(0); PG8_BAR; PG8_MMA(1, 0, At, B0); PG8_MMA(1, 1, At, B1); PG8_BAR; PG8_SCHED;
            PG8_LDB(B0, 1, 0); PG8_LDB(B1, 1, 1); PG8_SCHED; PG8_LDA(At, 1, 0); PG8_STAGE(PG8_SA(0, 1), a2 + hstep, voffA);
            PG8_WAIT_V(8); PG8_WAIT_L(0); PG8_BAR; PG8_MMA(0, 0, At, B0); PG8_MMA(0, 1, At, B1); PG8_BAR; PG8_SCHED;
            PG8_LDA(At, 1, 1); PG8_STAGE(PG8_SB(1, 0), b3, voffB); PG8_STAGE(PG8_SB(1, 1), b3 + hstep, voffB); PG8_STAGE(PG8_SA(1, 0), a3, voffA);
            PG8_WAIT_V(8); PG8_WAIT_L(0); PG8_BAR; PG8_MMA(1, 0, At, B0); PG8_MMA(1, 1, At, B1); PG8_BAR; PG8_SCHED;
            } else {
            PG8_LDB(B0, 0, 0); PG8_SCHED; PG8_LDA(At, 0, 0); PG8_STAGE(PG8_SA(1, 1), a1 + hstep, voffA);
            PG8_WAIT_L(8); PG8_BAR; PG8_WAIT_L(0); PG8_MMA(0, 0, At, B0); PG8_BAR; PG8_SCHED;
            PG8_LDB(B1, 0, 1); PG8_STAGE(PG8_SB(0, 0), b2, voffB);
            PG8_BAR; PG8_WAIT_L(0); PG8_MMA(0, 1, At, B1); PG8_BAR;
            PG8_LDA(At, 0, 1); PG8_STAGE(PG8_SA(0, 0), a2, voffA);
            PG8_BAR; PG8_WAIT_L(0); PG8_MMA(1, 0, At, B0); PG8_BAR; PG8_SCHED;
            PG8_STAGE(PG8_SB(0, 1), b2 + hstep, voffB);
            PG8_WAIT_V(6); PG8_BAR; PG8_MMA(1, 1, At, B1); PG8_BAR;
            PG8_LDB(B0, 1, 0); PG8_SCHED; PG8_LDA(At, 1, 0); PG8_STAGE(PG8_SA(0, 1), a2 + hstep, voffA);
            PG8_WAIT_L(8); PG8_BAR; PG8_WAIT_L(0); PG8_MMA(0, 0, At, B0); PG8_BAR; PG8_SCHED;
            PG8_LDB(B1, 1, 1); PG8_STAGE(PG8_SB(1, 0), b3, voffB);
            PG8_BAR; PG8_WAIT_L(0); PG8_MMA(0, 1, At, B1); PG8_BAR;
            PG8_LDA(At, 1, 1); PG8_STAGE(PG8_SA(1, 0), a3, voffA);
            PG8_BAR; PG8_WAIT_L(0); PG8_MMA(1, 0, At, B0); PG8_BAR; PG8_SCHED;
            PG8_STAGE(PG8_SB(1, 1), b3 + hstep, voffB);
            PG8_WAIT_V(6); PG8_BAR; PG8_MMA(1, 1, At, B1); PG8_BAR;
            }
        }
        if constexpr (ALIGN_EPI) { if (wr == 0) PG8_BAR; }
        if constexpr (F8) asm volatile("s_nop 15\n\ts_nop 15" ::: "memory");
        { const int le = fresh_lane(); E(acc, cur, wr, wc, le & 15, le >> 4); }
        S.done(cur);
        if (!has_next) break;
#pragma unroll
        for (int a = 0; a < 2; ++a)
#pragma unroll
            for (int b = 0; b < 2; ++b)
#pragma unroll
                for (int m = 0; m < 4; ++m)
#pragma unroll
                    for (int n = 0; n < 2; ++n) acc[a][b][m][n] = (f32x4){zf, zf, zf, zf};
        cur = nxt; cA = nA; cB = nB; ++ui;
        if constexpr (ALIGN_EPI) { if (wr == 1) PG8_BAR; }
    }
    PG8_WAIT_V(0);
    if constexpr (!ALIGN_EPI) { if (wr == 0) PG8_BAR; }
    PG8_BAR;
#undef PG8_SA
#undef PG8_SB
#undef PG8_STAGE
#undef PG8_LDA
#undef PG8_LDB
#undef PG8_MMA
#undef PG8_WAIT_V
#undef PG8_WAIT_L
#undef PG8_BAR
#undef PG8_SCHED
}

struct EpiInProj {
    static constexpr bool PERM = true;
    bf16_t *U, *RKV, *HY, *LORA, *GL;
    __device__ __forceinline__ void operator()(const f32x4 (&acc)[2][2][4][2], const Unit& u, int wr, int wc, int fr, int fq) const {
        const int pn = u.pn; bf16_t* base; int ld, c0, a0 = 0; bool skip1 = false;
        if (pn == 0) { base = U; ld = 256; c0 = 0; }
        else if (pn <= 6) { base = RKV; ld = 1536; c0 = (pn - 1) * 256; }
        else if (pn <= 9) { base = HY; ld = 768; c0 = (pn - 7) * 256; }
        else if (pn == 10) { base = LORA; ld = 256; c0 = 0; a0 = 1; }
        else { base = GL; ld = 256; c0 = 0; a0 = 2; }
        const int row0 = u.pm * BM + wr * 64 + fr, col = c0 + wc * 32 + 8 * fq;
#pragma unroll
        for (int ai = 0; ai < 2; ++ai)
#pragma unroll
            for (int m = 0; m < 4; ++m) { bf16_t* rowp = base + (size_t)(row0 + ai * HALF + m * 16) * ld + col;
                { f32x4 v0 = acc[ai][0][m][0], v1 = acc[ai][0][m][1];
                  if (a0 == 1) { v0 = act4<1>(v0); v1 = act4<1>(v1); } else if (a0 == 2) { v0 = act4<2>(v0); v1 = act4<2>(v1); }
                  *(u32x4*)(rowp) = pack8(v0, v1); }
                if (!skip1) *(u32x4*)(rowp + HALF) = pack8(acc[ai][1][m][0], acc[ai][1][m][1]); }
    }
};
template <int ACT> struct EpiBf16 {
    static constexpr bool PERM = true;
    bf16_t* O; int ld;
    __device__ __forceinline__ void operator()(const f32x4 (&acc)[2][2][4][2], const Unit& u, int wr, int wc, int fr, int fq) const {
        const int row0 = u.pm * BM + wr * 64 + fr, col = u.pn * BM + wc * 32 + 8 * fq;
#pragma unroll
        for (int ai = 0; ai < 2; ++ai)
#pragma unroll
            for (int m = 0; m < 4; ++m) { bf16_t* rowp = O + (size_t)(row0 + ai * HALF + m * 16) * ld + col;
#pragma unroll
                for (int bj = 0; bj < 2; ++bj) *(u32x4*)(rowp + bj * HALF) = pack8(act4<ACT>(acc[ai][bj][m][0]), act4<ACT>(acc[ai][bj][m][1])); }
    }
};
template <int MODE> struct EpiComb {
    static constexpr bool PERM = true;
    bf16_t* O; const bf16_t* G; int ld; int ldg;
    __device__ __forceinline__ void operator()(const f32x4 (&acc)[2][2][4][2], const Unit& u, int wr, int wc, int fr, int fq) const {
        const int row0 = u.pm * BM + wr * 64 + fr, col = u.pn * BM + wc * 32 + 8 * fq; const int lg = ldg ? ldg : ld;
        constexpr bool RG = (MODE == 0 || MODE == 1 || MODE == 4), RO = (MODE == 1 || MODE == 3);
#pragma unroll
        for (int ai = 0; ai < 2; ++ai) {
            u32x4 gv[4][2], ov[4][2];
#pragma unroll
            for (int m = 0; m < 4; ++m) { const size_t off = (size_t)(row0 + ai * HALF + m * 16) * ld + col, offg = (size_t)(row0 + ai * HALF + m * 16) * lg + col;
#pragma unroll
                for (int bj = 0; bj < 2; ++bj) { if (RG) gv[m][bj] = *(const u32x4*)(G + offg + bj * HALF); if (RO) ov[m][bj] = *(const u32x4*)(O + off + bj * HALF); } }
#pragma unroll
            for (int m = 0; m < 4; ++m) { const size_t off = (size_t)(row0 + ai * HALF + m * 16) * ld + col;
#pragma unroll
                for (int bj = 0; bj < 2; ++bj) { f32x4 v0 = acc[ai][bj][m][0], v1 = acc[ai][bj][m][1];
                    if (RG) { f32x4 g0, g1; unpack8(gv[m][bj], g0, g1);
                        if (MODE == 4) { v0 = g0 * act4<2>(v0); v1 = g1 * act4<2>(v1); } else { v0 = v0 * g0; v1 = v1 * g1; } }
                    if (RO) { f32x4 o0, o1; unpack8(ov[m][bj], o0, o1); v0 = v0 + o0; v1 = v1 + o1; }
                    *(u32x4*)(O + off + bj * HALF) = pack8(v0, v1); } }
            asm volatile("" ::: "memory"); }
    }
};
struct EpiF32 {
    static constexpr bool PERM = false;
    float* C; int ldc;
    __device__ __forceinline__ void operator()(const f32x4 (&acc)[2][2][4][2], const Unit& u, int wr, int wc, int fr, int fq) const {
        const int row0 = u.pm * BM + wr * 64 + fr, col0 = u.pn * BM + wc * 32 + 4 * fq;
#pragma unroll
        for (int ai = 0; ai < 2; ++ai)
#pragma unroll
            for (int m = 0; m < 4; ++m) { float* rowp = C + (size_t)(row0 + ai * HALF + m * 16) * ldc + col0;
#pragma unroll
                for (int bj = 0; bj < 2; ++bj)
#pragma unroll
                    for (int n = 0; n < 2; ++n) *(f32x4*)(rowp + bj * HALF + n * 16) = acc[ai][bj][m][n]; }
    }
};
struct EpiSwiGLU {
    static constexpr bool PERM = true;
    bf16_t* O; int ld;
    __device__ __forceinline__ void operator()(const f32x4 (&acc)[2][2][4][2], const Unit& u, int wr, int wc, int fr, int fq) const {
        const int row0 = u.pm * BM + wr * 64 + fr, col = u.pn * HALF + wc * 32 + 8 * fq;
#pragma unroll
        for (int ai = 0; ai < 2; ++ai)
#pragma unroll
            for (int m = 0; m < 4; ++m) { f32x4 v[2];
#pragma unroll
                for (int n = 0; n < 2; ++n) { const f32x4 gt = acc[ai][0][m][n], up = acc[ai][1][m][n];
#pragma unroll
                    for (int j = 0; j < 4; ++j) v[n][j] = gt[j] * sigmoidf_(gt[j]) * up[j]; }
                *(u32x4*)(O + (size_t)(row0 + ai * HALF + m * 16) * ld + col) = pack8(v[0], v[1]); }
    }
};
struct EpiSig8 {
    static constexpr bool PERM = true;
    bf16_t* O; int ld; float s;
    __device__ __forceinline__ void operator()(const f32x4 (&acc)[2][2][4][2], const Unit& u, int wr, int wc, int fr, int fq) const {
        const int row0 = u.pm * BM + wr * 64 + fr, col = u.pn * BM + wc * 32 + 8 * fq;
#pragma unroll
        for (int ai = 0; ai < 2; ++ai)
#pragma unroll
            for (int m = 0; m < 4; ++m) { bf16_t* rowp = O + (size_t)(row0 + ai * HALF + m * 16) * ld + col;
#pragma unroll
                for (int bj = 0; bj < 2; ++bj) *(u32x4*)(rowp + bj * HALF) = pack8(act4<2>(acc[ai][bj][m][0] * s), act4<2>(acc[ai][bj][m][1] * s)); }
    }
};
struct EpiF8Out {
    static constexpr bool PERM = true;
    unsigned char* O; int ld; float s;
    __device__ __forceinline__ void operator()(const f32x4 (&acc)[2][2][4][2], const Unit& u, int wr, int wc, int fr, int fq) const {
        const int row0 = u.pm * BM + wr * 64 + fr, col = u.pn * BM + wc * 32 + 8 * fq;
#pragma unroll
        for (int ai = 0; ai < 2; ++ai)
#pragma unroll
            for (int m = 0; m < 4; ++m) { unsigned char* rowp = O + (size_t)(row0 + ai * HALF + m * 16) * ld + col;
#pragma unroll
                for (int bj = 0; bj < 2; ++bj) { const f32x4 v0 = acc[ai][bj][m][0], v1 = acc[ai][bj][m][1]; u32x2 w;
                    w.x = cvt4_fp8(v0[0], v0[1], v0[2], v0[3], s); w.y = cvt4_fp8(v1[0], v1[1], v1[2], v1[3], s); *(u32x2*)(rowp + bj * HALF) = w; } }
    }
};
struct EpiSwiGLU8 {
    static constexpr bool PERM = true;
    unsigned char* O; int ld;
    __device__ __forceinline__ void operator()(const f32x4 (&acc)[2][2][4][2], const Unit& u, int wr, int wc, int fr, int fq) const {
        const int row0 = u.pm * BM + wr * 64 + fr, col = u.pn * HALF + wc * 32 + 8 * fq;
#pragma unroll
        for (int ai = 0; ai < 2; ++ai)
#pragma unroll
            for (int m = 0; m < 4; ++m) { f32x4 v[2];
#pragma unroll
                for (int n = 0; n < 2; ++n) { const f32x4 gt = acc[ai][0][m][n], up = acc[ai][1][m][n];
#pragma unroll
                    for (int j = 0; j < 4; ++j) { const float gj = gt[j] * (1.f / 8192.f); v[n][j] = gj * sigmoidf_(gj) * up[j]; } }
                u32x2 w; w.x = cvt4_fp8(v[0][0], v[0][1], v[0][2], v[0][3], 1.f / 1024.f); w.y = cvt4_fp8(v[1][0], v[1][1], v[1][2], v[1][3], 1.f / 1024.f);
                *(u32x2*)(O + (size_t)(row0 + ai * HALF + m * 16) * ld + col) = w; }
    }
};
}

constexpr int DM = 1024, NBATCH = 8, SEQL = 4096, CTXL = 256, NLAYER = 2;
constexpr int ML = NBATCH * SEQL, MC = NBATCH * CTXL, MT = ML + MC;
constexpr int IN_COLS = 6016, INP_N = 3072;
constexpr int FFH = 2816, EXH = 3584, NEXP = 8, EXQ = 3584;
constexpr int MOE_CAP = 2 * ML + NEXP * 256;
constexpr int NCHAIN = 68;
constexpr int NWAVES = 8, NTHR = 512;

constexpr size_t KiB = 1024, MiB = 1u << 20;
constexpr size_t WS_CTL = 0, CTL_ZERO_BYTES = 128 * KiB;
constexpr size_t WS_MODV = 256 * KiB;
constexpr size_t WS_S5TAB = 768 * KiB;
constexpr size_t WS_MOEMETA = 1408 * KiB;
constexpr size_t WS_HFILTC = 2304 * KiB;
constexpr size_t WS_W_LORA = 3328 * KiB;
constexpr size_t WS_W_IN = 4 * MiB;
constexpr size_t WS_W_GATE = 16 * MiB;
constexpr size_t WS_W_BR = 28 * MiB;
constexpr size_t WS_W_OUT = 32 * MiB;
constexpr size_t WS_W_GLU = 36 * MiB;
constexpr size_t WS_W_G2 = 36 * MiB + 256 * KiB;
constexpr size_t WS_W_FGU = 37 * MiB;
constexpr size_t WS_W_FD = 48 * MiB;
constexpr size_t WS_S5TAB2 = 53 * MiB + 512 * KiB;
constexpr size_t WS_H = 54 * MiB;
constexpr size_t WS_U = 122 * MiB;
constexpr size_t WS_RKV = 139 * MiB;
constexpr size_t WS_LORA = 241 * MiB;
constexpr size_t WS_GL = 258 * MiB;
constexpr size_t WS_HY = 275 * MiB;
constexpr size_t WS_HYT = 326 * MiB;
constexpr size_t WS_HFILT = 374 * MiB;
constexpr size_t WS_KSPEC = 390 * MiB;
constexpr size_t WS_E = 422 * MiB;
constexpr size_t WS_CIN = 430 * MiB + 512 * KiB;
constexpr size_t WS_YPRE = 439 * MiB;
constexpr size_t WS_S5OUT = 456 * MiB;
constexpr size_t WS_HYOT = 473 * MiB;
constexpr size_t WS_HYOUT = 489 * MiB;
constexpr size_t WS_RWOUT = 506 * MiB;
constexpr size_t WS_CBON = 540 * MiB;
constexpr size_t WS_CTXX = 542 * MiB + 256 * KiB;
constexpr size_t WS_YD = 550 * MiB + 256 * KiB;
constexpr size_t WS_END = 619 * MiB;
constexpr size_t WS_XS_A = 4 * MiB, WS_XS_B = 601 * MiB; constexpr int XS_ROWS_A = 25600;
constexpr size_t WS_H8 = 413 * MiB;
constexpr size_t WS_RWG = WS_RWOUT;
constexpr size_t WS_RA = WS_HY;
constexpr size_t WS_SC = WS_RA + 104 * MiB;
constexpr size_t RA_UNIT = 24832;
constexpr size_t WS_G = WS_U;
constexpr size_t WS_MB = WS_HYT;
constexpr size_t WS_YF = WS_HYT + 68 * MiB;
constexpr size_t WS_ACT = WS_U;
constexpr size_t WS_XB = 88 * MiB;
constexpr size_t WS_ACTQ = 154 * MiB;
constexpr size_t WS_YB = 385 * MiB;
constexpr size_t WS_MOEW = 517 * MiB;
static_assert(WS_W_FD + (size_t)1024 * FFH * 2 <= WS_H, "W");
static_assert(WS_RA + (size_t)4 * 8 * 2 * NCHAIN * RA_UNIT <= WS_SC && WS_SC + (size_t)4 * 8 * 2 * NCHAIN * 8192 <= WS_E, "RA");
static_assert(WS_G + (size_t)MT * 3072 * 2 <= WS_HYT && WS_MB + (size_t)MT * 1024 * 2 <= WS_YF, "G/MB");
static_assert(WS_YF + (size_t)MT * 1024 * 2 <= WS_HYOT, "YF");
static_assert(WS_ACT + (size_t)MT * FFH * 2 <= WS_HYT, "ACT");
static_assert((size_t)ML * 1024 + WS_H <= WS_XB && WS_XB + (size_t)MOE_CAP * 1024 <= WS_ACTQ && WS_ACTQ + (size_t)MOE_CAP * EXQ <= WS_YB && WS_YB + (size_t)MOE_CAP * 1024 * 2 <= WS_MOEW, "MoE buffers");
static_assert(WS_MOEW + (size_t)8 * 7168 * 1024 + (size_t)8 * 1024 * 3584 <= WS_END, "MOEW");
static_assert(WS_YD + (size_t)2 * MT * 512 * 2 <= WS_END, "YD");
static_assert(WS_SC + (size_t)4 * 8 * 2 * NCHAIN * 8192 <= WS_H8 && WS_H8 + (size_t)MT * 1024 <= WS_S5OUT, "H8");
constexpr int CW_BAR = 4096;
constexpr int CW_MOECNT = 16384;

constexpr int LDS_BYTES = 147456;
constexpr int LDS_XB = LDS_BYTES - 16;

#define XB_TMO      128
#define XB_XCNT(j)  (256  + 64 * (j))
#define XB_XSUB(j)  (1280 + 64 * (j))
#define XB_XGEN(j)  (2304 + 64 * (j))
#define XB_TOP      3328
#define XB_TOPGEN   3392
#define XCD_BAR_WORDS 3456
#define XB_SPIN_CAP (1u << 18)

__device__ __forceinline__ unsigned xb_ld(unsigned* p)              { return __hip_atomic_load(p, __ATOMIC_RELAXED, __HIP_MEMORY_SCOPE_AGENT); }
__device__ __forceinline__ unsigned xb_add(unsigned* p, unsigned v) { return __hip_atomic_fetch_add(p, v, __ATOMIC_RELAXED, __HIP_MEMORY_SCOPE_AGENT); }
__device__ __forceinline__ unsigned xb_xcc_id() { return (unsigned)__builtin_amdgcn_s_getreg((3 << 11) | 20) & 0xFu; }
#define XB_SPIN(cond, bar) do { unsigned _sp = 0; while (cond) { __builtin_amdgcn_s_sleep(1); \
    if ((++_sp & 255u) == 0u) { if (xb_ld(&(bar)[XB_TMO])) break; if (_sp > XB_SPIN_CAP) { atomicAdd(&(bar)[XB_TMO], 1u); break; } } } } while (0)

struct XcdBarrier { unsigned* bar; unsigned x; volatile LAS unsigned* st; };

__device__ __forceinline__ XcdBarrier xcd_barrier_post(unsigned* bar, volatile LAS unsigned* st, int wave_s) {
    XcdBarrier b; b.bar = bar; b.x = xb_xcc_id(); b.st = st;
    if (wave_s == 0 && fresh_lane() == 0) (void)xb_add(&bar[XB_XCNT(b.x)], 1u);
    return b;
}
__device__ __forceinline__ void xcd_barrier_complete(unsigned* bar, unsigned x, unsigned& nloc, unsigned& nx) {
    const unsigned G = gridDim.x * gridDim.y * gridDim.z;
    unsigned sum, cnt, mine, sp = 0u;
    for (;;) {
        sum = 0u; cnt = 0u; mine = 0u;
#pragma unroll
        for (unsigned j = 0; j < 16; ++j) { const unsigned c = xb_ld(&bar[XB_XCNT(j)]); sum += c; cnt += (c > 0u) ? 1u : 0u; mine = (j == x) ? c : mine; }
        if (sum == G) break;
        __builtin_amdgcn_s_sleep(1);
        if ((++sp & 255u) == 0u) { if (xb_ld(&bar[XB_TMO])) break; if (sp > XB_SPIN_CAP) { atomicAdd(&bar[XB_TMO], 1u); break; } }
    }
    nloc = mine > 0u ? mine : 1u; nx = cnt > 0u ? cnt : 1u;
}
__device__ __forceinline__ void xcd_barrier(const XcdBarrier& b, int wave_s, unsigned* bar) {
    asm volatile("s_waitcnt vmcnt(0)" ::: "memory");
    __syncthreads();
    if (wave_s == 0 && fresh_lane() == 0) {
        __builtin_amdgcn_s_waitcnt(0);
        unsigned nloc = b.st[0], nx = b.st[1];
        if (nloc == 0u) { xcd_barrier_complete(bar, b.x, nloc, nx); b.st[0] = nloc; b.st[1] = nx; }
        const unsigned old = xb_add(&bar[XB_XSUB(b.x)], 1u);
        const unsigned gen = old / nloc;
        if (old + 1u == (gen + 1u) * nloc) {
            __builtin_amdgcn_fence(__ATOMIC_RELEASE, "agent");
            asm volatile("s_waitcnt vmcnt(0)" ::: "memory");
            const unsigned og = xb_add(&bar[XB_TOP], 1u);
            const unsigned tg = og / nx;
            if (og + 1u == (tg + 1u) * nx) xb_add(&bar[XB_TOPGEN], 1u);
            else XB_SPIN(xb_ld(&bar[XB_TOPGEN]) == tg, bar);
            __builtin_amdgcn_fence(__ATOMIC_ACQUIRE, "agent");
            xb_add(&bar[XB_XGEN(b.x)], 1u);
            asm volatile("s_waitcnt vmcnt(0)" ::: "memory");
        } else {
            XB_SPIN(xb_ld(&bar[XB_XGEN(b.x)]) == gen, bar);
            __builtin_amdgcn_fence(__ATOMIC_ACQUIRE, "agent");
            asm volatile("s_waitcnt vmcnt(0)" ::: "memory");
        }
    }
    __syncthreads();
}
__device__ __forceinline__ void block_self_sync() {
    asm volatile("s_waitcnt vmcnt(0)" ::: "memory");
    __syncthreads();
    __builtin_amdgcn_fence(__ATOMIC_ACQUIRE, "agent");
    asm volatile("s_waitcnt vmcnt(0)" ::: "memory");
    __syncthreads();
}

struct Params { const float* in[49]; float* out; unsigned char* ws; int ph_lo, ph_hi; };
#define CAS __attribute__((address_space(4)))
struct KA { const CAS unsigned char* p;
    __device__ __forceinline__ const float* in(int i) const { return *(const float* const CAS*)(p + 8 * i); }
    __device__ __forceinline__ float* out() const { return *(float* const CAS*)(p + 8 * 49); }
    __device__ __forceinline__ unsigned char* ws() const { return *(unsigned char* const CAS*)(p + 8 * 50); }
    __device__ __forceinline__ int ph_lo() const { return *(const int CAS*)(p + 8 * 51); }
    __device__ __forceinline__ int ph_hi() const { return *(const int CAS*)(p + 8 * 51 + 4); } };
static_assert(sizeof(Params) == 8 * 51 + 8, "Params layout");
enum { I_X = 0, I_C, I_CTX, I_CCTX, I_MODW, I_MODB, I_NORMG, I_INW, I_S5LRE, I_S5LIM, I_S5STEP, I_S5BRE, I_S5BIM, I_S5CRE, I_S5CIM, I_S5D, I_S5GLU,
       I_RWCONV, I_RWW0, I_RWW2, I_RWA0, I_RWA2, I_RWG2, I_RWKK, I_RWKA, I_RWRK, I_RWLNW, I_RWLNB, I_HYCONVW, I_HYCONVB, I_HYFW1, I_HYFB1, I_HYFF1, I_HYFW2, I_HYFB2, I_HYFF2,
       I_HYFW3, I_HYBIAS, I_BRS5, I_BRRW, I_BRHY, I_OUTW, I_FFNWG, I_FFNWU, I_FFNWD, I_MOER, I_MOEWG, I_MOEWU, I_MOEWD };

struct Frame { LAS unsigned char* lds; int tid, lane, wave, bid, G, gw, NGW; };
#define LDS_WAIT() asm volatile("s_waitcnt lgkmcnt(0)" ::: "memory")

__device__ __forceinline__ void wt_item(const float* W, int ldn, int k0, int n0, bf16_t* dst, int ldd, LAS float* scr, int lane) {
    { float tv[32];
#pragma unroll
      for (int i = 0; i < 32; ++i) tv[i] = W[(size_t)(k0 + 2 * i + (lane >> 5)) * ldn + n0 + (lane & 31)];
#pragma unroll
      for (int i = 0; i < 32; ++i) scr[(2 * i + (lane >> 5)) * 33 + (lane & 31)] = tv[i]; }
    LDS_WAIT();
    const int c = lane & 7;
#pragma unroll
    for (int j = 0; j < 4; ++j) { const int n = (lane >> 3) + 8 * j; const LAS float* s = scr + (8 * c) * 33 + n;
        u32x4 o; o.x = cvt_pk_bf16(s[0 * 33], s[1 * 33]); o.y = cvt_pk_bf16(s[2 * 33], s[3 * 33]); o.z = cvt_pk_bf16(s[4 * 33], s[5 * 33]); o.w = cvt_pk_bf16(s[6 * 33], s[7 * 33]);
        *(u32x4*)(dst + (size_t)n * ldd + 8 * c) = o; }
    LDS_WAIT();
}
__device__ __forceinline__ void wt_job(int r, const float* W, int ldn, int nbc, int nbeg, bf16_t* D, int ldd, int drow0, int il, int krow0, LAS float* scr, int lane) {
    const int kb = r / nbc, nb = r % nbc, rel = 32 * nb;
    const int drow = drow0 + (il ? 256 * (rel / 128) + (rel % 128) : rel);
    wt_item(W + (size_t)krow0 * ldn, ldn, 64 * kb, nbeg + rel, D + (size_t)drow * ldd + 64 * kb, ldd, scr, lane);
}

__device__ __forceinline__ void wt_item8(const float* W, int ldn, int k0, int n0, unsigned char* dst, int ldd, LAS float* scr, int lane) {
    { float tv[32];
#pragma unroll
      for (int i = 0; i < 32; ++i) tv[i] = W[(size_t)(k0 + 2 * i + (lane >> 5)) * ldn + n0 + (lane & 31)];
#pragma unroll
      for (int i = 0; i < 32; ++i) scr[(2 * i + (lane >> 5)) * 33 + (lane & 31)] = tv[i]; }
    LDS_WAIT();
    const int c = lane & 7;
#pragma unroll
    for (int j = 0; j < 4; ++j) { const int n = (lane >> 3) + 8 * j; const LAS float* s = scr + (8 * c) * 33 + n;
        u32x2 o; o.x = cvt4_fp8(s[0 * 33], s[1 * 33], s[2 * 33], s[3 * 33], 512.f); o.y = cvt4_fp8(s[4 * 33], s[5 * 33], s[6 * 33], s[7 * 33], 512.f);
        *(u32x2*)(dst + (size_t)n * ldd + 8 * c) = o; }
    LDS_WAIT();
}
__device__ __forceinline__ void wt_job8(int r, const float* W, int ldn, int nbc, int nbeg, unsigned char* D, int ldd, int drow0, int il, int krow0, LAS float* scr, int lane) {
    const int kb = r / nbc, nb = r % nbc, rel = 32 * nb;
    const int drow = drow0 + (il ? 256 * (rel / 128) + (rel % 128) : rel);
    wt_item8(W + (size_t)krow0 * ldn, ldn, 64 * kb, nbeg + rel, D + (size_t)drow * ldd + 64 * kb, ldd, scr, lane);
}

__device__ __forceinline__ void p0_prologue(const Frame& F, const KA& P) {
    unsigned char* ws = P.ws();
    {
        LAS float* sc = (LAS float*)F.lds;
        LAS float* part = (LAS float*)(F.lds + 40960);
        for (int i = F.tid; i < 9 * 1024; i += NTHR) { const float v = (i < 8192) ? P.in(I_C)[i] : P.in(I_CCTX)[i - 8192]; sc[i] = v * sigmoidf_(v); }
        __syncthreads();
        const int colbase = F.bid * 48;
        if (F.tid < 384 && colbase < 12288) {
            const int c4 = F.tid % 12, kq = F.tid / 12, col = colbase + 4 * c4, l = col / 6144, j = col % 6144;
            const f32x4* W = (const f32x4*)(P.in(I_MODW) + (size_t)l * 1024 * 6144 + j);
            f32x4 a[9];
#pragma unroll
            for (int r = 0; r < 9; ++r) a[r] = (f32x4){0.f, 0.f, 0.f, 0.f};
#pragma unroll 1
            for (int half = 0; half < 4; ++half) {
                f32x4 wv[8]; const f32x4* Wh = W + (size_t)(kq + 256 * half) * 1536;
#pragma unroll
                for (int u = 0; u < 8; ++u) wv[u] = Wh[(size_t)(32 * u) * 1536];
#pragma unroll
                for (int u = 0; u < 8; ++u) { const int k = kq + 32 * (8 * half + u);
#pragma unroll
                    for (int r = 0; r < 9; ++r) a[r] += wv[u] * sc[r * 1024 + k]; }
            }
#pragma unroll
            for (int r = 0; r < 9; ++r) *(LAS f32x4*)(part + (kq * 9 + r) * 48 + 4 * c4) = a[r];
        }
        __syncthreads();
        if (F.tid < 432 && colbase < 12288) { const int r = F.tid / 48, cl = F.tid % 48, col = colbase + cl, l = col / 6144, j = col % 6144; float s = P.in(I_MODB)[l * 6144 + j];
#pragma unroll 8
            for (int kq = 0; kq < 32; ++kq) s += part[(kq * 9 + r) * 48 + cl];
            ((float*)(ws + WS_MODV))[((size_t)l * 9 + r) * 6144 + j] = s; }
        __syncthreads();
    }
    if (F.gw < 64) {
        const int ldg = F.gw, p = F.lane;
        const float lr = P.in(I_S5LRE)[ldg * 64 + p], li = P.in(I_S5LIM)[ldg * 64 + p], step = expf(P.in(I_S5STEP)[ldg]);
        const float mag = expf(lr * step), ang = li * step, ar = mag * cosf(ang), ai = mag * sinf(ang);
        const float den = lr * lr + li * li, nr = ar - 1.0f, ni = ai;
        const float qr = (nr * lr + ni * li) / den, qi = (ni * lr - nr * li) / den;
        float* T = (float*)(ws + WS_S5TAB) + (size_t)ldg * 2304;
        T[p] = ar; T[64 + p] = ai;
        float pr = ar, pi = ai;
#pragma unroll
        for (int s = 0; s < 6; ++s) { const float t = pr * pr - pi * pi; pi = 2.f * pr * pi; pr = t; }
        T[128 + p] = pr; T[192 + p] = pi;
        const float* br = P.in(I_S5BRE) + ((size_t)ldg * 64 + p) * 16; const float* bi = P.in(I_S5BIM) + ((size_t)ldg * 64 + p) * 16;
#pragma unroll
        for (int i = 0; i < 16; ++i) { T[256 + p * 16 + i] = qr * br[i] - qi * bi[i]; T[1280 + p * 16 + i] = qr * bi[i] + qi * br[i]; }
        bf16_t* T2 = (bf16_t*)(ws + WS_S5TAB2) + (size_t)ldg * 4096;
        const float* cre = P.in(I_S5CRE) + (size_t)ldg * 1024; const float* cim = P.in(I_S5CIM) + (size_t)ldg * 1024;
#pragma unroll
        for (int i = 0; i < 16; ++i) { T2[p * 16 + i] = f2bf(qr * br[i] - qi * bi[i]); T2[(64 + p) * 16 + i] = f2bf(qr * bi[i] + qi * br[i]);
            T2[2048 + i * 128 + 2 * p] = f2bf(cre[i * 64 + p]); T2[2048 + i * 128 + 2 * p + 1] = f2bf(-cim[i * 64 + p]); }
    }
    LAS float* scr = (LAS float*)(F.lds + F.wave * 16384);
    constexpr int PER_LAYER = 896 + 384 + 192 + 1536 + 128 + 256 + 128 + 512 + 32 + 32 + 64;
    constexpr int NITEMS = 2 * PER_LAYER + 3 * 1408;
    for (int it = F.gw; it < NITEMS; it += F.NGW) {
        int r = it;
        if (r < 2 * PER_LAYER) {
            const int l = r / PER_LAYER; r -= l * PER_LAYER;
            const float* inw = P.in(I_INW) + (size_t)l * 1024 * IN_COLS;
            bf16_t* Win = (bf16_t*)(ws + WS_W_IN) + (size_t)l * INP_N * 1024; unsigned char* Wg = ws + WS_W_GATE + (size_t)l * 3072 * 1024;
            bf16_t* Wbr = (bf16_t*)(ws + WS_W_BR + (size_t)l * 2 * MiB);
            if (r < 896) { wt_job(r, inw, IN_COLS, 56, 0, Win, 1024, 0, 0, 0, scr, F.lane); continue; } r -= 896;
            if (r < 384) { wt_job(r, inw, IN_COLS, 24, 2176, Win, 1024, 1792, 0, 0, scr, F.lane); continue; } r -= 384;
            if (r < 192) { wt_job(r, inw, IN_COLS, 12, 1792, Win, 1024, 2560, 0, 0, scr, F.lane); continue; } r -= 192;
            if (r < 1536) { wt_job8(r, inw, IN_COLS, 96, 2944, Wg, 1024, 0, 0, 0, scr, F.lane); continue; } r -= 1536;
            if (r < 128) { wt_job(r, P.in(I_BRS5) + (size_t)l * 256 * 1024, 1024, 32, 0, Wbr, 256, 0, 0, 0, scr, F.lane); continue; } r -= 128;
            if (r < 256) { wt_job(r, P.in(I_BRRW) + (size_t)l * 512 * 1024, 1024, 32, 0, Wbr + 1024 * 256, 512, 0, 0, 0, scr, F.lane); continue; } r -= 256;
            if (r < 128) { wt_job(r, P.in(I_BRHY) + (size_t)l * 256 * 1024, 1024, 32, 0, Wbr + 1024 * 256 + 1024 * 512, 256, 0, 0, 0, scr, F.lane); continue; } r -= 128;
            if (r < 512) { wt_job(r, P.in(I_OUTW) + (size_t)l * 1024 * 1024, 1024, 32, 0, (bf16_t*)(ws + WS_W_OUT) + (size_t)l * 1024 * 1024, 1024, 0, 0, 0, scr, F.lane); continue; } r -= 512;
            if (r < 32) { wt_job(r, P.in(I_S5GLU) + (size_t)l * 256 * 256, 256, 8, 0, (bf16_t*)(ws + WS_W_GLU) + (size_t)l * 256 * 256, 256, 0, 0, 0, scr, F.lane); continue; } r -= 32;
            if (r >= 32) { r -= 32;
                const int dd = r >> 5, which = (r >> 4) & 1, it2 = r & 15;
                wt_job(it2, (which ? P.in(I_RWA2) : P.in(I_RWW2)) + (size_t)(l * 2 + dd) * 64 * 512, 512, 16, 0, (bf16_t*)(ws + WS_W_LORA) + (size_t)((l * 2 + dd) * 2 + which) * 512 * 64, 64, 0, 0, 0, scr, F.lane);
                continue; }
            { bf16_t* G2 = (bf16_t*)(ws + WS_W_G2) + (size_t)l * 512 * 256;
              wt_job(r, P.in(I_RWG2) + (size_t)l * 128 * 512, 512, 16, 0, G2, 256, 0, 0, 0, scr, F.lane);
              const int nb = r % 16, kb = r / 16;
              for (int i = F.lane; i < 32 * 8; i += 64) *(u32x4*)(G2 + (size_t)(32 * nb + (i >> 3)) * 256 + 128 + 64 * kb + (i & 7) * 8) = (u32x4){0u, 0u, 0u, 0u}; }
            continue;
        }
        r -= 2 * PER_LAYER;
        if (r < 1408) { wt_job(r, P.in(I_FFNWG), FFH, 88, 0, (bf16_t*)(ws + WS_W_FGU), 1024, 0, 1, 0, scr, F.lane); continue; } r -= 1408;
        if (r < 1408) { wt_job(r, P.in(I_FFNWU), FFH, 88, 0, (bf16_t*)(ws + WS_W_FGU), 1024, 128, 1, 0, scr, F.lane); continue; } r -= 1408;
        wt_job(r, P.in(I_FFNWD), 1024, 32, 0, (bf16_t*)(ws + WS_W_FD), FFH, 0, 0, 0, scr, F.lane);
    }
}
__device__ __forceinline__ void moe_convert_quarter(const Frame& F, const KA& P, int q, int which) {
    LAS float* scr = (LAS float*)(F.lds + F.wave * 16384);
    unsigned char* Wgu = P.ws() + WS_MOEW; unsigned char* Wd = Wgu + (size_t)8 * 2 * EXQ * 1024;
    constexpr int NGU = (EXQ / 32) * 16, ND = 32 * (EXQ / 64);
#pragma unroll 1
    for (int it = F.gw; it < 8 * (2 * NGU + ND); it += F.NGW) {
        const int e = it / (2 * NGU + ND); int r = it % (2 * NGU + ND);
        const float* wg = P.in(I_MOEWG) + (size_t)e * 1024 * EXH; const float* wu = P.in(I_MOEWU) + (size_t)e * 1024 * EXH; const float* wd = P.in(I_MOEWD) + (size_t)e * EXH * 1024;
        if (r < NGU) { if (which & 1) wt_job8(r, wg, EXH, EXQ / 32, q * EXQ, Wgu + (size_t)e * 2 * EXQ * 1024, 1024, 0, 1, 0, scr, F.lane); continue; } r -= NGU;
        if (r < NGU) { if (which & 1) wt_job8(r, wu, EXH, EXQ / 32, q * EXQ, Wgu + (size_t)e * 2 * EXQ * 1024, 1024, 128, 1, 0, scr, F.lane); continue; } r -= NGU;
        if (which & 2) wt_job8(r, wd, 1024, 32, 0, Wd + (size_t)e * 1024 * EXQ, EXQ, 0, 0, q * EXQ, scr, F.lane);
    }
}

template <int MODE_Y, bool ROUTE>
__device__ __forceinline__ void resid_norm_row(const Frame& F, const KA& P, int row, const void* xin, bool xin_bf, const float* Yp, const f32x4 (&pa)[4], const f32x4 (&pb)[4], const f32x4 (&psh)[4], void* xout, bool xout_bf,
                                               bf16_t* Hout, f32x4 (&hv)[4], int s0 = 0, int s1 = 0, float g0 = 0.f, float g1 = 0.f) {
    f32x4 v[4];
    if (xin_bf) { const bf16_t* xb = (const bf16_t*)xin + 4 * F.lane;
#pragma unroll
        for (int j = 0; j < 4; ++j) { const u32x2 a = *(const u32x2*)(xb + 256 * j); v[j] = (f32x4){bflo(a.x), bfhi(a.x), bflo(a.y), bfhi(a.y)}; } }
    else { const f32x4* xr = (const f32x4*)(xin) + F.lane;
#pragma unroll
        for (int j = 0; j < 4; ++j) v[j] = xr[64 * j]; }
    if (MODE_Y != 0) {
        f32x4 y[4];
        if (MODE_Y == 1) { const bf16_t* yr = (const bf16_t*)(Yp) + 4 * F.lane;
#pragma unroll
            for (int j = 0; j < 4; ++j) { const u32x2 a = *(const u32x2*)(yr + 256 * j); y[j] = (f32x4){bflo(a.x), bfhi(a.x), bflo(a.y), bfhi(a.y)}; } }
        else {
            const unsigned char* yb = P.ws() + WS_YB;
#pragma unroll
            for (int j = 0; j < 4; ++j) { const int a = *(const int*)(yb + (size_t)s0 * 1024 + 4 * F.lane + 256 * j), b = *(const int*)(yb + (size_t)s1 * 1024 + 4 * F.lane + 256 * j);
                y[j] = (f32x4){g0 * __builtin_amdgcn_cvt_f32_fp8(a, 0) + g1 * __builtin_amdgcn_cvt_f32_fp8(b, 0), g0 * __builtin_amdgcn_cvt_f32_fp8(a, 1) + g1 * __builtin_amdgcn_cvt_f32_fp8(b, 1),
                               g0 * __builtin_amdgcn_cvt_f32_fp8(a, 2) + g1 * __builtin_amdgcn_cvt_f32_fp8(b, 2), g0 * __builtin_amdgcn_cvt_f32_fp8(a, 3) + g1 * __builtin_amdgcn_cvt_f32_fp8(b, 3)}; }
        }
        float s = 0.f;
#pragma unroll
        for (int j = 0; j < 4; ++j) s += (y[j].x * y[j].x + y[j].y * y[j].y) + (y[j].z * y[j].z + y[j].w * y[j].w);
        const float rs = rsqrtf(wave_sum(s) * (1.f / 1024.f) + 1e-6f);
#pragma unroll
        for (int j = 0; j < 4; ++j) v[j] = v[j] + pa[j] * (y[j] * rs);
    }
    if (xout) {
        if (xout_bf) { bf16_t* xo = (bf16_t*)xout + 4 * F.lane;
#pragma unroll
            for (int j = 0; j < 4; ++j) { u32x2 w; w.x = cvt_pk_bf16(v[j].x, v[j].y); w.y = cvt_pk_bf16(v[j].z, v[j].w); *(u32x2*)(xo + 256 * j) = w; } }
        else { f32x4* xo = (f32x4*)(xout) + F.lane;
#pragma unroll
            for (int j = 0; j < 4; ++j) xo[64 * j] = v[j]; } }
    if (Hout) {
        float s = 0.f;
#pragma unroll
        for (int j = 0; j < 4; ++j) s += (v[j].x * v[j].x + v[j].y * v[j].y) + (v[j].z * v[j].z + v[j].w * v[j].w);
        const float rs = rsqrtf(wave_sum(s) * (1.f / 1024.f) + 1e-6f);
#pragma unroll
        for (int j = 0; j < 4; ++j) { const f32x4 h = (v[j] * rs) * pb[j] + psh[j]; hv[j] = h;
            if (ROUTE) *(unsigned*)((unsigned char*)Hout + 4 * F.lane + 256 * j) = cvt4_fp8(h.x, h.y, h.z, h.w, 16.f);
            else { u32x2 w; w.x = cvt_pk_bf16(h.x, h.y); w.y = cvt_pk_bf16(h.z, h.w); *(u32x2*)(Hout + 4 * F.lane + 256 * j) = w; } }
    }
}

template <int MODE_Y, bool ROUTE>
__device__ __forceinline__ void phase_resid_norm(const Frame& F, const KA& P, int lmod_gate, int lmod_norm, const float* xin_lat, const float* xin_ctx, const float* Y, int gate_i, const float* gpost,
                                                 float* xout_lat, float* xout_ctx, const float* gpre, int shift_i, bf16_t* Hout, int nrows, const float* router, int xi_mode = 0, int xo_mode = 0) {
    const float* modv_g = (const float*)(P.ws() + WS_MODV) + (size_t)lmod_gate * 9 * 6144; const float* modv_n = (const float*)(P.ws() + WS_MODV) + (size_t)lmod_norm * 9 * 6144;
    LAS int* lcnt = (LAS int*)F.lds;
    int my_e = 0, my_r0 = 0, my_r1 = 0; float my_g0 = 0.f, my_g1 = 0.f;
    LAS float* rl = (LAS float*)(F.lds + 1024);
    if (ROUTE) { if (F.tid < 16) lcnt[F.tid] = 0;
        for (int i = F.tid; i < 8 * 1024; i += NTHR) rl[(i & 7) * 1024 + (i >> 3)] = router[i];
        __syncthreads(); }
    const int RPW = (nrows + F.NGW - 1) / F.NGW, r0 = F.gw * RPW, r1 = (r0 + RPW < nrows) ? r0 + RPW : nrows;
    int jrow = 0, cur_mod = -1;
    f32x4 pa[4], pb[4], psh[4];
#pragma unroll
    for (int j = 0; j < 4; ++j) { pa[j] = (f32x4){0.f, 0.f, 0.f, 0.f}; pb[j] = pa[j]; psh[j] = pa[j]; }
    const int* toks_c = (const int*)(P.ws() + WS_MOEMETA) + (size_t)ML * 2; const float* tokg_c = (const float*)(P.ws() + WS_MOEMETA) + (size_t)ML * 4;
    int ns0 = 0, ns1 = 0; float ng0 = 0.f, ng1 = 0.f;
    if (MODE_Y == 2 && r0 < r1) { ns0 = toks_c[r0 * 2]; ns1 = toks_c[r0 * 2 + 1]; ng0 = tokg_c[r0 * 2]; ng1 = tokg_c[r0 * 2 + 1]; }
    for (int row = r0; row < r1; ++row, ++jrow) {
        const int cs0 = ns0, cs1 = ns1; const float cg0 = ng0 * (1.f / 32.f), cg1 = ng1 * (1.f / 32.f);
        if (MODE_Y == 2) { const int rn = (row + 1 < r1) ? row + 1 : row; ns0 = toks_c[rn * 2]; ns1 = toks_c[rn * 2 + 1]; ng0 = tokg_c[rn * 2]; ng1 = tokg_c[rn * 2 + 1]; }
        const bool isc = row >= ML; const int modrow = isc ? 8 : row / SEQL;
        if (modrow != cur_mod) { cur_mod = modrow;
            if (MODE_Y != 0) { const f32x4* gt = (const f32x4*)(modv_g + (size_t)modrow * 6144 + gate_i * 1024) + F.lane; const f32x4* gp = (const f32x4*)(gpost) + F.lane;
#pragma unroll
                for (int j = 0; j < 4; ++j) pa[j] = gt[64 * j] * gp[64 * j]; }
            if (Hout) { const f32x4* gp = (const f32x4*)(gpre) + F.lane; const f32x4* sh = (const f32x4*)(modv_n + (size_t)modrow * 6144 + shift_i * 1024) + F.lane; const f32x4* sc = sh + 256;
#pragma unroll
                for (int j = 0; j < 4; ++j) { pb[j] = gp[64 * j] * (sc[64 * j] + 1.0f); psh[j] = sh[64 * j]; } } }
        const unsigned char* xs_row = P.ws() + (row < XS_ROWS_A ? WS_XS_A + (size_t)row * 2048 : WS_XS_B + (size_t)(row - XS_ROWS_A) * 2048);
        const void* xin = isc ? (const void*)(xin_ctx + (size_t)(row - ML) * 1024) : xi_mode == 0 ? (const void*)(xin_lat + (size_t)row * 1024) : xi_mode == 1 ? (const void*)((const unsigned char*)xin_lat + (size_t)row * 2048) : (const void*)xs_row;
        void* xout = isc ? (xout_ctx ? (void*)(xout_ctx + (size_t)(row - ML) * 1024) : nullptr) : !xout_lat ? nullptr : xo_mode == 0 ? (void*)(xout_lat + (size_t)row * 1024) : xo_mode == 1 ? (void*)((unsigned char*)xout_lat + (size_t)row * 2048) : (void*)xs_row;
        const bool xin_bf = !isc && xi_mode != 0, xout_bf = !isc && xo_mode != 0;
        f32x4 hv[4];
        resid_norm_row<MODE_Y, ROUTE>(F, P, row, xin, xin_bf, Y ? (const float*)((const bf16_t*)Y + (size_t)row * 1024) : nullptr, pa, pb, psh, xout, xout_bf, Hout ? Hout + (size_t)row * (ROUTE ? 512 : 1024) : nullptr, hv, cs0, cs1, cg0, cg1);
        if (ROUTE) {
            float lg[8];
#pragma unroll
            for (int e = 0; e < 8; ++e) lg[e] = 0.f;
#pragma unroll
            for (int j = 0; j < 4; ++j)
#pragma unroll
                for (int e = 0; e < 8; ++e) { const f32x4 rv = *(const LAS f32x4*)(rl + e * 1024 + 4 * F.lane + 256 * j);
                    lg[e] += (hv[j].x * rv.x + hv[j].y * rv.y) + (hv[j].z * rv.z + hv[j].w * rv.w); }
#pragma unroll
            for (int e = 0; e < 8; ++e) lg[e] = wave_sum(lg[e]);
            int e0 = 0; float b0 = lg[0];
#pragma unroll
            for (int e = 1; e < 8; ++e) if (lg[e] > b0) { b0 = lg[e]; e0 = e; }
            int e1 = -1; float b1 = -3.0e38f;
#pragma unroll
            for (int e = 0; e < 8; ++e) if (e != e0 && lg[e] > b1) { b1 = lg[e]; e1 = e; }
            const float g0 = 1.0f / (1.0f + __expf(b1 - b0)), g1 = 1.0f - g0;
            int r0 = 0, r1 = 0;
            if (F.lane == 0) { r0 = __hip_atomic_fetch_add(&lcnt[e0], 1, __ATOMIC_RELAXED, __HIP_MEMORY_SCOPE_WORKGROUP); r1 = __hip_atomic_fetch_add(&lcnt[e1], 1, __ATOMIC_RELAXED, __HIP_MEMORY_SCOPE_WORKGROUP); }
            r0 = __builtin_amdgcn_readfirstlane(r0); r1 = __builtin_amdgcn_readfirstlane(r1);
            if (F.lane == jrow) { my_e = e0 | (e1 << 8); my_r0 = r0; my_r1 = r1; my_g0 = g0; my_g1 = g1; }
        }
    }
    if (ROUTE) {
        __syncthreads();
        unsigned* gcnt = (unsigned*)(P.ws() + WS_CTL) + CW_MOECNT;
        if (F.tid < 8) lcnt[8 + F.tid] = (int)atomicAdd(&gcnt[64 * F.tid], (unsigned)lcnt[F.tid]);
        __syncthreads();
        const int row = r0 + F.lane;
        if (F.lane < jrow && row < nrows) {
            int* toke = (int*)(P.ws() + WS_MOEMETA); int* toks = toke + (size_t)ML * 2; float* tokg = (float*)(P.ws() + WS_MOEMETA) + (size_t)ML * 4;
            const int e0 = my_e & 255, e1 = my_e >> 8;
            toke[row * 2] = e0; toke[row * 2 + 1] = e1; toks[row * 2] = my_r0 + lcnt[8 + e0]; toks[row * 2 + 1] = my_r1 + lcnt[8 + e1]; tokg[row * 2] = my_g0; tokg[row * 2 + 1] = my_g1;
        }
        __syncthreads();
    }
}

__device__ __forceinline__ void phase_h8(const Frame& F, const KA& P, int nrows) {
    if (F.bid < 128) return;
    const bf16_t* H = (const bf16_t*)(P.ws() + WS_H); unsigned char* H8 = P.ws() + WS_H8;
    const int nw = (F.G - 128) * NWAVES;
#pragma unroll 4
    for (int row = (F.bid - 128) * NWAVES + F.wave; row < nrows; row += nw) {
        const u32x4* src = (const u32x4*)(H + (size_t)row * 1024) + 2 * F.lane; const u32x4 a = src[0], b = src[1];
        u32x4 o; o.x = cvt4_fp8(bflo(a.x), bfhi(a.x), bflo(a.y), bfhi(a.y), 16.f); o.y = cvt4_fp8(bflo(a.z), bfhi(a.z), bflo(a.w), bfhi(a.w), 16.f);
        o.z = cvt4_fp8(bflo(b.x), bfhi(b.x), bflo(b.y), bfhi(b.y), 16.f); o.w = cvt4_fp8(bflo(b.z), bfhi(b.z), bflo(b.w), bfhi(b.w), 16.f);
        *((u32x4*)(H8 + (size_t)row * 1024) + F.lane) = o;
    }
}

__device__ __forceinline__ void moe_pad_ends(const KA& P, int (&pe)[8]) {
    const unsigned* gcnt = (const unsigned*)(P.ws() + WS_CTL) + CW_MOECNT; int acc = 0;
#pragma unroll
    for (int e = 0; e < 8; ++e) { const int sz = __builtin_amdgcn_readfirstlane((int)__hip_atomic_load(&gcnt[64 * e], __ATOMIC_RELAXED, __HIP_MEMORY_SCOPE_AGENT)); acc += (sz + 255) / 256 * 256; pe[e] = acc; }
}
__device__ __forceinline__ void phase_moe_gather(const Frame& F, const KA& P) {
    int pe[8]; moe_pad_ends(P, pe);
    const int* toke = (const int*)(P.ws() + WS_MOEMETA); int* toks = (int*)(P.ws() + WS_MOEMETA) + (size_t)ML * 2;
    const unsigned char* H = P.ws() + WS_H; unsigned char* XB = P.ws() + WS_XB;
#pragma unroll 4
    for (int row = F.gw; row < ML; row += F.NGW) {
        const u32x4 a = *((const u32x4*)(H + (size_t)row * 1024) + F.lane);
#pragma unroll
        for (int k = 0; k < 2; ++k) {
            const int e = __builtin_amdgcn_readfirstlane(toke[row * 2 + k]); int ps = 0;
#pragma unroll
            for (int j = 1; j < 8; ++j) if (j == e) ps = pe[j - 1];
            const int slot = ps + toks[row * 2 + k];
            *((u32x4*)(XB + (size_t)slot * 1024) + F.lane) = a;
            if (F.lane == 0) toks[row * 2 + k] = slot;
        }
    }
}

__device__ __forceinline__ void phase_hyena_filter_mlp(const Frame& F, const KA& P, int l, int ntok, float* out) {
    LAS float* feats = (LAS float*)F.lds;
    LAS float* h1 = feats + 8 * 36;
    LAS float* h2 = h1 + 8 * 64;
    const float* w1 = P.in(I_HYFW1) + (size_t)l * 33 * 64; const float* b1 = P.in(I_HYFB1) + l * 64; const float* f1 = P.in(I_HYFF1) + l * 64;
    const float* w2 = P.in(I_HYFW2) + (size_t)l * 64 * 64; const float* b2 = P.in(I_HYFB2) + l * 64; const float* f2 = P.in(I_HYFF2) + l * 64;
    const float* w3 = P.in(I_HYFW3) + (size_t)l * 64 * 1024;
    const int pl = F.tid >> 6, j = F.tid & 63;
    const float TWO_PI = 6.283185307179586f;
    for (int u = F.bid; u < ntok / 8; u += F.G) {
        const int pos = u * 8 + pl; const float t = (float)pos / (float)(ntok - 1); const float w = (TWO_PI / (float)ntok) * (float)pos;
        if (j < 33) { float v;
            if (j == 0) v = t;
            else { const int b = (j - 1) & 15; const float f = 1e-4f + (float)b * ((15.0f - 1e-4f) / 15.0f); const float a = f * w; v = (j <= 16) ? cosf(a) : -sinf(a); }
            feats[pl * 36 + j] = v; }
        __syncthreads();
        { float s = b1[j];
          for (int i = 0; i < 33; ++i) s += feats[pl * 36 + i] * w1[i * 64 + j];
          h1[pl * 64 + j] = sinf(f1[j] * s); }
        __syncthreads();
        { float s = b2[j];
          for (int i = 0; i < 64; ++i) s += h1[pl * 64 + i] * w2[i * 64 + j];
          h2[pl * 64 + j] = sinf(f2[j] * s); }
        __syncthreads();
#pragma unroll
        for (int half = 0; half < 2; ++half) {
            const int oc = F.tid + 512 * half;
            float a[8];
#pragma unroll
            for (int p = 0; p < 8; ++p) a[p] = 0.f;
#pragma unroll 1
            for (int i0 = 0; i0 < 64; i0 += 16) { float wv[16];
#pragma unroll
                for (int k = 0; k < 16; ++k) wv[k] = w3[(i0 + k) * 1024 + oc];
#pragma unroll
                for (int k = 0; k < 16; ++k)
#pragma unroll
                    for (int p = 0; p < 8; ++p) a[p] += h2[p * 64 + i0 + k] * wv[k]; }
            const int ch = oc & 255; const float ra = -15.350567286626973f, rb = -3.0701134573253946f;
            const float rate = fabsf(ra + (float)ch * ((rb - ra) / 255.0f));
            float* o = out + (size_t)oc * ntok + u * 8;
#pragma unroll
            for (int p = 0; p < 8; ++p) { const float tt = (float)(u * 8 + p) / (float)(ntok - 1); o[p] = a[p] * __expf(-tt * rate); }
        }
        __syncthreads();
    }
}

constexpr int FN = 8192;
__device__ __forceinline__ f32x2 cmul(f32x2 a, f32x2 b) { return (f32x2){a.x * b.x - a.y * b.y, a.x * b.y + a.y * b.x}; }
__device__ __forceinline__ f32x2 cmulc(f32x2 a, f32x2 b) { return (f32x2){a.x * b.x + a.y * b.y, a.y * b.x - a.x * b.y}; }
__device__ __forceinline__ void fft_make_twiddles(LAS f32x2* TW, int tid) {
    for (int k = tid; k < FN / 2; k += NTHR) {
        const int q = k >> 10, r = k & 1023; const float a = (float)r * (6.283185307179586f / 8192.0f);
        const float a2 = a * a;
        const float s = a + a * a2 * (-1.6666654611e-1f + a2 * (8.3321608736e-3f + a2 * (-1.9515295891e-4f)));
        const float c = 1.0f - 0.5f * a2 + a2 * a2 * (4.166664568298827e-2f + a2 * (-1.388731625493765e-3f + a2 * 2.443315711809948e-5f));
        const float R = 0.70710678118654752f;
        float cr, sr;
        if (q == 0) { cr = c; sr = s; } else if (q == 1) { cr = R * (c - s); sr = R * (c + s); } else if (q == 2) { cr = -s; sr = c; } else { cr = -R * (c + s); sr = R * (c - s); }
        TW[k] = (f32x2){cr, -sr};
        if ((k & 15) == 0 && k < 512) TW[FN / 2 + (k >> 4)] = (f32x2){cr, -sr};
    }
}
__device__ __forceinline__ void pw16(const f32x2 w, f32x2 (&p)[16]) {
    p[0] = (f32x2){1.f, 0.f}; p[1] = w; p[2] = cmul(w, w); p[4] = cmul(p[2], p[2]); p[8] = cmul(p[4], p[4]);
    p[3] = cmul(p[2], w); p[5] = cmul(p[4], w); p[6] = cmul(p[4], p[2]); p[7] = cmul(p[4], p[3]);
#pragma unroll
    for (int k = 1; k < 8; ++k) p[8 + k] = cmul(p[8], p[k]);
}
#define XI(e) ((e) + ((e) >> 5))
constexpr int FFT_X_BYTES = (FN + FN / 32) * 8;
__device__ __forceinline__ f32x2 tw_get(const LAS f32x2* TW, int idx) { const f32x2 w = TW[idx & (FN / 2 - 1)]; return (idx & (FN / 2)) ? (f32x2){-w.x, -w.y} : w; }
template <int K> __device__ __forceinline__ f32x2 w16c() {
    constexpr float c[8] = {1.f, 0.92387953251f, 0.70710678119f, 0.38268343237f, 0.f, -0.38268343237f, -0.70710678119f, -0.92387953251f};
    constexpr float s[8] = {0.f, -0.38268343237f, -0.70710678119f, -0.92387953251f, -1.f, -0.92387953251f, -0.70710678119f, -0.38268343237f};
    return (f32x2){c[K], s[K]}; }
template <int H, int B, int J> __device__ __forceinline__ void bf_dif(f32x2 (&x)[16]) { const f32x2 a = x[B + J], c = x[B + J + H]; x[B + J] = a + c; x[B + J + H] = cmul(a - c, w16c<J * (8 / H)>()); }
template <int H, int B, int J> __device__ __forceinline__ void bf_dit(f32x2 (&x)[16]) { const f32x2 a = x[B + J], c = cmulc(x[B + J + H], w16c<J * (8 / H)>()); x[B + J] = a + c; x[B + J + H] = a - c; }
template <int H, int B, int J> struct Bf16Loop {
    static __device__ __forceinline__ void dif(f32x2 (&x)[16]) { bf_dif<H, B, J>(x); if constexpr (J + 1 < H) Bf16Loop<H, B, J + 1>::dif(x); else if constexpr (B + 2 * H < 16) Bf16Loop<H, B + 2 * H, 0>::dif(x); }
    static __device__ __forceinline__ void dit(f32x2 (&x)[16]) { bf_dit<H, B, J>(x); if constexpr (J + 1 < H) Bf16Loop<H, B, J + 1>::dit(x); else if constexpr (B + 2 * H < 16) Bf16Loop<H, B + 2 * H, 0>::dit(x); }
};
__device__ __forceinline__ void dif16(f32x2 (&x)[16]) { Bf16Loop<8, 0, 0>::dif(x); Bf16Loop<4, 0, 0>::dif(x); Bf16Loop<2, 0, 0>::dif(x); Bf16Loop<1, 0, 0>::dif(x); }
__device__ __forceinline__ void dit16(f32x2 (&x)[16]) { Bf16Loop<1, 0, 0>::dit(x); Bf16Loop<2, 0, 0>::dit(x); Bf16Loop<4, 0, 0>::dit(x); Bf16Loop<8, 0, 0>::dit(x); }
__device__ __forceinline__ constexpr int rev4(int r) { return ((r & 1) << 3) | ((r & 2) << 1) | ((r & 4) >> 1) | ((r & 8) >> 3); }
__device__ __forceinline__ void fft_dif(LAS f32x2* X, const LAS f32x2* TW, int tid) {
    f32x2 x[16];
#pragma unroll
    for (int j = 0; j < 16; ++j) x[j] = X[XI(tid + 512 * j)];
    dif16(x);
    { f32x2 pw[16]; pw16(TW[tid], pw);
#pragma unroll
      for (int r = 1; r < 16; ++r) x[r] = cmul(x[r], pw[rev4(r)]); }
#pragma unroll
    for (int r = 0; r < 16; ++r) X[XI(tid + 512 * r)] = x[r];
    __syncthreads();
    { const int base = (tid >> 5) * 512 + (tid & 31), ip = tid & 31;
#pragma unroll
      for (int j = 0; j < 16; ++j) x[j] = X[XI(base + 32 * j)];
      dif16(x);
      { f32x2 pw[16]; pw16(TW[FN / 2 + ip], pw);
#pragma unroll
        for (int r = 1; r < 16; ++r) x[r] = cmul(x[r], pw[rev4(r)]); }
#pragma unroll
      for (int r = 0; r < 16; ++r) X[XI(base + 32 * r)] = x[r]; }
    __syncthreads();
    if (tid < 256) { const int base = 33 * tid;
        f32x2 y[16];
#pragma unroll
        for (int j = 0; j < 16; ++j) { const f32x2 a = X[base + j], c = X[base + 16 + j]; x[j] = a + c; y[j] = cmul(a - c, tw_get(TW, 256 * j)); }
        dif16(x); dif16(y);
#pragma unroll
        for (int j = 0; j < 16; ++j) { X[base + j] = x[j]; X[base + 16 + j] = y[j]; } }
    __syncthreads();
}
__device__ __forceinline__ void fft_dit_inv(LAS f32x2* X, const LAS f32x2* TW, int tid) {
    f32x2 x[16];
    if (tid < 256) { const int base = 33 * tid; f32x2 y[16];
#pragma unroll
        for (int j = 0; j < 16; ++j) { x[j] = X[base + j]; y[j] = X[base + 16 + j]; }
        dit16(x); dit16(y);
#pragma unroll
        for (int j = 0; j < 16; ++j) { const f32x2 c = cmulc(y[j], tw_get(TW, 256 * j)); X[base + j] = x[j] + c; X[base + 16 + j] = x[j] - c; } }
    __syncthreads();
    { const int base = (tid >> 5) * 512 + (tid & 31), ip = tid & 31;
#pragma unroll
      for (int r = 0; r < 16; ++r) x[r] = X[XI(base + 32 * r)];
      { f32x2 pw[16]; pw16(TW[FN / 2 + ip], pw);
#pragma unroll
        for (int r = 1; r < 16; ++r) x[r] = cmulc(x[r], pw[rev4(r)]); }
      dit16(x);
#pragma unroll
      for (int j = 0; j < 16; ++j) X[XI(base + 32 * j)] = x[j]; }
    __syncthreads();
#pragma unroll
    for (int r = 0; r < 16; ++r) x[r] = X[XI(tid + 512 * r)];
    { f32x2 pw[16]; pw16(TW[tid], pw);
#pragma unroll
      for (int r = 1; r < 16; ++r) x[r] = cmulc(x[r], pw[rev4(r)]); }
    dit16(x);
#pragma unroll
    for (int j = 0; j < 16; ++j) X[XI(tid + 512 * j)] = x[j];
    __syncthreads();
}

__device__ __forceinline__ void phase_hyena_filter_fft(const Frame& F, const KA& P) {
    LAS f32x2* X = (LAS f32x2*)F.lds; LAS f32x2* TW = (LAS f32x2*)(F.lds + FFT_X_BYTES);
    fft_make_twiddles(TW, F.tid);
    const float* hf = (const float*)(P.ws() + WS_HFILT); f32x2* KS = (f32x2*)(P.ws() + WS_KSPEC);
    for (int u = F.bid; u < 512; u += F.G) {
        const int o = u >> 8, ch = u & 255;
        const float* fw = hf + ((size_t)(o * 2 + 0) * 256 + ch) * 4096; const float* bw = hf + ((size_t)(o * 2 + 1) * 256 + ch) * 4096;
        __syncthreads();
        { float fv[8], bv[8];
#pragma unroll
          for (int k = 0; k < 8; ++k) { const int i = F.tid + NTHR * k; fv[k] = fw[i]; bv[k] = bw[i == 0 ? 0 : 4096 - i]; }
#pragma unroll
          for (int k = 0; k < 8; ++k) { const int i = F.tid + NTHR * k; X[XI(i)] = (f32x2){fv[k], 0.f}; X[XI(4096 + i)] = (f32x2){i == 0 ? 0.f : bv[k], 0.f}; } }
        __syncthreads();
        fft_dif(X, TW, F.tid);
        for (int i = F.tid; i < FN; i += NTHR) KS[(size_t)u * FN + i] = X[XI(i)];
    }
    __syncthreads();
}

__device__ __forceinline__ void phase_hyena_transpose_in(const Frame& F, const KA& P, int l) {
    constexpr int LD = 768;
    LAS bf16_t* T = (LAS bf16_t*)F.lds;
    const bf16_t* HY = (const bf16_t*)(P.ws() + WS_HY); bf16_t* HYT = (bf16_t*)(P.ws() + WS_HYT);
    const float* cw = P.in(I_HYCONVW) + (size_t)l * 3 * 768; const float* cb = P.in(I_HYCONVB) + (size_t)l * 768;
    LAS float* WL = (LAS float*)(F.lds + 64 * LD * 2);
    for (int i = F.tid; i < 4 * 768; i += NTHR) WL[i] = (i < 3 * 768) ? cw[i] : cb[i - 3 * 768];
    for (int u = F.bid; u < NBATCH * 64; u += F.G) {
        const int b = u >> 6, gr = u & 63; const size_t row0 = (size_t)b * SEQL + gr * 64;
        __syncthreads();
        { u32x4 tv[12];
#pragma unroll
          for (int k = 0; k < 12; ++k) { const int i = F.tid + NTHR * k, t = i / 96, c8 = i % 96; tv[k] = *(const u32x4*)(HY + (row0 + t) * 768 + c8 * 8); }
#pragma unroll
          for (int k = 0; k < 12; ++k) { const int i = F.tid + NTHR * k, t = i / 96, c8 = i % 96; *(LAS u32x4*)(T + t * LD + ((c8 ^ ((t >> 3) & 7)) * 8)) = tv[k]; } }
        __syncthreads();
#pragma unroll 2
        for (int i = F.tid; i < 768 * 8; i += NTHR) {
            const int piece = i & 7, c = i >> 3, t0 = piece * 8;
            const float w0 = WL[c], w1 = WL[768 + c], w2 = WL[1536 + c], bb = WL[2304 + c];
            float x[10];
#pragma unroll
            for (int k = 0; k < 10; ++k) { const int t = t0 - 1 + k; x[k] = (t >= 0 && t < 64) ? bf2f(T[t * LD + ((((c >> 3) ^ ((t >> 3) & 7)) << 3) | (c & 7))]) : 0.f; }
            float y[8];
#pragma unroll
            for (int k = 0; k < 8; ++k) y[k] = w0 * x[k] + w1 * x[k + 1] + w2 * x[k + 2] + bb;
            u32x4 o; o.x = cvt_pk_bf16(y[0], y[1]); o.y = cvt_pk_bf16(y[2], y[3]); o.z = cvt_pk_bf16(y[4], y[5]); o.w = cvt_pk_bf16(y[6], y[7]);
            *(u32x4*)(HYT + ((size_t)b * 768 + c) * SEQL + gr * 64 + t0) = o;
        }
    }
    __syncthreads();
}
__device__ __forceinline__ void phase_hyena_transpose_out(const Frame& F, const KA& P) {
    constexpr int LD = 72;
    LAS bf16_t* T = (LAS bf16_t*)F.lds;
    const bf16_t* HYOT = (const bf16_t*)(P.ws() + WS_HYOT); bf16_t* HYOUT = (bf16_t*)(P.ws() + WS_HYOUT);
    for (int u = F.bid; u < NBATCH * 64; u += F.G) {
        const int b = u >> 6, gr = u & 63;
        __syncthreads();
        { u32x4 tv[4];
#pragma unroll
          for (int k = 0; k < 4; ++k) { const int i = F.tid + NTHR * k, ch = i >> 3, p = i & 7; tv[k] = *(const u32x4*)(HYOT + ((size_t)b * 256 + ch) * SEQL + gr * 64 + p * 8); }
#pragma unroll
          for (int k = 0; k < 4; ++k) { const int i = F.tid + NTHR * k, ch = i >> 3, p = i & 7; *(LAS u32x4*)(T + ch * LD + p * 8) = tv[k]; } }
        __syncthreads();
        for (int i = F.tid; i < 64 * 32; i += NTHR) { const int t = i & 63, c8 = i >> 6;
            unsigned w[4];
#pragma unroll
            for (int k = 0; k < 4; ++k) w[k] = (unsigned)T[(c8 * 8 + 2 * k) * LD + t] | ((unsigned)T[(c8 * 8 + 2 * k + 1) * LD + t] << 16);
            *(u32x4*)(HYOUT + ((size_t)b * SEQL + gr * 64 + t) * 256 + c8 * 8) = (u32x4){w[0], w[1], w[2], w[3]}; }
    }
    __syncthreads();
}

__device__ __forceinline__ void phase_hyena_main(const Frame& F, const KA& P, int l) {
    LAS f32x2* X = (LAS f32x2*)F.lds; LAS f32x2* TW = (LAS f32x2*)(F.lds + FFT_X_BYTES);
    fft_make_twiddles(TW, F.tid);
    const bf16_t* HYT = (const bf16_t*)(P.ws() + WS_HYT); bf16_t* HYOT = (bf16_t*)(P.ws() + WS_HYOT); const f32x2* KS = (const f32x2*)(P.ws() + WS_KSPEC);
    const float inv = 1.0f / (float)FN;
    const int t0 = F.tid * 8;
    for (int u = F.bid; u < 4 * 256; u += F.G) {
        const int bp = u >> 8, ch = u & 255, b0 = 2 * bp, b1 = 2 * bp + 1;
        const float bias0 = __int_as_float(__builtin_amdgcn_readfirstlane(__float_as_int(P.in(I_HYBIAS)[(size_t)l * 512 + ch])));
        const float bias1 = __int_as_float(__builtin_amdgcn_readfirstlane(__float_as_int(P.in(I_HYBIAS)[(size_t)l * 512 + 256 + ch])));
        const bf16_t* r0 = HYT + ((size_t)b0 * 768 + ch) * SEQL + t0; const bf16_t* r1 = HYT + ((size_t)b1 * 768 + ch) * SEQL + t0;
        f32x4 va0, va1, vb0, vb1;
        const u32x4 gx1a = *(const u32x4*)(r0 + (size_t)256 * SEQL), gx1b = *(const u32x4*)(r1 + (size_t)256 * SEQL);
        unpack8(*(const u32x4*)(r0), va0, va1); unpack8(*(const u32x4*)(r1), vb0, vb1);
        f32x2 ksv[16];
        { const f32x2* ks = KS + (size_t)(0 * 256 + ch) * FN;
#pragma unroll
          for (int k = 0; k < 16; ++k) ksv[k] = ks[F.tid + NTHR * k]; }
        __syncthreads();
#pragma unroll
        for (int k = 0; k < 4; ++k) { X[XI(t0 + k)] = (f32x2){va0[k], vb0[k]}; X[XI(t0 + 4 + k)] = (f32x2){va1[k], vb1[k]}; }
#pragma unroll
        for (int k = 0; k < 8; ++k) X[XI(4096 + t0 + k)] = (f32x2){0.f, 0.f};
        __syncthreads();
        fft_dif(X, TW, F.tid);
#pragma unroll
        for (int k = 0; k < 16; ++k) { const int i = F.tid + NTHR * k; X[XI(i)] = cmul(X[XI(i)], ksv[k]) * inv; }
        { const f32x2* ks = KS + (size_t)(1 * 256 + ch) * FN;
#pragma unroll
          for (int k = 0; k < 16; ++k) ksv[k] = ks[F.tid + NTHR * k]; }
        __syncthreads();
        fft_dit_inv(X, TW, F.tid);
        f32x4 za0, za1, zb0, zb1;
        { f32x4 xa0, xa1, xb0, xb1; unpack8(gx1a, xa0, xa1); unpack8(gx1b, xb0, xb1);
#pragma unroll
          for (int k = 0; k < 4; ++k) { const f32x2 y = X[XI(t0 + k)], y2 = X[XI(t0 + 4 + k)];
              za0[k] = xa0[k] * fmaf(va0[k], bias0, y.x); zb0[k] = xb0[k] * fmaf(vb0[k], bias0, y.y);
              za1[k] = xa1[k] * fmaf(va1[k], bias0, y2.x); zb1[k] = xb1[k] * fmaf(vb1[k], bias0, y2.y); } }
        const u32x4 gx2a = *(const u32x4*)(r0 + (size_t)512 * SEQL), gx2b = *(const u32x4*)(r1 + (size_t)512 * SEQL);
        __syncthreads();
#pragma unroll
        for (int k = 0; k < 4; ++k) { X[XI(t0 + k)] = (f32x2){za0[k], zb0[k]}; X[XI(t0 + 4 + k)] = (f32x2){za1[k], zb1[k]}; }
#pragma unroll
        for (int k = 0; k < 8; ++k) X[XI(4096 + t0 + k)] = (f32x2){0.f, 0.f};
        __syncthreads();
        fft_dif(X, TW, F.tid);
#pragma unroll
        for (int k = 0; k < 16; ++k) { const int i = F.tid + NTHR * k; X[XI(i)] = cmul(X[XI(i)], ksv[k]) * inv; }
        __syncthreads();
        fft_dit_inv(X, TW, F.tid);
        { f32x4 xa0, xa1, xb0, xb1; unpack8(gx2a, xa0, xa1); unpack8(gx2b, xb0, xb1);
          f32x4 oa0, oa1, ob0, ob1;
#pragma unroll
          for (int k = 0; k < 4; ++k) { const f32x2 y = X[XI(t0 + k)], y2 = X[XI(t0 + 4 + k)];
              oa0[k] = xa0[k] * fmaf(za0[k], bias1, y.x); ob0[k] = xb0[k] * fmaf(zb0[k], bias1, y.y);
              oa1[k] = xa1[k] * fmaf(za1[k], bias1, y2.x); ob1[k] = xb1[k] * fmaf(zb1[k], bias1, y2.y); }
          *(u32x4*)(HYOT + ((size_t)b0 * 256 + ch) * SEQL + t0) = pack8(oa0, oa1); *(u32x4*)(HYOT + ((size_t)b1 * 256 + ch) * SEQL + t0) = pack8(ob0, ob1); }
    }
    __syncthreads();
}
__device__ __forceinline__ void phase_hyena_ctx(const Frame& F, const KA& P, int l) {
    LAS float* Z = (LAS float*)F.lds;
    const int half = F.tid >> 8, t = F.tid & 255;
    LAS float* z = Z + half * 2048; LAS float* gf = z + 256;
    const bf16_t* HY = (const bf16_t*)(P.ws() + WS_HY); bf16_t* HYOUT = (bf16_t*)(P.ws() + WS_HYOUT);
    const float* hfc = (const float*)(P.ws() + WS_HFILTC);
    const float* cw = P.in(I_HYCONVW) + (size_t)l * 3 * 768; const float* cb = P.in(I_HYCONVB) + (size_t)l * 768;
    for (int u0 = F.bid * 2; u0 < NBATCH * 256; u0 += F.G * 2) {
        const int u = u0 + half, b = u >> 8, ch = u & 255; const size_t row0 = (size_t)ML + b * CTXL;
        float s[3];
#pragma unroll
        for (int k = 0; k < 3; ++k) { const int c = k * 256 + ch; float a = cb[c];
#pragma unroll
            for (int j = 0; j < 3; ++j) { const int tt = t - 1 + j; if (tt >= 0 && tt < CTXL) a += cw[j * 768 + c] * bf2f(HY[(row0 + tt) * 768 + c]); }
            s[k] = a; }
        float zc = s[0];
#pragma unroll
        for (int o = 0; o < 2; ++o) {
            __syncthreads();
            z[t] = zc; gf[255 + t] = hfc[((size_t)(o * 2 + 0) * 256 + ch) * 256 + t]; if (t > 0) gf[255 - t] = hfc[((size_t)(o * 2 + 1) * 256 + ch) * 256 + t];
            __syncthreads();
            float y0 = 0.f, y1 = 0.f, y2 = 0.f, y3 = 0.f; const LAS float* gp = gf + 255 + t;
#pragma unroll 8
            for (int q = 0; q < CTXL; q += 4) { const f32x4 z4 = *(const LAS f32x4*)(z + q);
                y0 += gp[-q] * z4.x; y1 += gp[-q - 1] * z4.y; y2 += gp[-q - 2] * z4.z; y3 += gp[-q - 3] * z4.w; }
            const float y = (y0 + y1) + (y2 + y3);
            const float bias = P.in(I_HYBIAS)[(size_t)l * 512 + o * 256 + ch];
            zc = s[1 + o] * (y + zc * bias);
        }
        HYOUT[(row0 + t) * 256 + ch] = f2bf(zc);
    }
    __syncthreads();
}

__device__ __forceinline__ int chain_row(int b, int d, int c) {
    if (c < 4) { const int j = d ? 3 - c : c; return ML + b * CTXL + 64 * j; }
    const int j = d ? 67 - c : c - 4; return b * SEQL + 64 * j;
}
__device__ __forceinline__ void ld8bf(const bf16_t* p, float (&o)[8]) { const u32x4 w = *(const u32x4*)p; o[0] = bflo(w.x); o[1] = bfhi(w.x); o[2] = bflo(w.y); o[3] = bfhi(w.y); o[4] = bflo(w.z); o[5] = bfhi(w.z); o[6] = bflo(w.w); o[7] = bfhi(w.w); }
__device__ __forceinline__ void ld8f(const float* p, float (&o)[8]) { const f32x4 a = *(const f32x4*)p, b = *(const f32x4*)(p + 4); o[0] = a.x; o[1] = a.y; o[2] = a.z; o[3] = a.w; o[4] = b.x; o[5] = b.y; o[6] = b.z; o[7] = b.w; }
__device__ __forceinline__ void lds_ld8(const LAS float* p, float (&o)[8]) { const f32x4 a = *(const LAS f32x4*)p, b = *(const LAS f32x4*)(p + 4); o[0] = a.x; o[1] = a.y; o[2] = a.z; o[3] = a.w; o[4] = b.x; o[5] = b.y; o[6] = b.z; o[7] = b.w; }
__device__ __forceinline__ void lds_st8(LAS float* p, const float (&o)[8]) { *(LAS f32x4*)p = (f32x4){o[0], o[1], o[2], o[3]}; *(LAS f32x4*)(p + 4) = (f32x4){o[4], o[5], o[6], o[7]}; }
#define WAVE_LDS_SYNC() do { asm volatile("s_waitcnt lgkmcnt(0)" ::: "memory"); } while (0)

__device__ __forceinline__ float gelu_as(float v) {
    const float t = __builtin_amdgcn_rcpf(fabsf(v) * 0.2316418882f + 1.0f);
    float q = t * 0.5307027145f + (-0.7265760135f); q = q * t + 0.7107068705f; q = q * t + (-0.142248368f); q = q * t + 0.127414796f; q = q * t;
    const float m = v * (q * __builtin_amdgcn_exp2f((v * v) * (-0.72134752044f)));
    return v < 0.f ? m : v - m;
}
typedef float f32x16s __attribute__((ext_vector_type(16)));
constexpr int HBP = 68;
struct S5Tab { float ar, ai; u32x4 bfr[4], cf[4]; };
template <bool OUT>
__device__ __forceinline__ void s5_tab_load(S5Tab& t, const KA& P, int l, int d, int g, int lane) {
    const int ldg = (l * 2 + d) * 16 + g, r = lane & 31, hb = lane >> 5;
    const float* tab = (const float*)(P.ws() + WS_S5TAB) + (size_t)ldg * 2304;
    t.ar = tab[lane]; t.ai = tab[64 + lane];
    const bf16_t* T2 = (const bf16_t*)(P.ws() + WS_S5TAB2) + (size_t)ldg * 4096;
#pragma unroll
    for (int tn = 0; tn < 4; ++tn) t.bfr[tn] = *(const u32x4*)(T2 + (32 * tn + r) * 16 + 8 * hb);
#pragma unroll
    for (int q = 0; q < 4; ++q) t.cf[q] = OUT ? *(const u32x4*)(T2 + 2048 + (lane & 15) * 128 + 32 * q + 8 * (lane >> 4)) : (u32x4){0u, 0u, 0u, 0u};
}
template <bool OUT>
__device__ __forceinline__ void s5_task(const S5Tab& t, const KA& P, int d, int g, int rowbase, float& hr, float& hi, LAS unsigned* HB, LAS float* yt, int lane) {
    const int r = lane & 31, hb = lane >> 5, p = lane;
    const float ar = t.ar, ai = t.ai;
    const bf16_t* U = (const bf16_t*)(P.ws() + WS_U);
#pragma unroll 1
    for (int hf = 0; hf < 2; ++hf) {
        const int sr = 32 * hf + r, tr = d ? 63 - sr : sr;
        const u32x4 afr = *(const u32x4*)(U + (size_t)(rowbase + tr) * 256 + g * 16 + 8 * hb);
        f32x16s acc[4];
#pragma unroll
        for (int tn = 0; tn < 4; ++tn) {
#pragma unroll
            for (int i = 0; i < 16; ++i) acc[tn][i] = 0.f;
            acc[tn] = __builtin_amdgcn_mfma_f32_32x32x16_bf16(__builtin_bit_cast(bf16x8, afr), __builtin_bit_cast(bf16x8, t.bfr[tn]), acc[tn], 0, 0, 0); }
        asm volatile("s_waitcnt lgkmcnt(0)" ::: "memory");
#pragma unroll
        for (int i = 0; i < 16; ++i) { const int s = 8 * (i >> 2) + 4 * hb + (i & 3);
            HB[s * HBP + r] = cvt_pk_bf16(acc[0][i], acc[2][i]); HB[s * HBP + 32 + r] = cvt_pk_bf16(acc[1][i], acc[3][i]); }
        asm volatile("s_waitcnt lgkmcnt(0)" ::: "memory");
#pragma unroll 8
        for (int s = 0; s < 32; ++s) { const unsigned w = HB[s * HBP + p];
            const float nr = ar * hr - ai * hi + bflo(w), ni = ar * hi + ai * hr + bfhi(w); hr = nr; hi = ni;
            if (OUT) HB[s * HBP + p] = cvt_pk_bf16(hr, hi); }
        if (OUT) {
            asm volatile("s_waitcnt lgkmcnt(0)" ::: "memory");
#pragma unroll
            for (int tm = 0; tm < 2; ++tm) { f32x4 y = (f32x4){0.f, 0.f, 0.f, 0.f};
#pragma unroll
                for (int q = 0; q < 4; ++q) y = __builtin_amdgcn_mfma_f32_16x16x32_bf16(__builtin_bit_cast(bf16x8, *(const LAS u32x4*)(HB + (16 * tm + (lane & 15)) * HBP + 16 * q + 4 * (lane >> 4))), __builtin_bit_cast(bf16x8, t.cf[q]), y, 0, 0, 0);
#pragma unroll
                for (int j = 0; j < 4; ++j) { const int s = 32 * hf + 16 * tm + 4 * (lane >> 4) + j, t = d ? 63 - s : s;
                    yt[t * 68 + (g & 3) * 16 + (lane & 15)] = y[j]; } }
        }
    }
}
__device__ __forceinline__ void phase_s5_local(const Frame& F, const KA& P, int l) {
    f32x2* E = (f32x2*)(P.ws() + WS_E);
    LAS unsigned* HB = (LAS unsigned*)(F.lds + F.wave * (32 * HBP * 4));
    const int dg = F.gw & 31, d = dg >> 4, g = dg & 15;
    S5Tab tb; s5_tab_load<false>(tb, P, l, d, g, fresh_lane());
    for (int bc = F.gw >> 5; bc < NBATCH * NCHAIN; bc += F.NGW >> 5) {
        const int lane = fresh_lane();
        const int c = bc % NCHAIN, b = bc / NCHAIN;
        float hr = 0.f, hi = 0.f;
        s5_task<false>(tb, P, d, g, chain_row(b, d, c), hr, hi, HB, nullptr, lane);
        E[((size_t)(((b * 2 + d) * 16 + g) * NCHAIN + c)) * 64 + lane] = (f32x2){hr, hi};
    }
    __syncthreads();
}
__device__ __forceinline__ void phase_s5_carry(const Frame& F, const KA& P, int l) {
    const f32x2* E = (const f32x2*)(P.ws() + WS_E); f32x2* CIN = (f32x2*)(P.ws() + WS_CIN);
    LAS f32x2* XS = (LAS f32x2*)F.lds;
    const int p = F.lane, w = F.wave, n = (w < 4) ? 9 : 8, c0 = (w < 4) ? 9 * w : 36 + 8 * (w - 4);
    for (int bdg = F.bid; bdg < NBATCH * 32; bdg += F.G) {
        const int d = (bdg >> 4) & 1, g = bdg & 15;
        const float* tab = (const float*)(P.ws() + WS_S5TAB) + (size_t)((l * 2 + d) * 16 + g) * 2304;
        const float tr = tab[128 + p], ti = tab[192 + p];
        f32x2 e[9];
#pragma unroll
        for (int k = 0; k < 9; ++k) { const int c = (c0 + k < NCHAIN) ? c0 + k : NCHAIN - 1; e[k] = E[((size_t)bdg * NCHAIN + c) * 64 + p]; }
        float lr[9], li[9]; float cr = 0.f, ci = 0.f;
#pragma unroll
        for (int k = 0; k < 9; ++k) { lr[k] = cr; li[k] = ci;
            if (k < n) { const float nr = tr * cr - ti * ci + e[k].x, ni = tr * ci + ti * cr + e[k].y; cr = nr; ci = ni; } }
        __syncthreads();
        XS[w * 64 + p] = (f32x2){cr, ci};
        __syncthreads();
        const float t2r = tr * tr - ti * ti, t2i = 2.f * tr * ti, t4r = t2r * t2r - t2i * t2i, t4i = 2.f * t2r * t2i, t8r = t4r * t4r - t4i * t4i, t8i = 2.f * t4r * t4i;
        const float t9r = t8r * tr - t8i * ti, t9i = t8r * ti + t8i * tr;
        float hr = 0.f, hi = 0.f;
#pragma unroll
        for (int v = 0; v < 7; ++v) if (v < w) { const float ar = (v < 4) ? t9r : t8r, ai = (v < 4) ? t9i : t8i; const f32x2 bv = XS[v * 64 + p];
            const float nr = ar * hr - ai * hi + bv.x, ni = ar * hi + ai * hr + bv.y; hr = nr; hi = ni; }
        float pr = hr, pi = hi;
#pragma unroll
        for (int k = 0; k < 9; ++k) if (k < n) { CIN[((size_t)bdg * NCHAIN + c0 + k) * 64 + p] = (f32x2){pr + lr[k], pi + li[k]};
            const float nr = tr * pr - ti * pi, ni = tr * pi + ti * pr; pr = nr; pi = ni; }
    }
}
__device__ __forceinline__ void phase_s5_out(const Frame& F, const KA& P, int l) {
    LAS unsigned* HB = (LAS unsigned*)(F.lds + F.wave * (32 * HBP * 4));
    LAS float* yt2 = (LAS float*)(F.lds + 8 * (32 * HBP * 4));
    const bf16_t* U = (const bf16_t*)(P.ws() + WS_U); const f32x2* CIN = (const f32x2*)(P.ws() + WS_CIN); bf16_t* YPRE = (bf16_t*)(P.ws() + WS_YPRE);
    const int d = F.wave & 1;
    const int gq = F.bid & 3, g = gq * 4 + (F.wave >> 1);
    S5Tab tb; s5_tab_load<true>(tb, P, l, d, g, fresh_lane());
    for (int bt = F.bid >> 2; bt < NBATCH * NCHAIN; bt += F.G >> 2) {
        const int lane = fresh_lane(), tid = F.wave * 64 + lane;
        const int tc = bt % NCHAIN, b = bt / NCHAIN;
        const bool isc = tc < 4; const int j = isc ? tc : tc - 4; const int rowbase = isc ? ML + b * CTXL + 64 * j : b * SEQL + 64 * j;
        const int c = isc ? (d ? 3 - j : j) : (d ? 67 - j : 4 + j);
        __syncthreads();
        const f32x2 h0 = CIN[((size_t)(((b * 2 + d) * 16 + g) * NCHAIN + c)) * 64 + lane];
        float hr = h0.x, hi = h0.y;
        const int ft = tid >> 3, fcs = tid & 7;
        const u32x4 fu = *(const u32x4*)(U + (size_t)(rowbase + ft) * 256 + gq * 64 + fcs * 8);
        float Dv[8]; ld8f(P.in(I_S5D) + (size_t)l * 256 + gq * 64 + fcs * 8, Dv);
        __syncthreads();
        s5_task<true>(tb, P, d, g, rowbase, hr, hi, HB, yt2 + d * (64 * 68), lane);
        __syncthreads();
        { const int t = ft, cs = fcs;
          f32x4 u0, u1; unpack8(fu, u0, u1);
          f32x4 y0, y1;
#pragma unroll
          for (int k = 0; k < 4; ++k) { float a = yt2[t * 68 + cs * 8 + k] + yt2[64 * 68 + t * 68 + cs * 8 + k] + Dv[k] * u0[k], bq = yt2[t * 68 + cs * 8 + 4 + k] + yt2[64 * 68 + t * 68 + cs * 8 + 4 + k] + Dv[4 + k] * u1[k];
              y0[k] = gelu_as(a); y1[k] = gelu_as(bq); }
          *(u32x4*)(YPRE + (size_t)(rowbase + t) * 256 + gq * 64 + cs * 8) = pack8(y0, y1); }
    }
    __syncthreads();
}

__device__ __forceinline__ float softplusf_(float x) { return fmaxf(x, 0.f) + log1pf(__expf(-fabsf(x))); }
__device__ __forceinline__ void conv8(const bf16_t* X, int ld, size_t row, int col, bool lo, bool hi, const float* cw, int cwld, float (&y)[8]) {
    float x0[8], xm[8], xp[8], w0[8], w1[8], w2[8];
    ld8bf(X + row * ld + col, x0);
    if (lo) ld8bf(X + (row - 1) * ld + col, xm); else { for (int i = 0; i < 8; ++i) xm[i] = 0.f; }
    if (hi) ld8bf(X + (row + 1) * ld + col, xp); else { for (int i = 0; i < 8; ++i) xp[i] = 0.f; }
    ld8f(cw + col, w0); ld8f(cw + cwld + col, w1); ld8f(cw + 2 * cwld + col, w2);
#pragma unroll
    for (int i = 0; i < 8; ++i) y[i] = w0[i] * xm[i] + w1[i] * x0[i] + w2[i] * xp[i];
}
__device__ __forceinline__ void phase_rwkv_naive(const Frame& F, const KA& P, int l) {
    LAS float* Rr = (LAS float*)F.lds; LAS float* Ww = Rr + 4096; LAS float* Kd = Ww + 4096; LAS float* Aa = Kd + 4096; LAS float* Bb = Aa + 4096; LAS float* Vv = Bb + 4096;
    LAS float* Lo = Vv + 2048; LAS float* Yl = Lo;
    const bf16_t* RKV = (const bf16_t*)(P.ws() + WS_RKV); const bf16_t* LORA = (const bf16_t*)(P.ws() + WS_LORA);
    bf16_t* YD = (bf16_t*)(P.ws() + WS_YD); float* CBON = (float*)(P.ws() + WS_CBON);
    const float* cw = P.in(I_RWCONV) + (size_t)l * 3 * 1536;
    for (int ci = F.bid; ci < 256; ci += F.G) {
        const int b = ci >> 5, h = (ci >> 2) & 7, d = (ci >> 1) & 1, vh = ci & 1;
        const int t = F.tid >> 3, cg = F.tid & 7, hc = h * 64 + cg * 8;
        const float* w2p = P.in(I_RWW2) + (size_t)(l * 2 + d) * 64 * 512 + hc; const float* a2p = P.in(I_RWA2) + (size_t)(l * 2 + d) * 64 * 512 + hc;
        float st[8];
#pragma unroll
        for (int i = 0; i < 8; ++i) st[i] = 0.f;
        const int sv = F.tid >> 3, kq = F.tid & 7;
#pragma unroll 1
        for (int c = 0; c < NCHAIN; ++c) {
            const int rowbase = chain_row(b, d, c); const bool isc = c < 4;
            const size_t row = (size_t)rowbase + t;
            int hcx = hc; asm volatile("" : "+v"(hcx));
            bool lo = t > 0, hi = t < 63;
            if (isc) { const int tt = rowbase - (ML + b * CTXL) + t; lo = tt > 0; hi = tt < CTXL - 1; }
            float r8[8], k8[8], v8[8];
            conv8(RKV, 1536, row, hc, lo, hi, cw, 1536, r8); conv8(RKV, 1536, row, 512 + hc, lo, hi, cw, 1536, k8);
            if ((cg >> 2) == vh) { conv8(RKV, 1536, row, 1024 + hc, lo, hi, cw, 1536, v8); lds_st8(Vv + t * 32 + (cg & 3) * 8, v8); }
            lds_st8(Rr + t * 64 + cg * 8, r8);
            float kk[8]; float ss = 0.f;
            { float kkw[8]; ld8f(P.in(I_RWKK) + l * 512 + hcx, kkw);
#pragma unroll
              for (int i = 0; i < 8; ++i) { kk[i] = k8[i] * kkw[i]; ss += kk[i] * kk[i]; } }
            ss = red8(ss); { const float inv = rsqrtf(fmaxf(ss, 1e-24f));
#pragma unroll
              for (int i = 0; i < 8; ++i) kk[i] *= inv; }
            { float na[8];
#pragma unroll
              for (int i = 0; i < 8; ++i) na[i] = -kk[i];
              lds_st8(Aa + t * 64 + cg * 8, na); }
            { float lw[8], la[8]; ld8bf(LORA + row * 256 + d * 64 + cg * 8, lw); ld8bf(LORA + row * 256 + 128 + d * 64 + cg * 8, la);
              lds_st8(Lo + t * 128 + cg * 8, lw); lds_st8(Lo + t * 128 + 64 + cg * 8, la); }
            __syncthreads();
            float wa[8], aa[8];
            ld8f(P.in(I_RWW0) + (l * 2 + d) * 512 + hcx, wa); ld8f(P.in(I_RWA0) + (l * 2 + d) * 512 + hcx, aa);
#pragma unroll 2
            for (int j = 0; j < 64; ++j) { const float lw = Lo[t * 128 + j], la = Lo[t * 128 + 64 + j]; float w2r[8], a2r[8]; ld8f(w2p + (size_t)j * 512, w2r); ld8f(a2p + (size_t)j * 512, a2r);
#pragma unroll
                for (int i = 0; i < 8; ++i) { wa[i] += lw * w2r[i]; aa[i] += la * a2r[i]; } }
            float cb = 0.f;
            { float dec[8], kd[8], bb[8], kaw[8], rkw[8]; ld8f(P.in(I_RWKA) + l * 512 + hcx, kaw); ld8f(P.in(I_RWRK) + l * 512 + hcx, rkw);
#pragma unroll
              for (int i = 0; i < 8; ++i) { const float wl = -softplusf_(-wa[i]) - 0.5f; dec[i] = __expf(-__expf(wl)); const float as = sigmoidf_(aa[i]);
                  kd[i] = k8[i] * (1.0f + (as - 1.0f) * kaw[i]); bb[i] = kk[i] * as; cb += r8[i] * rkw[i] * kd[i]; }
              lds_st8(Ww + t * 64 + cg * 8, dec); lds_st8(Kd + t * 64 + cg * 8, kd); lds_st8(Bb + t * 64 + cg * 8, bb); }
            cb = red8(cb);
            if (cg == 0 && vh == 0) CBON[((size_t)d * MT + row) * 8 + h] = cb;
            __syncthreads();
            if (F.tid < 256) {
#pragma unroll 2
                for (int s = 0; s < 64; ++s) {
                    const int tt = d ? 63 - s : s;
                    float a8[8], w8[8], b8[8], q8[8], rr8[8];
                    lds_ld8(Aa + tt * 64 + kq * 8, a8); lds_ld8(Ww + tt * 64 + kq * 8, w8); lds_ld8(Bb + tt * 64 + kq * 8, b8); lds_ld8(Kd + tt * 64 + kq * 8, q8); lds_ld8(Rr + tt * 64 + kq * 8, rr8);
                    const float vt = Vv[tt * 32 + sv];
                    float sa = 0.f;
#pragma unroll
                    for (int i = 0; i < 8; ++i) sa += st[i] * a8[i];
                    sa = red8(sa);
                    float y = 0.f;
#pragma unroll
                    for (int i = 0; i < 8; ++i) { st[i] = st[i] * w8[i] + sa * b8[i] + vt * q8[i]; y += st[i] * rr8[i]; }
                    y = red8(y);
                    if (kq == 0) Yl[tt * 32 + sv] = y;
                }
            }
            __syncthreads();
            { const int seg = F.tid & 7; const f32x4 y = *(const LAS f32x4*)(Yl + t * 32 + seg * 4);
              u32x2 w; w.x = cvt_pk_bf16(y.x, y.y); w.y = cvt_pk_bf16(y.z, y.w);
              *(u32x2*)(YD + ((size_t)d * MT + row) * 512 + h * 64 + vh * 32 + seg * 4) = w; }
            __syncthreads();
        }
    }
}
__device__ __forceinline__ void phase_rwkv_final(const Frame& F, const KA& P, int l) {
    LAS float* stt = (LAS float*)F.lds;
    const bf16_t* RKV = (const bf16_t*)(P.ws() + WS_RKV); const bf16_t* YD = (const bf16_t*)(P.ws() + WS_YD); const bf16_t* RWG = (const bf16_t*)(P.ws() + WS_RWG);
    const float* CBON = (const float*)(P.ws() + WS_CBON); bf16_t* RWOUT = (bf16_t*)(P.ws() + WS_RWOUT);
    const float* cw = P.in(I_RWCONV) + (size_t)l * 3 * 1536;
    const int c = F.tid, head = c >> 6;
    const float lnw = P.in(I_RWLNW)[l * 512 + c], lnb = P.in(I_RWLNB)[l * 512 + c];
    const float cw0 = cw[1024 + c], cw1 = cw[1536 + 1024 + c], cw2 = cw[3072 + 1024 + c];
    for (int tile = F.bid; tile < MT / 64; tile += F.G) {
        const int rowbase = tile * 64; const bool isc = rowbase >= ML;
        __syncthreads();
#pragma unroll 1
        for (int k = 0; k < 8; ++k) { const int t = F.wave * 8 + k; const size_t row = (size_t)rowbase + t;
            float y0[8], y1[8]; ld8bf(YD + row * 512 + F.lane * 8, y0); ld8bf(YD + ((size_t)MT + row) * 512 + F.lane * 8, y1);
            float s = 0.f;
#pragma unroll
            for (int i = 0; i < 8; ++i) {
#ifdef DBG_SAN2
                if (!(fabsf(y0[i]) < 1e30f)) y0[i] = 0.f; if (!(fabsf(y1[i]) < 1e30f)) y1[i] = 0.f;
#endif
                y0[i] += y1[i]; s += y0[i]; }
            const float mu = red8(s) * (1.0f / 64.0f); float q = 0.f;
#pragma unroll
            for (int i = 0; i < 8; ++i) { const float dd = y0[i] - mu; q += dd * dd; }
            const float rstd = rsqrtf(red8(q) * (1.0f / 64.0f) + 64e-5f);
            if ((F.lane & 7) == 0) { stt[(t * 8 + (F.lane >> 3)) * 2] = mu; stt[(t * 8 + (F.lane >> 3)) * 2 + 1] = rstd; } }
        __syncthreads();
        float xm = 0.f, x0 = bf2f(RKV[(size_t)rowbase * 1536 + 1024 + c]);
        if (isc && (rowbase - ML) % CTXL != 0) xm = bf2f(RKV[(size_t)(rowbase - 1) * 1536 + 1024 + c]);
#pragma unroll 2
        for (int t = 0; t < 64; ++t) { const size_t row = (size_t)rowbase + t;
            bool hi = t < 63; if (isc) hi = ((int)(row - ML) % CTXL) != CTXL - 1;
            const float xp = hi ? bf2f(RKV[(row + 1) * 1536 + 1024 + c]) : 0.f;
            const float v = cw0 * xm + cw1 * x0 + cw2 * xp; xm = x0; x0 = xp;
            float wk0 = bf2f(YD[row * 512 + c]), wk1 = bf2f(YD[((size_t)MT + row) * 512 + c]);
#ifdef DBG_SAN2
            if (!(fabsf(wk0) < 1e30f)) wk0 = 0.f; if (!(fabsf(wk1) < 1e30f)) wk1 = 0.f;
#endif
            const float wkv = wk0 + wk1;
            const float mu = stt[(t * 8 + head) * 2], rstd = stt[(t * 8 + head) * 2 + 1];
            const float cb = CBON[row * 8 + head] + CBON[((size_t)MT + row) * 8 + head];
            const float o = (wkv - mu) * rstd * lnw + lnb + cb * v;
            RWOUT[row * 512 + c] = f2bf(o * bf2f(RWG[row * 512 + c]));
        }
    }
    __syncthreads();
}

typedef float f32x16 __attribute__((ext_vector_type(16)));
constexpr int MP = 72, MSZ = 64 * MP * 2;
__device__ __forceinline__ int mi(int row, int col) { return row * MP + (col ^ (((row >> 3) & 7) << 3)); }
__device__ __forceinline__ int acc_row(int i, int hb) { return 8 * (i >> 2) + 4 * hb + (i & 3); }
__device__ __forceinline__ bf16x8 as_bf16x8(u32x4 w) { return __builtin_bit_cast(bf16x8, w); }
__device__ __forceinline__ unsigned pk_bf16_c(float lo, float hi) { unsigned a = __float_as_uint(lo), b = __float_as_uint(hi);
    a += 0x7fffu + ((a >> 16) & 1u); b += 0x7fffu + ((b >> 16) & 1u); return (a >> 16) | (b & 0xffff0000u); }
__device__ __forceinline__ void mm_tile(f32x16& acc, const LAS bf16_t* A, int row0, const LAS bf16_t* B, int col0, int lane, int q0, int q1) {
    const int r = lane & 31, hb = lane >> 5;
    for (int q = q0; q < q1; ++q) {
        const bf16x8 a = *(const LAS bf16x8*)(A + mi(row0 + r, 16 * q + 8 * hb)), b = *(const LAS bf16x8*)(B + mi(col0 + r, 16 * q + 8 * hb));
        acc = __builtin_amdgcn_mfma_f32_32x32x16_bf16(a, b, acc, 0, 0, 0);
    }
}
__device__ __forceinline__ void st_tile_T(LAS bf16_t* D, int col0, int row0, const f32x16& acc, int lane) {
    const int r = lane & 31, hb = lane >> 5;
#pragma unroll
    for (int g = 0; g < 4; ++g) { u32x2 w; w.x = cvt_pk_bf16(acc[4 * g], acc[4 * g + 1]); w.y = cvt_pk_bf16(acc[4 * g + 2], acc[4 * g + 3]);
        *(LAS u32x2*)(D + mi(col0 + r, row0 + 8 * g + 4 * hb)) = w; }
}
#define TOFF(i) ((8 * ((i) >> 2) + ((i) & 3)) * MP)
__device__ __forceinline__ void tile_base(int row0, int col0, int lane, int (&tb)[4]) {
    const int r = lane & 31, hb = lane >> 5, b0 = (row0 + 4 * hb) * MP + (col0 ^ row0);
#pragma unroll
    for (int g = 0; g < 4; ++g) tb[g] = b0 + (r ^ (8 * g));
}
__device__ __forceinline__ void st_tile_tb(LAS bf16_t* D, const int (&tb)[4], const f32x16& acc) {
#pragma unroll
    for (int i = 0; i < 16; i += 2) { const unsigned w = cvt_pk_bf16(acc[i], acc[i + 1]); D[tb[i >> 2] + TOFF(i)] = (bf16_t)(w & 0xffffu); D[tb[i >> 2] + TOFF(i + 1)] = (bf16_t)(w >> 16); }
}
__device__ __forceinline__ void st_tile(LAS bf16_t* D, int row0, int col0, const f32x16& acc, int lane) { int tb[4]; tile_base(row0, col0, lane, tb); st_tile_tb(D, tb, acc); }
__device__ __forceinline__ void write_permuted(const LAS bf16_t* X, unsigned char* dst, int tid) {
    const int tmq = tid >> 6, lane = tid & 63, tm = tmq >> 2, q = tmq & 3, r = lane & 31, hb = lane >> 5;
    const u32x2 lo = *(const LAS u32x2*)(X + mi(32 * tm + r, 16 * q + 4 * hb)), hi = *(const LAS u32x2*)(X + mi(32 * tm + r, 16 * q + 8 + 4 * hb));
    *(u32x4*)(dst + (size_t)tid * 16) = (u32x4){lo.x, lo.y, hi.x, hi.y};
}

struct RaIn { u32x4 x[9]; u32x4 a[4]; };
__device__ __forceinline__ void ra_unit_decode(int u, int bh, int& c, int& d, int& h, int& b) { c = u % NCHAIN; d = (u / NCHAIN) & 1; h = (u / (2 * NCHAIN)) & 7; b = bh * 4 + u / (16 * NCHAIN); }
__device__ __forceinline__ void ra_prefetch(RaIn& in, const bf16_t* RKV, const bf16_t* LORA, int u, int bh, int tid, int w, int lane) {
    int c, d, h, b; ra_unit_decode(u, bh, c, d, h, b);
    const int rowbase = chain_row(b, d, c); const bool isc = c < 4;
    const int s = tid >> 3, cg = tid & 7, t = d ? 63 - s : s, hc = h * 64 + cg * 8; const size_t row = (size_t)rowbase + t;
    bool lo = t > 0, hi = t < 63;
    if (isc) { const int tt = rowbase - (ML + b * CTXL) + t; lo = tt > 0; hi = tt < CTXL - 1; }
    const u32x4 z = (u32x4){0u, 0u, 0u, 0u};
#pragma unroll
    for (int sec = 0; sec < 3; ++sec) { const bf16_t* p = RKV + row * 1536 + sec * 512 + hc;
        const u32x4 xm = *(const u32x4*)(lo ? p - 1536 : p), xp = *(const u32x4*)(hi ? p + 1536 : p);
        in.x[sec * 3 + 0] = *(const u32x4*)p; in.x[sec * 3 + 1] = lo ? xm : z; in.x[sec * 3 + 2] = hi ? xp : z; }
    const int r = lane & 31, hb = lane >> 5, which = w >> 2, tm = (w >> 1) & 1, sp = 32 * tm + r, tp = d ? 63 - sp : sp;
    const bf16_t* ap = LORA + (size_t)(rowbase + tp) * 256 + which * 128 + d * 64 + 8 * hb;
#pragma unroll
    for (int q = 0; q < 4; ++q) in.a[q] = *(const u32x4*)(ap + 16 * q);
}
__device__ __forceinline__ void conv8_raw(const u32x4 x0v, const u32x4 xmv, const u32x4 xpv, int col, const float* cw, int cwld, float (&y)[8]) {
    f32x4 a0, a1, m0, m1, p0, p1; unpack8(x0v, a0, a1); unpack8(xmv, m0, m1); unpack8(xpv, p0, p1);
    float w0[8], w1[8], w2[8]; ld8f(cw + col, w0); ld8f(cw + cwld + col, w1); ld8f(cw + 2 * cwld + col, w2);
#pragma unroll
    for (int i = 0; i < 4; ++i) { y[i] = w0[i] * m0[i] + w1[i] * a0[i] + w2[i] * p0[i]; y[4 + i] = w0[4 + i] * m1[i] + w1[4 + i] * a1[i] + w2[4 + i] * p1[i]; }
}
__device__ __forceinline__ void conv8_lds(const u32x4 x0v, const u32x4 xmv, const u32x4 xpv, const LAS float* w, int cg, float (&y)[8]) {
    f32x4 a0, a1, m0, m1, p0, p1; unpack8(x0v, a0, a1); unpack8(xmv, m0, m1); unpack8(xpv, p0, p1);
    float w0[8], w1[8], w2[8]; lds_ld8(w + cg * 8, w0); lds_ld8(w + 64 + cg * 8, w1); lds_ld8(w + 128 + cg * 8, w2);
#pragma unroll
    for (int i = 0; i < 4; ++i) { y[i] = w0[i] * m0[i] + w1[i] * a0[i] + w2[i] * p0[i]; y[4 + i] = w0[4 + i] * m1[i] + w1[4 + i] * a1[i] + w2[4 + i] * p1[i]; }
}
__device__ __forceinline__ void phase_rwkv_chunkA(const Frame& F, const KA& P, int l, int bh) {
#define MAT(i) ((LAS bf16_t*)(F.lds + (i) * MSZ))
    LAS float* AAB = (LAS float*)(F.lds + 12 * MSZ);
    LAS float* PTl = AAB + 64 * 68;
    LAS float* LW = (LAS float*)(F.lds + 8 * MSZ);
    LAS float* CP = LW + 4096; LAS float* AS = CP + 4096; LAS float* SEG = AS + 4096; LAS float* SEGX = SEG + 512;
    const bf16_t* RKV = (const bf16_t*)(P.ws() + WS_RKV); const bf16_t* LORA = (const bf16_t*)(P.ws() + WS_LORA);
    bf16_t* YD = (bf16_t*)(P.ws() + WS_YD); float* CBON = (float*)(P.ws() + WS_CBON);
    const float* cw = P.in(I_RWCONV) + (size_t)l * 3 * 1536;
    const int w = F.wave;
    RaIn rin;
    const int hh = F.bid & 7, slot = F.bid >> 3, nslot = F.G >> 3; constexpr int NPH = 4 * 2 * NCHAIN;
    LAS float* WT = (LAS float*)(F.lds + 128512);
    for (int i = F.tid; i < 768; i += NTHR) { float v;
        if (i < 576) { const int sec = i / 192, tap = (i / 64) % 3, ch = i & 63; v = cw[tap * 1536 + sec * 512 + hh * 64 + ch]; }
        else { const int which = (i - 576) >> 6, ch = i & 63; v = (which == 0 ? P.in(I_RWKK) : which == 1 ? P.in(I_RWKA) : P.in(I_RWRK))[l * 512 + hh * 64 + ch]; }
        WT[i] = v; }
#define RA_UNIT_OF(idx) (((((idx) / (2 * NCHAIN)) * 8 + hh) * 2 + (((idx) / NCHAIN) & 1)) * NCHAIN + (idx) % NCHAIN)
    if (slot < NPH) { const int l0 = fresh_lane(); ra_prefetch(rin, RKV, LORA, RA_UNIT_OF(slot), bh, w * 64 + l0, w, l0); }
    for (int uidx = slot; uidx < NPH; uidx += nslot) {
        const int u = RA_UNIT_OF(uidx);
        const int lane = fresh_lane(), tid = w * 64 + lane, r = lane & 31, hb = lane >> 5;
        const int c = u % NCHAIN, d = (u / NCHAIN) & 1, h = (u / (2 * NCHAIN)) & 7, b = bh * 4 + u / (16 * NCHAIN);
        const int rowbase = chain_row(b, d, c); const bool isc = c < 4;
        unsigned char* ra = P.ws() + WS_RA + (size_t)u * RA_UNIT;
        __syncthreads();
        const int p2_which = w >> 2, p2_tm = (w >> 1) & 1, p2_tn = w & 1;
        u32x4 p2a[4], p2b[4]; float p2bias;
        { const int sp = 32 * p2_tm + r, tp = d ? 63 - sp : sp;
          (void)tp;
          const bf16_t* bp = (const bf16_t*)(P.ws() + WS_W_LORA) + ((size_t)((l * 2 + d) * 2 + p2_which) * 512 + h * 64 + 32 * p2_tn + r) * 64 + 8 * hb;
#pragma unroll
          for (int q = 0; q < 4; ++q) { p2a[q] = rin.a[q]; p2b[q] = *(const u32x4*)(bp + 16 * q); }
          p2bias = (p2_which ? P.in(I_RWA0) : P.in(I_RWW0))[(l * 2 + d) * 512 + h * 64 + 32 * p2_tn + r]; }
        const int s = tid >> 3, cg = tid & 7, t = d ? 63 - s : s, hc = h * 64 + cg * 8; const size_t row = (size_t)rowbase + t;
        float kkw[8], kaw[8], rkw[8]; lds_ld8(WT + 576 + cg * 8, kkw); lds_ld8(WT + 640 + cg * 8, kaw); lds_ld8(WT + 704 + cg * 8, rkw);
        bool lo = t > 0, hi = t < 63;
        if (isc) { const int tt = rowbase - (ML + b * CTXL) + t; lo = tt > 0; hi = tt < CTXL - 1; }
        float r8[8], k8[8], kk[8];
        { float v8[8]; conv8_lds(rin.x[6], rin.x[7], rin.x[8], WT + 384, cg, v8);
#pragma unroll
          for (int i = 0; i < 8; ++i) MAT(5)[mi(cg * 8 + i, s)] = f2bf(v8[i]); }
        conv8_lds(rin.x[0], rin.x[1], rin.x[2], WT, cg, r8); conv8_lds(rin.x[3], rin.x[4], rin.x[5], WT + 192, cg, k8);
        (void)lo; (void)hi;
        { float ss = 0.f;
#pragma unroll
          for (int i = 0; i < 8; ++i) { kk[i] = k8[i] * kkw[i]; ss += kk[i] * kk[i]; }
          ss = red8(ss); const float inv = rsqrtf(fmaxf(ss, 1e-24f));
#pragma unroll
          for (int i = 0; i < 8; ++i) kk[i] *= inv; }
        { const int which = p2_which, tm = p2_tm, tn = p2_tn;
          f32x16 acc;
#pragma unroll
          for (int i = 0; i < 16; ++i) acc[i] = 0.f;
#pragma unroll
          for (int q = 0; q < 4; ++q) acc = __builtin_amdgcn_mfma_f32_32x32x16_bf16(as_bf16x8(p2a[q]), as_bf16x8(p2b[q]), acc, 0, 0, 0);
          const float bias = p2bias;
          LAS float* dst = which ? AS : LW;
          LAS float* dp = dst + (32 * tm + 4 * hb) * 64 + 32 * tn + r;
          if (which) {
#pragma unroll
              for (int i = 0; i < 16; ++i) dp[(8 * (i >> 2) + (i & 3)) * 64] = sigmoidf_(acc[i] + bias);
          } else {
#pragma unroll
              for (int i = 0; i < 16; ++i) dp[(8 * (i >> 2) + (i & 3)) * 64] = -0.60653066f * sigmoidf_(acc[i] + bias); } }
        asm volatile("" ::: "memory");
        { const int un = (uidx + nslot < NPH) ? RA_UNIT_OF(uidx + nslot) : u;
          ra_prefetch(rin, RKV, LORA, un, bh, tid, w, lane); }
        __syncthreads();
        { const int k = tid & 63, seg = tid >> 6; float p = 0.f;
#pragma unroll
          for (int i = 0; i < 8; ++i) { p += LW[(8 * seg + i) * 64 + k]; CP[(8 * seg + i) * 64 + k] = p; }
          SEG[seg * 64 + k] = p; }
        __syncthreads();
        if (w == 0) { float a = 0.f;
#pragma unroll
          for (int g = 0; g < 8; ++g) { SEGX[g * 64 + lane] = a; a += SEG[g * 64 + lane]; }
          SEGX[512 + lane] = a; PTl[lane] = __expf(a); }
        __syncthreads();
        { float lw[8], cp[8], as[8], off[8], tot[8];
          lds_ld8(LW + s * 64 + cg * 8, lw); lds_ld8(CP + s * 64 + cg * 8, cp); lds_ld8(AS + s * 64 + cg * 8, as);
          lds_ld8(SEGX + (s >> 3) * 64 + cg * 8, off); lds_ld8(SEGX + 512 + cg * 8, tot);
          float at[8], rt[8], bt[8], kt[8], bhv[8], khv[8]; float cb = 0.f;
#pragma unroll
          for (int i = 0; i < 8; ++i) { const float cum = cp[i] + off[i]; const float e2 = __expf(cum), e1 = __expf(cum - lw[i]), e3 = __expf(-cum), e4 = __expf(tot[i] - cum);
              const float kd = k8[i] * (1.0f + (as[i] - 1.0f) * kaw[i]), bb = kk[i] * as[i];
              at[i] = -kk[i] * e1; rt[i] = r8[i] * e2; bt[i] = bb * e3; kt[i] = kd * e3; bhv[i] = bb * e4; khv[i] = kd * e4; cb += r8[i] * rkw[i] * kd;
              }
          *(LAS u32x4*)(MAT(0) + mi(s, cg * 8)) = pack8((f32x4){at[0], at[1], at[2], at[3]}, (f32x4){at[4], at[5], at[6], at[7]});
          *(LAS u32x4*)(MAT(1) + mi(s, cg * 8)) = pack8((f32x4){rt[0], rt[1], rt[2], rt[3]}, (f32x4){rt[4], rt[5], rt[6], rt[7]});
          *(LAS u32x4*)(MAT(6) + mi(s, cg * 8)) = pack8((f32x4){bt[0], bt[1], bt[2], bt[3]}, (f32x4){bt[4], bt[5], bt[6], bt[7]});
          *(LAS u32x4*)(MAT(7) + mi(s, cg * 8)) = pack8((f32x4){kt[0], kt[1], kt[2], kt[3]}, (f32x4){kt[4], kt[5], kt[6], kt[7]});
#pragma unroll
          for (int i = 0; i < 8; ++i) { MAT(2)[mi(cg * 8 + i, s)] = f2bf(at[i]); MAT(3)[mi(cg * 8 + i, s)] = f2bf(bhv[i]); MAT(4)[mi(cg * 8 + i, s)] = f2bf(khv[i]); }
          cb = red8(cb);
          if (cg == 0) CBON[((size_t)d * MT + row) * 8 + h] = cb; }
        __syncthreads();
        { const int am = w >> 1, tm = w & 1;
          const LAS bf16_t* A = (am < 2) ? MAT(0) : MAT(1); const LAS bf16_t* B = (am & 1) ? MAT(7) : MAT(6);
#pragma unroll
          for (int tn = 0; tn < 2; ++tn) {
              f32x16 acc;
#pragma unroll
              for (int i = 0; i < 16; ++i) acc[i] = 0.f;
              if (!(tm == 0 && tn == 1)) mm_tile(acc, A, 32 * tm, B, 32 * tn, lane, 0, 4);
              const int dl = 32 * tn + r - (32 * tm + 4 * hb) - ((am < 2) ? 0 : 1);
              if (am == 0) { LAS float* dp = AAB + (32 * tn + r) * 68 + 8 * tm + hb;
#pragma unroll
                  for (int i = 0; i < 16; ++i) { const int ci = 8 * (i >> 2) + (i & 3); dp[(i & 3) * 16 + 2 * (i >> 2)] = (dl < ci) ? acc[i] : 0.f; }
              } else { int tb[4]; tile_base(32 * tm, 32 * tn, lane, tb); f32x16 mv;
#pragma unroll
                  for (int i = 0; i < 16; ++i) { const int ci = 8 * (i >> 2) + (i & 3); mv[i] = (dl < ci) ? acc[i] : 0.f; }
                  st_tile_tb(MAT(7 + am), tb, mv); } } }
        __syncthreads();
        f32x16 pre_y, pre_s;
        { float z = 0.f; asm volatile("" : "+v"(z)); pre_y = (f32x16){z, z, z, z, z, z, z, z, z, z, z, z, z, z, z, z}; pre_s = pre_y; }
        if (w < 4) {
            const int cc = tid >> 2, jq = tid & 3; float x[16];
#pragma unroll
            for (int i = 0; i < 16; ++i) x[i] = (4 * i + jq == cc) ? 1.0f : 0.f;
            const LAS float* ap = AAB + jq * 16;
#pragma unroll
            for (int g = 0; g < 16; ++g) {
#pragma unroll
                for (int k = 0; k < 4; ++k) {
                    if (g == 15 && k == 3) continue;
                    const int sst = 4 * g + k;
                    f32x4 a[4];
#pragma unroll
                    for (int q = 0; q < 4; ++q) if (q >= (g >> 2)) a[q] = *(const LAS f32x4*)(ap + sst * 68 + 4 * q);
                    float xs;
                    if (k == 0) xs = dpp_f<0x00>(x[g]); else if (k == 1) xs = dpp_f<0x55>(x[g]); else if (k == 2) xs = dpp_f<0xAA>(x[g]); else xs = dpp_f<0xFF>(x[g]);
#pragma unroll
                    for (int i = 0; i < 16; ++i) if (i >= g) x[i] = fmaf(a[i >> 2][i & 3], xs, x[i]);
                }
            }
#pragma unroll
            for (int i = 0; i < 16; ++i) MAT(11)[mi(4 * i + jq, cc)] = f2bf(x[i]);
        } else {
            const int tm = (w - 4) >> 1, tn = (w - 4) & 1; f32x16 acc;
#pragma unroll
            for (int i = 0; i < 16; ++i) acc[i] = 0.f;
            mm_tile(acc, MAT(8), 32 * tm, MAT(5), 32 * tn, lane, 0, tm ? 4 : 2);
            st_tile_T(MAT(6), 32 * tn, 32 * tm, acc, lane);
#pragma unroll
            for (int i = 0; i < 16; ++i) { pre_y[i] = 0.f; pre_s[i] = 0.f; }
            mm_tile(pre_y, MAT(10), 32 * tm, MAT(5), 32 * tn, lane, 0, tm ? 4 : 2);
            mm_tile(pre_s, MAT(4), 32 * tm, MAT(5), 32 * tn, lane, 0, 4);
        }
        __syncthreads();
        { const int tm = w & 1, tn = w >> 1; f32x16 acc;
#pragma unroll
          for (int i = 0; i < 16; ++i) acc[i] = 0.f;
          mm_tile(acc, MAT(11), 32 * tm, (tn < 2) ? MAT(2) : MAT(6), 32 * (tn & 1), lane, 0, tm ? 4 : 2);
          st_tile_T((tn < 2) ? MAT(7) : MAT(8), 32 * (tn & 1), 32 * tm, acc, lane); }
        __syncthreads();
        if (w < 4) { const int tm = w >> 1, tn = w & 1; f32x16 acc; int tb[4]; tile_base(32 * tm, 32 * tn, lane, tb);
#pragma unroll
            for (int i = 0; i < 16; ++i) acc[i] = bf2f(MAT(1)[tb[i >> 2] + TOFF(i)]);
            mm_tile(acc, MAT(9), 32 * tm, MAT(7), 32 * tn, lane, 0, tm ? 4 : 2);
            st_tile_tb(MAT(11), tb, acc);
        } else { const int tm = (w - 4) >> 1, tn = (w - 4) & 1; f32x16 acc = pre_y;
            mm_tile(acc, MAT(9), 32 * tm, MAT(8), 32 * tn, lane, 0, tm ? 4 : 2);
            u32x4* yd = (u32x4*)((unsigned char*)YD + (size_t)u * 8192 + (size_t)((tm * 2 + tn) * 64 + lane) * 32);
            yd[0] = pack8((f32x4){acc[0], acc[1], acc[2], acc[3]}, (f32x4){acc[4], acc[5], acc[6], acc[7]});
            yd[1] = pack8((f32x4){acc[8], acc[9], acc[10], acc[11]}, (f32x4){acc[12], acc[13], acc[14], acc[15]});
        }
        if (w < 4) { const int tm = w >> 1, tn = w & 1; f32x16 acc;
#pragma unroll
            for (int i = 0; i < 16; ++i) acc[i] = 0.f;
            mm_tile(acc, MAT(3), 32 * tm, MAT(7), 32 * tn, lane, 0, 4);
            st_tile(MAT(10), 32 * tm, 32 * tn, acc, lane);
        } else { const int tm = (w - 4) >> 1, tn = (w - 4) & 1; f32x16 acc = pre_s;
            mm_tile(acc, MAT(3), 32 * tm, MAT(8), 32 * tn, lane, 0, 4);
#ifdef DBG_NANQ
            { float z = 0.f;
#pragma unroll
              for (int i = 0; i < 16; ++i) {
                  if (DBG_NANQ & 1) z += 0.f * bf2f(MAT(11)[mi(32 * tm + acc_row(i, hb), 32 * tn + r)]);
                  if (DBG_NANQ & 2) z += 0.f * acc[i];
              }
              const int ss0 = 32 * tm + acc_row(0, hb), tt0 = d ? 63 - ss0 : ss0;
              bf16_t* yq = YD + ((size_t)d * MT + rowbase + tt0) * 512 + h * 64 + 32 * tn + r; *yq = f2bf(bf2f(*yq) + z); }
#endif
            u32x4* dst = (u32x4*)(ra + 16384 + ((size_t)((tn * 2 + tm) * 64 + lane)) * 32);
            dst[0] = pack8((f32x4){acc[0], acc[1], acc[2], acc[3]}, (f32x4){acc[4], acc[5], acc[6], acc[7]});
            dst[1] = pack8((f32x4){acc[8], acc[9], acc[10], acc[11]}, (f32x4){acc[12], acc[13], acc[14], acc[15]});
        }
        __syncthreads();
        write_permuted(MAT(11), ra, tid);
        write_permuted(MAT(10), ra + 8192, tid);
        if (tid < 64) ((float*)(ra + 24576))[tid] = PTl[tid];
    }
    __syncthreads();
#undef MAT
#undef RA_UNIT_OF
}
constexpr int RB_SLOT = 12800, RB_RING = 12288, RB_NSLOT = 8;
__device__ __forceinline__ void rb_spin(volatile LAS int* w, int need) { unsigned spins = 0; while (*w < need) { __builtin_amdgcn_s_sleep(1); if (++spins > (1u << 22)) break; } asm volatile("" ::: "memory"); }
struct RbOps { u32x4 ogm[2], ogo[2], osl[2]; f32x4 opt[4]; };
__device__ __forceinline__ void rb_read_ops(RbOps& o, const LAS unsigned char* slot, int tk, int lane, int hb) {
#pragma unroll
    for (int s2 = 0; s2 < 2; ++s2) { o.ogm[s2] = *(const LAS u32x4*)(slot + ((tk * 4 + 2 * tk + s2) * 64 + lane) * 16); o.ogo[s2] = *(const LAS u32x4*)(slot + ((tk * 4 + 2 * (1 - tk) + s2) * 64 + lane) * 16); }
    o.osl[0] = *(const LAS u32x4*)(slot + 8192 + (tk * 64 + lane) * 32); o.osl[1] = *(const LAS u32x4*)(slot + 8192 + (tk * 64 + lane) * 32 + 16);
#pragma unroll
    for (int g = 0; g < 4; ++g) o.opt[g] = *(const LAS f32x4*)(slot + 12288 + (32 * tk + 8 * g + 4 * hb) * 4);
}
__device__ __forceinline__ void rb_spin_fast(volatile LAS int* w, int need) { unsigned spins = 0; while (*w < need) { if (++spins > (1u << 24)) break; } asm volatile("" ::: "memory"); }
__device__ __forceinline__ void phase_rwkv_chunkB(const Frame& F, const KA& P, int bh) {
    LAS unsigned char* xb = F.lds;
    volatile LAS int* flg = (volatile LAS int*)(F.lds + 8192);
    if (F.tid < 16) flg[F.tid] = 0;
    __syncthreads();
    const int lane = F.lane, hb = lane >> 5, w = F.wave;
    const int ci = F.bid;
    float z = 0.f; asm volatile("" : "+v"(z));
    f32x16 S = (f32x16){z, z, z, z, z, z, z, z, z, z, z, z, z, z, z, z};
    if (ci < 128) {
    const int bl = ci >> 5, h = (ci >> 2) & 7, d = (ci >> 1) & 1, vh = ci & 1;
    const size_t u0 = (size_t)(((bl * 8 + h) * 2 + d) * NCHAIN);
    const unsigned char* ra = P.ws() + WS_RA + u0 * RA_UNIT;
    if (w >= 2) {
        for (int c = w - 2; c < NCHAIN; c += 6) {
            if (c >= RB_NSLOT) { rb_spin(flg + 10, c - RB_NSLOT + 1); rb_spin(flg + 11, c - RB_NSLOT + 1); }
            const unsigned char* src = ra + (size_t)c * RA_UNIT;
            u32x4 g[8], s4[4];
#pragma unroll
            for (int i = 0; i < 8; ++i) g[i] = *(const u32x4*)(src + 8192 + (size_t)(i * 64 + lane) * 16);
#pragma unroll
            for (int tk = 0; tk < 2; ++tk) { const u32x4* sl = (const u32x4*)(src + 16384 + (size_t)((vh * 2 + tk) * 64 + lane) * 32); s4[2 * tk] = sl[0]; s4[2 * tk + 1] = sl[1]; }
            const float ptv = ((const float*)(src + 24576))[lane];
            LAS unsigned char* slot = F.lds + RB_RING + (c & (RB_NSLOT - 1)) * RB_SLOT;
#pragma unroll
            for (int i = 0; i < 8; ++i) *(LAS u32x4*)(slot + (i * 64 + lane) * 16) = g[i];
#pragma unroll
            for (int tk = 0; tk < 2; ++tk) { *(LAS u32x4*)(slot + 8192 + (tk * 64 + lane) * 32) = s4[2 * tk]; *(LAS u32x4*)(slot + 8192 + (tk * 64 + lane) * 32 + 16) = s4[2 * tk + 1]; }
            *(LAS float*)(slot + 12288 + lane * 4) = ptv;
            asm volatile("s_waitcnt lgkmcnt(0)" ::: "memory");
            if (lane == 0) flg[c & (RB_NSLOT - 1)] = c + 1;
        }
    } else {
    const int tk = w;
    unsigned char* sc = P.ws() + WS_SC + (u0 * 2 + vh) * 4096;
    S = (f32x16){z, z, z, z, z, z, z, z, z, z, z, z, z, z, z, z};
    RbOps opA, opB;
    rb_spin(flg + 0, 1); rb_read_ops(opA, F.lds + RB_RING, tk, lane, hb);
    asm volatile("s_waitcnt lgkmcnt(0)" ::: "memory");
    if (lane == 0) flg[10 + tk] = 1;
#define RB_STEP(cc, CUR, NXT) do { const int c_ = (cc); \
        u32x4 mine[2], other[2]; LAS u32x4* buf = (LAS u32x4*)(xb + (c_ & 1) * 4096); unsigned char* scc = sc + (size_t)c_ * 8192; \
        _Pragma("unroll") for (int s2 = 0; s2 < 2; ++s2) { const int b0 = 8 * s2, q = 2 * tk + s2; \
            const u32x4 wv = (u32x4){cvt_pk_bf16(S[b0], S[b0 + 1]), cvt_pk_bf16(S[b0 + 2], S[b0 + 3]), cvt_pk_bf16(S[b0 + 4], S[b0 + 5]), cvt_pk_bf16(S[b0 + 6], S[b0 + 7])}; \
            mine[s2] = wv; buf[q * 64 + lane] = wv; *(u32x4*)(scc + (size_t)(q * 64 + lane) * 16) = wv; } \
        asm volatile("s_waitcnt lgkmcnt(0)" ::: "memory");                \
        if (lane == 0) flg[8 + tk] = c_ + 1; \
        f32x4 a0, a1, a2, a3; unpack8(CUR.osl[0], a0, a1); unpack8(CUR.osl[1], a2, a3); \
        f32x16 n; \
        _Pragma("unroll") for (int i = 0; i < 4; ++i) { n[i] = a0[i] + CUR.opt[0][i] * S[i]; n[4 + i] = a1[i] + CUR.opt[1][i] * S[4 + i]; n[8 + i] = a2[i] + CUR.opt[2][i] * S[8 + i]; n[12 + i] = a3[i] + CUR.opt[3][i] * S[12 + i]; } \
        _Pragma("unroll") for (int s2 = 0; s2 < 2; ++s2) n = __builtin_amdgcn_mfma_f32_32x32x16_bf16(as_bf16x8(CUR.ogm[s2]), as_bf16x8(mine[s2]), n, 0, 0, 0);     \
        if (c_ + 1 < NCHAIN) { rb_spin(flg + ((c_ + 1) & (RB_NSLOT - 1)), c_ + 2); rb_read_ops(NXT, F.lds + RB_RING + ((c_ + 1) & (RB_NSLOT - 1)) * RB_SLOT, tk, lane, hb); } \
        rb_spin_fast(flg + 8 + (1 - tk), c_ + 1); \
        _Pragma("unroll") for (int s2 = 0; s2 < 2; ++s2) { const int q = 2 * (1 - tk) + s2; other[s2] = buf[q * 64 + lane]; } \
        _Pragma("unroll") for (int s2 = 0; s2 < 2; ++s2) n = __builtin_amdgcn_mfma_f32_32x32x16_bf16(as_bf16x8(CUR.ogo[s2]), as_bf16x8(other[s2]), n, 0, 0, 0); \
        S = n; \
        asm volatile("s_waitcnt lgkmcnt(0)" ::: "memory");                \
        if (lane == 0) flg[10 + tk] = c_ + 2; \
    } while (0)
#pragma unroll 1
    for (int c = 0; c < NCHAIN; c += 2) { RB_STEP(c, opA, opB); RB_STEP(c + 1, opB, opA); }
#undef RB_STEP
    } }
}
struct RcIn { u32x4 yv[2]; u32x4 q[4]; u32x4 s[4]; };
__device__ __forceinline__ void rc_prefetch(RcIn& in, const KA& P, const bf16_t* YD, int u, int bh, int w, int lane) {
    const int r = lane & 31, hb = lane >> 5;
    const int tc = u % NCHAIN, h = (u / NCHAIN) & 7, bl = u / (8 * NCHAIN), b = bh * 4 + bl;
    const bool isc = tc < 4; const int j = isc ? tc : tc - 4; const int rowbase = isc ? ML + b * CTXL + 64 * j : b * SEQL + 64 * j;
    const int d = w >> 2, vh = (w >> 1) & 1, tm = w & 1;
    const int c = isc ? (d ? 3 - j : j) : (d ? 67 - j : 4 + j);
    const size_t uu = (size_t)(((bl * 8 + h) * 2 + d) * NCHAIN + c);
    const unsigned char* ra = P.ws() + WS_RA + uu * RA_UNIT; const unsigned char* sc = P.ws() + WS_SC + (uu * 2 + vh) * 4096;
    { const u32x4* yd = (const u32x4*)((const unsigned char*)YD + uu * 8192 + (size_t)((tm * 2 + vh) * 64 + lane) * 32); in.yv[0] = yd[0]; in.yv[1] = yd[1]; }
#pragma unroll
    for (int q = 0; q < 4; ++q) { in.q[q] = *(const u32x4*)(ra + (size_t)((tm * 4 + q) * 64 + lane) * 16); in.s[q] = *(const u32x4*)(sc + (size_t)(q * 64 + lane) * 16); }
}
__device__ __forceinline__ void phase_rwkv_chunkC(const Frame& F, const KA& P, int l, int bh, bool dummy = false) {
    constexpr int YP = 68;
    LAS float* Ys = (LAS float*)F.lds;
    const bf16_t* RKV = (const bf16_t*)(P.ws() + WS_RKV); const bf16_t* YD = (const bf16_t*)(P.ws() + WS_YD); const bf16_t* RWG = (const bf16_t*)(P.ws() + WS_RWG);
    const float* CBON = (const float*)(P.ws() + WS_CBON); bf16_t* RWOUT = (bf16_t*)(P.ws() + WS_RWOUT);
    const float* cw = P.in(I_RWCONV) + (size_t)l * 3 * 1536;
    const int w = F.wave;
    RcIn cin;
    const int hh = F.bid & 7, slot = F.bid >> 3, nslot = F.G >> 3; constexpr int NPH = 4 * NCHAIN;
    LAS float* WT = (LAS float*)(F.lds + 36864);
    for (int i = F.tid; i < 320; i += NTHR) { const int ch = i & 63;
        WT[i] = (i < 192) ? cw[(i >> 6) * 1536 + 1024 + hh * 64 + ch] : (i < 256) ? P.in(I_RWLNW)[l * 512 + hh * 64 + ch] : P.in(I_RWLNB)[l * 512 + hh * 64 + ch]; }
    __syncthreads();
#define RC_UNIT_OF(idx) ((((idx) / NCHAIN) * 8 + hh) * NCHAIN + (idx) % NCHAIN)
    if (slot < NPH) rc_prefetch(cin, P, YD, RC_UNIT_OF(slot), bh, w, fresh_lane());
    for (int uidx = slot; uidx < NPH; uidx += nslot) {
        const int u = RC_UNIT_OF(uidx);
        const int lane = fresh_lane(), tid = w * 64 + lane, r = lane & 31, hb = lane >> 5;
        const int tc = u % NCHAIN, h = (u / NCHAIN) & 7, bl = u / (8 * NCHAIN), b = bh * 4 + bl;
        const bool isc = tc < 4; const int j = isc ? tc : tc - 4; const int rowbase = isc ? ML + b * CTXL + 64 * j : b * SEQL + 64 * j;
        const int ft = tid >> 3, fcg = tid & 7, fhc = h * 64 + fcg * 8; const size_t frow = (size_t)rowbase + ft;
        float v8[8], lnw[8], lnb[8], g8[8]; float cb;
        { bool lo = ft > 0, hi = ft < 63;
          if (isc) { const int tt = rowbase - (ML + b * CTXL) + ft; lo = tt > 0; hi = tt < CTXL - 1; }
          { float x0[8], xm[8], xp[8], w0[8], w1[8], w2[8];
            ld8bf(RKV + frow * 1536 + 1024 + fhc, x0);
            if (lo) ld8bf(RKV + (frow - 1) * 1536 + 1024 + fhc, xm); else { for (int i = 0; i < 8; ++i) xm[i] = 0.f; }
            if (hi) ld8bf(RKV + (frow + 1) * 1536 + 1024 + fhc, xp); else { for (int i = 0; i < 8; ++i) xp[i] = 0.f; }
            lds_ld8(WT + fcg * 8, w0); lds_ld8(WT + 64 + fcg * 8, w1); lds_ld8(WT + 128 + fcg * 8, w2);
#pragma unroll
            for (int i = 0; i < 8; ++i) v8[i] = w0[i] * xm[i] + w1[i] * x0[i] + w2[i] * xp[i]; }
          cb = CBON[frow * 8 + h] + CBON[((size_t)MT + frow) * 8 + h];
          lds_ld8(WT + 192 + fcg * 8, lnw); lds_ld8(WT + 256 + fcg * 8, lnb); ld8bf(RWG + frow * 512 + fhc, g8); }
        __syncthreads();
        { const int d = w >> 2, vh = (w >> 1) & 1, tm = w & 1;
          f32x16 y;
#pragma unroll
          for (int i = 0; i < 1; ++i) { f32x4 y0, y1, y2, y3; unpack8(cin.yv[0], y0, y1); unpack8(cin.yv[1], y2, y3);
#pragma unroll
              for (int k = 0; k < 4; ++k) { y[k] = y0[k]; y[4 + k] = y1[k]; y[8 + k] = y2[k]; y[12 + k] = y3[k]; } }
#pragma unroll
          for (int q = 0; q < 4; ++q) y = __builtin_amdgcn_mfma_f32_32x32x16_bf16(as_bf16x8(cin.q[q]), as_bf16x8(cin.s[q]), y, 0, 0, 0);
          rc_prefetch(cin, P, YD, (uidx + nslot < NPH) ? RC_UNIT_OF(uidx + nslot) : u, bh, w, lane);
          { LAS float* yp0 = Ys + (d * 64 + (d ? 63 - 32 * tm - 4 * hb : 32 * tm + 4 * hb)) * YP + 32 * vh + r; const int ys = d ? -YP : YP;
#pragma unroll
            for (int i = 0; i < 16; ++i) yp0[(8 * (i >> 2) + (i & 3)) * ys] = y[i]; } }
        __syncthreads();
        { const int t = ft, cg = fcg, hc = fhc; const size_t row = frow;
          float wk[8], a1[8];
          lds_ld8(Ys + t * YP + cg * 8, wk); lds_ld8(Ys + (64 + t) * YP + cg * 8, a1);
          float s = 0.f;
#pragma unroll
          for (int i = 0; i < 8; ++i) { wk[i] += a1[i]; s += wk[i]; }
          const float mu = red8(s) * (1.0f / 64.0f); float q2 = 0.f;
#pragma unroll
          for (int i = 0; i < 8; ++i) { const float dd = wk[i] - mu; q2 += dd * dd; }
          const float rstd = rsqrtf(red8(q2) * (1.0f / 64.0f) + 64e-5f);
          f32x4 o0, o1;
#pragma unroll
          for (int i = 0; i < 4; ++i) { o0[i] = ((wk[i] - mu) * rstd * lnw[i] + lnb[i] + cb * v8[i]) * g8[i]; o1[i] = ((wk[4 + i] - mu) * rstd * lnw[4 + i] + lnb[4 + i] + cb * v8[4 + i]) * g8[4 + i]; }
          if (dummy) *(u32x4*)((bf16_t*)(P.ws() + WS_U) + (row & 16383) * 512 + hc) = pack8(o0, o1);
          else *(u32x4*)(RWOUT + row * 512 + hc) = pack8(o0, o1); }
    }
    __syncthreads();
}

#ifndef PROBE
#define PROBE 0
#endif
#define PREP(k) for (int _rep = 0; _rep < ((PROBE == (k)) ? 2 : 1); ++_rep)
#ifndef GEN
#define GEN 0xffffffff
#endif
#ifndef EN
#define EN 0xffffffff
#endif
#ifndef MK_PER_PHASE
#define MK_PER_PHASE 0
#endif
constexpr int MAX_PHASES = 35;

__device__ __forceinline__ void ka_opq(KA& P, Frame& F, int& ph) { asm volatile("" : "+s"(P.p), "+s"(F.wave), "+s"(F.bid), "+s"(F.G), "+s"(ph)); F.gw = F.bid * NWAVES + F.wave; F.NGW = F.G * NWAVES; }
__global__ void __launch_bounds__(NTHR, 2) mega_fwd(Params P_unused) {
    KA P; P.p = (const CAS unsigned char*)__builtin_amdgcn_kernarg_segment_ptr();
    extern __shared__ __attribute__((aligned(16))) unsigned char lds_raw[];
    Frame F; F.lds = (LAS unsigned char*)lds_raw;
    F.wave = __builtin_amdgcn_readfirstlane((int)threadIdx.x >> 6); F.lane = fresh_lane(); F.tid = F.wave * 64 + F.lane; F.bid = blockIdx.x; F.G = gridDim.x; F.gw = F.bid * NWAVES + F.wave; F.NGW = F.G * NWAVES;
    #define ws (P.ws())
    if (F.tid == 0) *(LAS u32x4*)(F.lds + LDS_XB) = (u32x4){0u, 0u, 0u, 0u};
    __syncthreads();
    XcdBarrier bar; bar.bar = (unsigned*)(ws + WS_CTL) + CW_BAR; bar.x = 0; bar.st = nullptr;
    const bool use_bar = (P.ph_hi() - P.ph_lo()) > 1;
    if (use_bar) bar = xcd_barrier_post((unsigned*)(ws + WS_CTL) + CW_BAR, (volatile LAS unsigned*)(F.lds + LDS_XB), F.wave);
    int ph = 0;
#define PH_ON (ka_opq(P, F, ph), F.lane = fresh_lane(), F.tid = F.wave * 64 + F.lane, (ph >= P.ph_lo() && ph < P.ph_hi()))
#define PH_END do { if (PH_ON && (ph + 1) < P.ph_hi()) xcd_barrier(bar, F.wave, (unsigned*)(ws + WS_CTL) + CW_BAR); ++ph; } while (0)

    bf16_t* H = (bf16_t*)(ws + WS_H);
    float* YF = (float*)(ws + WS_YF);
    float* CTXX = (float*)(ws + WS_CTXX);

    if (PROBE == 30 && use_bar) { for (int i = 0; i < 40; ++i) xcd_barrier(bar, F.wave, (unsigned*)(ws + WS_CTL) + CW_BAR); }
    if (PH_ON) { PREP(20) { PREP(34) { if (EN & 1) p0_prologue(F, P); __syncthreads(); } } }
    PH_END;

#pragma unroll 1
    for (int l = 0; l < NLAYER; ++l) {
        const float* ng = P.in(I_NORMG) + (size_t)l * 4 * 1024;
        const int Mrows = (l == 0) ? MT : ML;
        if (PH_ON) {
            if (l == 0) {
                if (EN & 4096) phase_resid_norm<0, false>(F, P, 0, 0, P.in(I_X), P.in(I_CTX), nullptr, 0, nullptr, nullptr, nullptr, ng, 0, H, MT, nullptr);
                __syncthreads();
                PREP(20) { PREP(35) { if (EN & 8192) phase_hyena_filter_mlp(F, P, 0, SEQL, (float*)(ws + WS_HFILT));
                if (EN & 8192) phase_hyena_filter_mlp(F, P, 0, CTXL, (float*)(ws + WS_HFILTC)); } }
            }
        }
        if (l == 0) PH_END;
        if (PH_ON) {
            if (l == 1) { if (EN & 8192) phase_hyena_filter_mlp(F, P, 1, SEQL, (float*)(ws + WS_HFILT)); __syncthreads(); }
            PREP(1) {
            pg8::Gemm g{H, (const bf16_t*)(ws + WS_W_IN) + (size_t)l * INP_N * 1024, MT, INP_N, 1024}; pg8::StaticOrder S; S.init(MT, INP_N, F.G, F.bid);
            pg8::EpiInProj E{(bf16_t*)(ws + WS_U), (bf16_t*)(ws + WS_RKV), (bf16_t*)(ws + WS_HY), (bf16_t*)(ws + WS_LORA), (bf16_t*)(ws + WS_GL)};
            if (GEN & 1) pg8::gemm_phase(F.lds, g, S, E, F.wave);
            }
        }
        PH_END;
        if (PH_ON) { PREP(20) { PREP(31) { if (EN & 4) phase_hyena_transpose_in(F, P, l); } PREP(32) { if (EN & 8) phase_s5_local(F, P, l); } PREP(33) { if (EN & 16) phase_hyena_filter_fft(F, P); } } }
        PH_END;
        if (PH_ON) { PREP(21) { if (EN & 32) phase_s5_carry(F, P, l); __syncthreads(); } PREP(7) { if (EN & 64) phase_hyena_main(F, P, l); } PREP(21) { if ((EN & 128) && l == 0) phase_hyena_ctx(F, P, l); } }
        PH_END;
        if (PH_ON) { PREP(3) { phase_s5_out(F, P, l); } PREP(21) { phase_hyena_transpose_out(F, P); }
            __syncthreads();
            { pg8::Gemm g{(const bf16_t*)(ws + WS_GL), (const bf16_t*)(ws + WS_W_G2) + (size_t)l * 512 * 256, MT, 512, 256}; pg8::StaticOrder S; S.init(MT, 512, F.G, F.bid);
              pg8::EpiBf16<0> E{(bf16_t*)(ws + WS_RWG), 512}; pg8::gemm_phase(F.lds, g, S, E, F.wave); }
            __syncthreads();
            PREP(2) { phase_rwkv_chunkA(F, P, l, 0); } }
        PH_END;
        if (PH_ON) { PREP(36) { phase_rwkv_chunkB(F, P, 0); }
            __syncthreads();
            pg8::Gemm g{(const bf16_t*)(ws + WS_YPRE), (const bf16_t*)(ws + WS_W_GLU) + (size_t)l * 256 * 256, MT, 256, 256}; pg8::StaticOrder S; S.init(MT, 256, F.G, (F.bid + 128) % F.G);
            pg8::EpiComb<4> E{(bf16_t*)(ws + WS_S5OUT), (const bf16_t*)(ws + WS_YPRE), 256, 0};
            pg8::gemm_phase(F.lds, g, S, E, F.wave); }
        PH_END;
        if (PH_ON) { if (PROBE == 25) phase_rwkv_chunkC(F, P, l, 0, true); phase_rwkv_chunkC(F, P, l, 0); }
        PH_END;
        if (PH_ON) { PREP(2) { phase_rwkv_chunkA(F, P, l, 1); } }
        PH_END;
        if (PH_ON) { PREP(36) { phase_rwkv_chunkB(F, P, 1); } PREP(29) { phase_h8(F, P, Mrows); } }
        PH_END;
        if (PH_ON) { if (PROBE == 25) phase_rwkv_chunkC(F, P, l, 1, true); phase_rwkv_chunkC(F, P, l, 1); }
        PH_END;
        if (PH_ON) {
            pg8::Gemm g{(const bf16_t*)(ws + WS_H8), (const bf16_t*)(ws + WS_W_GATE + (size_t)l * 3072 * 1024), Mrows, 3072, 512}; pg8::StaticOrder S; S.init(Mrows, 3072, F.G, F.bid);
            pg8::EpiSig8 E{(bf16_t*)(ws + WS_G), 3072, 1.f / 8192.f}; PREP(27) { pg8::gemm_phase<pg8::EpiSig8, pg8::StaticOrder, true>(F.lds, g, S, E, F.wave); }
        }
        PH_END;
        if (PH_ON) {
            const bf16_t* Wbr = (const bf16_t*)(ws + WS_W_BR + (size_t)l * 2 * MiB);
            const bf16_t* G3 = (const bf16_t*)(ws + WS_G); bf16_t* MB = (bf16_t*)(ws + WS_MB);
            pg8::StaticOrder S; S.init(Mrows, 1024, F.G, F.bid);
            PREP(26) {
            { pg8::Gemm g{(const bf16_t*)(ws + WS_S5OUT), Wbr, Mrows, 1024, 256}; pg8::EpiComb<0> E{MB, G3, 1024, 3072}; pg8::gemm_phase(F.lds, g, S, E, F.wave); }
            block_self_sync();
            { pg8::Gemm g{(const bf16_t*)(ws + WS_RWOUT), Wbr + 1024 * 256, Mrows, 1024, 512}; pg8::EpiComb<1> E{MB, G3 + 1024, 1024, 3072}; pg8::gemm_phase(F.lds, g, S, E, F.wave); }
            block_self_sync();
            { pg8::Gemm g{(const bf16_t*)(ws + WS_HYOUT), Wbr + 1024 * 256 + 1024 * 512, Mrows, 1024, 256}; pg8::EpiComb<1> E{MB, G3 + 2048, 1024, 3072}; pg8::gemm_phase(F.lds, g, S, E, F.wave); }
            if (PROBE == 26 && _rep == 0) block_self_sync();
            }
        }
        PH_END;
        if (PH_ON) {
            pg8::Gemm g{(const bf16_t*)(ws + WS_MB), (const bf16_t*)(ws + WS_W_OUT) + (size_t)l * 1024 * 1024, Mrows, 1024, 1024}; pg8::StaticOrder S; S.init(Mrows, 1024, F.G, F.bid);
            pg8::EpiBf16<0> E{(bf16_t*)YF, 1024}; PREP(24) { if (GEN & 256) pg8::gemm_phase(F.lds, g, S, E, F.wave); }
        }
        PH_END;
        if (PH_ON) {
            if (l == 0) { if (PROBE == 22) { phase_resid_norm<1, false>(F, P, 0, 0, P.in(I_X), P.in(I_CTX), YF, 2, ng + 1024, (float*)(ws + WS_U), (float*)(ws + WS_U + 129 * MiB), ng + 2048, 3, nullptr, MT, nullptr); __syncthreads(); }
                          if (EN & 4096) phase_resid_norm<1, false>(F, P, 0, 0, P.in(I_X), P.in(I_CTX), YF, 2, ng + 1024, P.out(), CTXX, ng + 2048, 3, H, MT, nullptr, 0, 1); }
            else        { if (EN & 4096) phase_resid_norm<1, true>(F, P, 1, 1, P.out(), CTXX, YF, 2, ng + 1024, P.out(), CTXX, ng + 2048, 3, H, ML, P.in(I_MOER), 1, 2); }
        }
        PH_END;
        if (l == 0) {
            if (PH_ON) {
                pg8::Gemm g{H, (const bf16_t*)(ws + WS_W_FGU), MT, 2 * FFH, 1024}; pg8::StaticOrder S; S.init(MT, 2 * FFH, F.G, F.bid);
                pg8::EpiSwiGLU E{(bf16_t*)(ws + WS_ACT), FFH}; PREP(5) { if (GEN & 512) pg8::gemm_phase(F.lds, g, S, E, F.wave); }
            }
            PH_END;
            if (PH_ON) {
                pg8::Gemm g{(const bf16_t*)(ws + WS_ACT), (const bf16_t*)(ws + WS_W_FD), MT, 1024, FFH}; pg8::StaticOrder S; S.init(MT, 1024, F.G, F.bid);
                pg8::EpiBf16<0> E{(bf16_t*)YF, 1024}; PREP(24) { if (GEN & 1024) pg8::gemm_phase(F.lds, g, S, E, F.wave); }
            }
            PH_END;
            if (PH_ON) {
                if (EN & 4096) phase_resid_norm<1, false>(F, P, 0, 1, P.out(), CTXX, YF, 5, ng + 3072, P.out(), CTXX, P.in(I_NORMG) + (size_t)4 * 1024, 0, H, MT, nullptr, 1, 1);
            }
            PH_END;
        } else {
            unsigned char* Wgu = ws + WS_MOEW; unsigned char* Wd = Wgu + (size_t)8 * 2 * EXQ * 1024;
            if (PH_ON) { if (EN & 16384) phase_moe_gather(F, P); __syncthreads(); PREP(23) { if (EN & 32768) moe_convert_quarter(F, P, 0, 3); } }
            PH_END;
            if (PH_ON) {
                pg8::MoeOrder S; moe_pad_ends(P, S.pe); S.init(S.pe[7], 2 * EXQ, F.G, F.bid); S.estride = (size_t)2 * EXQ * 1024;
                pg8::Gemm g{(const bf16_t*)(ws + WS_XB), (const bf16_t*)Wgu, S.pe[7], 2 * EXQ, 512};
                pg8::EpiSwiGLU8 E{ws + WS_ACTQ, EXQ}; PREP(10) { if (GEN & 2048) pg8::gemm_phase<pg8::EpiSwiGLU8, pg8::MoeOrder, true>(F.lds, g, S, E, F.wave); }
            }
            PH_END;
            if (PH_ON) {
                pg8::MoeOrder S; moe_pad_ends(P, S.pe); S.init(S.pe[7], 1024, F.G, F.bid); S.estride = (size_t)1024 * EXQ;
                pg8::Gemm g{(const bf16_t*)(ws + WS_ACTQ), (const bf16_t*)Wd, S.pe[7], 1024, EXQ / 2};
                pg8::EpiF8Out E{ws + WS_YB, 1024, 1.f / 128.f}; PREP(28) { if (GEN & 4096) pg8::gemm_phase<pg8::EpiF8Out, pg8::MoeOrder, true>(F.lds, g, S, E, F.wave); }
            }
            PH_END;
            if (PH_ON) if (EN & 4096) phase_resid_norm<2, false>(F, P, 1, 1, P.out(), nullptr, nullptr, 5, ng + 3072, P.out(), nullptr, nullptr, 0, nullptr, ML, nullptr, 2, 0);
            PH_END;
        }
    }
#undef PH_ON
#undef PH_END
}

#undef ws
extern "C" void kernel_launch(void* const* d_in, const int* in_sizes, int n_in, void* d_out, int out_size, void* d_ws, size_t ws_size, hipStream_t stream) {
    static int grid = 0;
    if (grid == 0) {
        if (n_in != 49 || in_sizes[0] != ML * DM || out_size != ML * DM || ws_size < WS_END) {
            fprintf(stderr, "kernel_launch: unexpected problem: n_in %d in0 %d out %d ws %zu (need %zu); nothing launched\n", n_in, n_in > 0 ? in_sizes[0] : -1, out_size, ws_size, (size_t)WS_END); grid = -1; return; }
        int dev = 0, cus = 0, per_cu = 0;
        if (hipGetDevice(&dev) != hipSuccess || hipDeviceGetAttribute(&cus, hipDeviceAttributeMultiprocessorCount, dev) != hipSuccess) { grid = -1; return; }
        if (hipFuncSetAttribute((const void*)mega_fwd, hipFuncAttributeMaxDynamicSharedMemorySize, LDS_BYTES) != hipSuccess) { fprintf(stderr, "kernel_launch: hipFuncSetAttribute failed\n"); grid = -1; return; }
        if (hipOccupancyMaxActiveBlocksPerMultiprocessor(&per_cu, (const void*)mega_fwd, NTHR, LDS_BYTES) != hipSuccess || per_cu < 1) { fprintf(stderr, "kernel_launch: occupancy query reports %d\n", per_cu); }
        (void)hipGetLastError();
        grid = cus;
        if (grid > 256) grid = 256;
    }
    if (grid < 0) return;
    if (hipMemsetAsync((char*)d_ws + WS_CTL, 0, CTL_ZERO_BYTES, stream) != hipSuccess) return;
    Params p{};
    for (int i = 0; i < 49; ++i) p.in[i] = (const float*)d_in[i];
    p.out = (float*)d_out; p.ws = (unsigned char*)d_ws;
#if MK_PER_PHASE
    for (int k = 0; k < MAX_PHASES; ++k) { p.ph_lo = k; p.ph_hi = k + 1; hipLaunchKernelGGL(mega_fwd, dim3(grid), dim3(NTHR), LDS_BYTES, stream, p); }
#else
    p.ph_lo = 0; p.ph_hi = MAX_PHASES;
    hipLaunchKernelGGL(mega_fwd, dim3(grid), dim3(NTHR), LDS_BYTES, stream, p);
#endif
}
```

```cpp
#include <hip/hip_runtime.h>
#include <cstdio>
#include <cstdint>

#define LAS __attribute__((address_space(3)))
typedef unsigned short bf16_t;
typedef short bf16x8 __attribute__((ext_vector_type(8)));
typedef float f32x4 __attribute__((ext_vector_type(4)));
typedef float f32x2 __attribute__((ext_vector_type(2)));
typedef unsigned u32x4 __attribute__((ext_vector_type(4)));
typedef unsigned u32x2 __attribute__((ext_vector_type(2)));

__device__ __forceinline__ float bf2f(unsigned b) { return __uint_as_float(b << 16); }
__device__ __forceinline__ float bflo(unsigned w) { return __uint_as_float(w << 16); }
__device__ __forceinline__ float bfhi(unsigned w) { return __uint_as_float(w & 0xffff0000u); }
typedef __bf16 bf16v2_t __attribute__((ext_vector_type(2)));
__device__ __forceinline__ unsigned cvt_pk_bf16(float lo, float hi) { const f32x2 v = {lo, hi}; return __builtin_bit_cast(unsigned, __builtin_convertvector(v, bf16v2_t)); }
typedef int i32x8 __attribute__((ext_vector_type(8)));
typedef int i32x4 __attribute__((ext_vector_type(4)));
__device__ __forceinline__ float clamp8(float x) { return __builtin_amdgcn_fmed3f(x, -448.f, 448.f); }
__device__ __forceinline__ unsigned cvt4_fp8(float a, float b, float c, float d, float s) {
    int p = __builtin_amdgcn_cvt_pk_fp8_f32(clamp8(a * s), clamp8(b * s), 0, false); p = __builtin_amdgcn_cvt_pk_fp8_f32(clamp8(c * s), clamp8(d * s), p, true); return (unsigned)p; }
__device__ __forceinline__ i32x8 cat8(const bf16x8 lo, const bf16x8 hi) { const i32x4 a = __builtin_bit_cast(i32x4, lo), b = __builtin_bit_cast(i32x4, hi); return __builtin_shufflevector(a, b, 0, 1, 2, 3, 4, 5, 6, 7); }
__device__ __forceinline__ bf16_t f2bf(float f) { return (bf16_t)(cvt_pk_bf16(f, 0.f) & 0xffffu); }
__device__ __forceinline__ float sigmoidf_(float x) { return __builtin_amdgcn_rcpf(1.0f + __expf(-x)); }
__device__ __forceinline__ float tanhf_(float x) { const float e = __expf(2.0f * x); return 1.0f - 2.0f * __builtin_amdgcn_rcpf(e + 1.0f); }
__device__ __forceinline__ int fresh_lane() { int l; asm volatile("v_mbcnt_lo_u32_b32 %0, -1, 0\n\tv_mbcnt_hi_u32_b32 %0, -1, %0" : "=v"(l)); return l; }
template <int CTRL> __device__ __forceinline__ float dpp_f(float v) { return __int_as_float(__builtin_amdgcn_update_dpp(0, __float_as_int(v), CTRL, 0xf, 0xf, true)); }
__device__ __forceinline__ float red8(float v) { v += dpp_f<0xB1>(v); v += dpp_f<0x4E>(v); v += dpp_f<0x141>(v); return v; }
__device__ __forceinline__ float wave_sum(float v) {
    v = red8(v); v += dpp_f<0x140>(v);
    v += __int_as_float(__builtin_amdgcn_ds_swizzle(__float_as_int(v), 0x401F));
    return __int_as_float(__builtin_amdgcn_readlane(__float_as_int(v), 0)) + __int_as_float(__builtin_amdgcn_readlane(__float_as_int(v), 32));
}

__device__ __forceinline__ u32x4 pack8(const f32x4 v0, const f32x4 v1) { u32x4 w; w.x = cvt_pk_bf16(v0[0], v0[1]); w.y = cvt_pk_bf16(v0[2], v0[3]); w.z = cvt_pk_bf16(v1[0], v1[1]); w.w = cvt_pk_bf16(v1[2], v1[3]); return w; }
__device__ __forceinline__ void unpack8(const u32x4 w, f32x4& v0, f32x4& v1) { v0 = (f32x4){bflo(w.x), bfhi(w.x), bflo(w.y), bfhi(w.y)}; v1 = (f32x4){bflo(w.z), bfhi(w.z), bflo(w.w), bfhi(w.w)}; }
template <int ACT> __device__ __forceinline__ f32x4 act4(f32x4 v) {
    if (ACT == 1) { for (int j = 0; j < 4; ++j) v[j] = tanhf_(v[j]); }
    if (ACT == 2) { for (int j = 0; j < 4; ++j) v[j] = sigmoidf_(v[j]); }
    return v; }


namespace pg8 {
constexpr int BM = 256, BK = 64, HALF = 128, HTB = HALF * BK * 2, STAGE_BYTES = 8 * HTB, NXCD = 8, WGM = 8;
__host__ __device__ __forceinline__ int lds_byte(int r, int c) { const int st = (r >> 4) * 2 + (c >> 5), rr = r & 15, cc = c & 31, ob = rr * 64 + cc * 2; return st * 1024 + (ob ^ (((ob >> 9) & 1) << 5)); }
__host__ __device__ __forceinline__ void stage_rc(int b, int& R, int& C) { const int st = b / 1024, sb = b % 1024, swz = sb ^ (((sb >> 9) & 1) << 5); R = (st >> 1) * 16 + swz / 64; C = (st & 1) * 32 + (swz % 64) / 2; }
__host__ __device__ __forceinline__ int perm32(int rho) { const int n = rho >> 4, i = rho & 15; return 8 * (i >> 2) + 4 * n + (i & 3); }

struct Unit { int pm, pn; };
struct Gemm { const bf16_t* A; const bf16_t* Bt; int M, N, K; };

struct StaticOrder {
    int nM, nN, nwg, G, c;
    __device__ void init(int M, int N, int G_, int c_) { nM = M / BM; nN = N / BM; nwg = nM * nN; G = G_; c = c_; }
    __device__ bool next(int i, Unit& u) const {
        const long L = (long)i * G + c; if (L >= nwg) return false;
        int wgid = (int)L; { const int q = nwg / NXCD, r = nwg % NXCD, xcd = wgid % NXCD, off = wgid / NXCD; wgid = (xcd < r ? xcd * (q + 1) : r * (q + 1) + (xcd - r) * q) + off; }
        const int nig = WGM * nN, gid = wgid / nig, fm = gid * WGM, gsz = (nM - fm) < WGM ? (nM - fm) : WGM;
        u.pm = fm + ((wgid % nig) % gsz); u.pn = (wgid % nig) / gsz; return true;
    }
    __device__ __forceinline__ size_t boff(const Unit&) const { return 0; }
    __device__ __forceinline__ void a_ready(const Unit&) const {}
    __device__ __forceinline__ void done(const Unit&) const {}
};
struct MoeOrder : StaticOrder {
    int pe[8]; size_t estride;
    __device__ __forceinline__ size_t boff(const Unit& u) const { const int r = u.pm * BM; int e = 0;
#pragma unroll
        for (int j = 0; j < 8; ++j) e += (r >= pe[j]) ? 1 : 0;
        e = e > 7 ? 7 : e; return (size_t)e * estride; }
};

template <class Epi, class Sched, bool F8 = false, bool ALIGN_EPI = true, bool SP2 = true>
__device__ __forceinline__ void gemm_phase(LAS unsigned char* lds, const Gemm g, const Sched& S, const Epi& E, int wave_s) {
    const int wid = wave_s, lane = fresh_lane(), tid = wid * 64 + lane, wr = wid >> 2, wc = wid & 3, fr = lane & 15, fq = lane >> 4;
    const int K = g.K, nt = K / BK;
    unsigned voffA[2], voffB[2];
#pragma unroll
    for (int i = 0; i < 2; ++i) { int R, C; stage_rc(tid * 16 + i * 8192, R, C); const int Rb = Epi::PERM ? ((R & ~31) + perm32(R & 31)) : R;
        voffA[i] = (unsigned)(R * K + C) * 2u; voffB[i] = (unsigned)(Rb * K + C) * 2u; }
    const size_t kstep = (size_t)(BK * 2);
    const size_t hstep = (size_t)HALF * K * 2;
    const size_t tstep = 2 * hstep;
    const unsigned ldsw = (unsigned)wid * 1024u;
    const int aoff = lds_byte(wr * 64 + fr, fq * 8), boff = lds_byte(wc * 32 + fr, fq * 8);
#define PG8_SA(b, h) (((b) * 2 + (h)) * HTB)
#define PG8_SB(b, h) ((4 + (b) * 2 + (h)) * HTB)
#define PG8_STAGE(bufoff, gbase, voff) do { _Pragma("unroll") for (int _i = 0; _i < 2; ++_i) { unsigned _vo = (voff)[_i]; if constexpr (F8 || Epi::PERM) asm volatile("" : "+v"(_vo)); \
        __builtin_amdgcn_global_load_lds((const unsigned*)((const char*)(gbase) + _vo), (LAS unsigned*)(lds + (bufoff) + ldsw + _i * 8192), 16, 0, 0); } } while (0)
#define PG8_LDA(dst, b, h) do { _Pragma("unroll") for (int m = 0; m < 4; ++m) _Pragma("unroll") for (int k = 0; k < 2; ++k) dst[m][k] = *(const LAS bf16x8*)(lds + PG8_SA(b, h) + aoff + m * 2048 + k * 1024); } while (0)
#define PG8_LDB(dst, b, h) do { _Pragma("unroll") for (int n = 0; n < 2; ++n) _Pragma("unroll") for (int k = 0; k < 2; ++k) dst[n][k] = *(const LAS bf16x8*)(lds + PG8_SB(b, h) + boff + n * 2048 + k * 1024); } while (0)
#define PG8_MMA(ai, bj, At, Bt) do { __builtin_amdgcn_s_setprio(1); _Pragma("unroll") for (int m = 0; m < 4; ++m) _Pragma("unroll") for (int n = 0; n < 2; ++n) { \
        if constexpr (F8) { const i32x8 _b = cat8(Bt[n][0], Bt[n][1]), _a = cat8(At[m][0], At[m][1]); asm volatile("v_mfma_f32_16x16x128_f8f6f4 %0, %1, %2, %0" : "+v"(acc[ai][bj][m][n]) : "v"(_b), "v"(_a)); } \
        else { _Pragma("unroll") for (int k = 0; k < 2; ++k) acc[ai][bj][m][n] = __builtin_amdgcn_mfma_f32_16x16x32_bf16(Bt[n][k], At[m][k], acc[ai][bj][m][n], 0, 0, 0); } } __builtin_amdgcn_s_setprio(0); } while (0)
#define PG8_WAIT_V(n) asm volatile("s_waitcnt vmcnt(" #n ")" ::: "memory")
#define PG8_WAIT_L(n) asm volatile("s_waitcnt lgkmcnt(" #n ")" ::: "memory")
#define PG8_BAR __builtin_amdgcn_s_barrier()
#define PG8_SCHED __builtin_amdgcn_sched_barrier(0)
    Unit cur, nxt; int ui = 0;
    if (!S.next(0, cur)) return;
    f32x4 acc[2][2][4][2];
    float zf = 0.f; if constexpr (F8) asm volatile("" : "+v"(zf));
#pragma unroll
    for (int a = 0; a < 2; ++a)
#pragma unroll
        for (int b = 0; b < 2; ++b)
#pragma unroll
            for (int m = 0; m < 4; ++m)
#pragma unroll
                for (int n = 0; n < 2; ++n) acc[a][b][m][n] = (f32x4){zf, zf, zf, zf};
    bf16x8 At[4][2], B0[2][2], B1[2][2];
    const char* cA = (const char*)g.A + (size_t)cur.pm * tstep; const char* cB = (const char*)g.Bt + S.boff(cur) + (size_t)cur.pn * tstep;
    S.a_ready(cur);
    if constexpr (SP2) {
        PG8_STAGE(PG8_SB(0, 0), cB, voffB); PG8_STAGE(PG8_SB(0, 1), cB + hstep, voffB); PG8_STAGE(PG8_SA(0, 0), cA, voffA); PG8_STAGE(PG8_SA(0, 1), cA + hstep, voffA);
        if (wr == 1) PG8_BAR;
        PG8_WAIT_V(2); PG8_BAR;
        PG8_STAGE(PG8_SB(1, 0), cB + kstep, voffB); PG8_STAGE(PG8_SA(1, 0), cA + kstep, voffA); PG8_STAGE(PG8_SB(1, 1), cB + hstep + kstep, voffB);
        PG8_WAIT_V(6); PG8_BAR;
    } else {
        PG8_STAGE(PG8_SB(0, 0), cB, voffB); PG8_STAGE(PG8_SA(0, 0), cA, voffA); PG8_STAGE(PG8_SB(0, 1), cB + hstep, voffB); PG8_STAGE(PG8_SA(0, 1), cA + hstep, voffA);
        if (wr == 1) PG8_BAR;
        PG8_WAIT_V(4); PG8_BAR;
        PG8_STAGE(PG8_SB(1, 0), cB + kstep, voffB); PG8_STAGE(PG8_SA(1, 0), cA + kstep, voffA); PG8_STAGE(PG8_SB(1, 1), cB + hstep + kstep, voffB);
        PG8_WAIT_V(6); PG8_BAR;
    }
    for (;;) {
        const bool has_next = S.next(ui + 1, nxt);
        const char* nA = has_next ? (const char*)g.A + (size_t)nxt.pm * tstep : cA; const char* nB = has_next ? (const char*)g.Bt + S.boff(nxt) + (size_t)nxt.pn * tstep : cB;
        for (int t = 0; t < nt; t += 2) {
            const bool last = (t == nt - 2);
            const char* a1 = cA + (size_t)(t + 1) * kstep;
            const char* a2 = last ? nA : cA + (size_t)(t + 2) * kstep; const char* b2 = last ? nB : cB + (size_t)(t + 2) * kstep;
            const char* a3 = a2 + kstep; const char* b3 = b2 + kstep;
            if (last && has_next) S.a_ready(nxt);
            if constexpr (SP2) {
            PG8_LDB(B0, 0, 0); PG8_LDB(B1, 0, 1); PG8_SCHED; PG8_LDA(At, 0, 0); PG8_STAGE(PG8_SA(1, 1), a1 + hstep, voffA);
            PG8_WAIT_V(8); PG8_WAIT_L(0); PG8_BAR; PG8_MMA(0, 0, At, B0); PG8_MMA(0, 1, At, B1); PG8_BAR; PG8_SCHED;
            PG8_LDA(At, 0, 1); PG8_STAGE(PG8_SB(0, 0), b2, voffB); PG8_STAGE(PG8_SB(0, 1), b2 + hstep, voffB); PG8_STAGE(PG8_SA(0, 0), a2, voffA);
            PG8_WAIT_V(8); PG8_WAIT_L(0); PG8_BAR; PG8_MMA(1, 0, At, B0); PG8_MMA(1, 1, At, B1); PG8_BAR; PG8_SCHED;
            PG8_LDB(B0, 1, 0); PG8_LDB(B1, 1, 1); PG8_SCHED; PG8_LDA(At, 1, 0); PG8_STAGE(PG8_SA(0, 1), a2 + hstep, voffA);
            PG8_WAIT_V(8); PG8_WAIT_L(0); PG8_BAR; PG8_MMA(0, 0, At, B0); PG8_MMA(0, 1, At, B1); PG8_BAR; PG8_SCHED;
            PG8_LDA(At, 1, 1); PG8_STAGE(PG8_SB(1, 0), b3, voffB); PG8_STAGE(PG8_SB(1, 1), b3 + hstep, voffB); PG8_STAGE(PG8_SA(1, 0), a3, voffA);
            PG8_WAIT_V(8); PG8_WAIT_L(0); PG8_BAR; PG8_MMA(1, 0, At, B0); PG8_MMA(1, 1, At, B1); PG8_BAR; PG8_SCHED;
            } else {
            PG8_LDB(B0, 0, 0); PG8_SCHED; PG8_LDA(At, 0, 0); PG8_STAGE(PG8_SA(1, 1), a1 + hstep, voffA);
            PG8_WAIT_L(8); PG8_BAR; PG8_WAIT_L(0); PG8_MMA(0, 0, At, B0); PG8_BAR; PG8_SCHED;
            PG8_LDB(B1, 0, 1); PG8_STAGE(PG8_SB(0, 0), b2, voffB);
            PG8_BAR; PG8_WAIT_L(0); PG8_MMA(0, 1, At, B1); PG8_BAR;
            PG8_LDA(At, 0, 1); PG8_STAGE(PG8_SA(0, 0), a2, voffA);
            PG8_BAR; PG8_WAIT_L(0); PG8_MMA(1, 0, At, B0); PG8_BAR; PG8_SCHED;
            PG8_STAGE(PG8_SB(0, 1), b2 + hstep, voffB);
            PG8_WAIT_V(6); PG8_BAR; PG8_MMA(1, 1, At, B1); PG8_BAR;
            PG8_LDB(B0, 1, 0); PG8_SCHED; PG8_LDA(At, 1, 0); PG8_STAGE(PG8_SA(0, 1), a2 + hstep, voffA);
            PG8_WAIT_L(8); PG8_BAR; PG8_WAIT_L(0); PG8_MMA(0, 0, At, B0); PG8_BAR; PG8_SCHED;
            PG8_LDB(B1, 1, 1); PG8_STAGE(PG8_SB(1, 0), b3, voffB);
            PG8_BAR; PG8_WAIT_L(0); PG8_MMA(0, 1, At, B1); PG8_BAR;
            PG8_LDA(At, 1, 1); PG8_STAGE(PG8_SA(1, 0), a3, voffA);
            PG8_BAR; PG8_WAIT_L(0); PG8_MMA(1, 0, At, B0); PG8_BAR; PG8_SCHED;
            PG8_STAGE(PG8_SB(1, 1), b3 + hstep, voffB);
            PG8_WAIT_V(6); PG8_BAR; PG8_MMA(1, 1, At, B1); PG8_BAR;
            }
        }
        if constexpr (ALIGN_EPI) { if (wr == 0) PG8_BAR; }
        if constexpr (F8) asm volatile("s_nop 15\n\ts_nop 15" ::: "memory");
        { const int le = fresh_lane(); E(acc, cur, wr, wc, le & 15, le >> 4); }
        S.done(cur);
        if (!has_next) break;
#pragma unroll
        for (int a = 0; a < 2; ++a)
#pragma unroll
            for (int b = 0; b < 2; ++b)
#pragma unroll
                for (int m = 0; m < 4; ++m)
#pragma unroll
                    for (int n = 0; n < 2; ++n) acc[a][b][m][n] = (f32x4){zf, zf, zf, zf};
        cur = nxt; cA = nA; cB = nB; ++ui;
        if constexpr (ALIGN_EPI) { if (wr == 1) PG8_BAR; }
    }
    PG8_WAIT_V(0);
    if constexpr (!ALIGN_EPI) { if (wr == 0) PG8_BAR; }
    PG8_BAR;
#undef PG8_SA
#undef PG8_SB
#undef PG8_STAGE
#undef PG8_LDA
#undef PG8_LDB
#undef PG8_MMA
#undef PG8_WAIT_V
#undef PG8_WAIT_L
#undef PG8_BAR
#undef PG8_SCHED
}

struct EpiInProj {
    static constexpr bool PERM = true;
    bf16_t *U, *RKV, *HY, *LORA, *GL;
    __device__ __forceinline__ void operator()(const f32x4 (&acc)[2][2][4][2], const Unit& u, int wr, int wc, int fr, int fq) const {
        const int pn = u.pn; bf16_t* base; int ld, c0, a0 = 0; bool skip1 = false;
        if (pn == 0) { base = U; ld = 256; c0 = 0; }
        else if (pn <= 6) { base = RKV; ld = 1536; c0 = (pn - 1) * 256; }
        else if (pn <= 9) { base = HY; ld = 768; c0 = (pn - 7) * 256; }
        else if (pn == 10) { base = LORA; ld = 256; c0 = 0; a0 = 1; }
        else { base = GL; ld = 256; c0 = 0; a0 = 2; }
        const int row0 = u.pm * BM + wr * 64 + fr, col = c0 + wc * 32 + 8 * fq;
#pragma unroll
        for (int ai = 0; ai < 2; ++ai)
#pragma unroll
            for (int m = 0; m < 4; ++m) { bf16_t* rowp = base + (size_t)(row0 + ai * HALF + m * 16) * ld + col;
                { f32x4 v0 = acc[ai][0][m][0], v1 = acc[ai][0][m][1];
                  if (a0 == 1) { v0 = act4<1>(v0); v1 = act4<1>(v1); } else if (a0 == 2) { v0 = act4<2>(v0); v1 = act4<2>(v1); }
                  *(u32x4*)(rowp) = pack8(v0, v1); }
                if (!skip1) *(u32x4*)(rowp + HALF) = pack8(acc[ai][1][m][0], acc[ai][1][m][1]); }
    }
};
template <int ACT> struct EpiBf16 {
    static constexpr bool PERM = true;
    bf16_t* O; int ld;
    __device__ __forceinline__ void operator()(const f32x4 (&acc)[2][2][4][2], const Unit& u, int wr, int wc, int fr, int fq) const {
        const int row0 = u.pm * BM + wr * 64 + fr, col = u.pn * BM + wc * 32 + 8 * fq;
#pragma unroll
        for (int ai = 0; ai < 2; ++ai)
#pragma unroll
            for (int m = 0; m < 4; ++m) { bf16_t* rowp = O + (size_t)(row0 + ai * HALF + m * 16) * ld + col;
#pragma unroll
                for (int bj = 0; bj < 2; ++bj) *(u32x4*)(rowp + bj * HALF) = pack8(act4<ACT>(acc[ai][bj][m][0]), act4<ACT>(acc[ai][bj][m][1])); }
    }
};
template <int MODE> struct EpiComb {
    static constexpr bool PERM = true;
    bf16_t* O; const bf16_t* G; int ld; int ldg; int glin;
    __device__ __forceinline__ void operator()(const f32x4 (&acc)[2][2][4][2], const Unit& u, int wr, int wc, int fr, int fq) const {
        const int row0 = u.pm * BM + wr * 64 + fr, col = u.pn * BM + wc * 32 + 8 * fq; const int lg = ldg ? ldg : ld;
        constexpr bool RG = (MODE == 0 || MODE == 1 || MODE == 4), RO = (MODE == 1 || MODE == 3);
#pragma unroll
        for (int ai = 0; ai < 2; ++ai) {
            u32x4 gv[4][2], ov[4][2];
#pragma unroll
            for (int m = 0; m < 4; ++m) { const size_t off = (size_t)(row0 + ai * HALF + m * 16) * ld + col, offg = (size_t)(row0 + ai * HALF + m * 16) * lg + col;
#pragma unroll
                for (int bj = 0; bj < 2; ++bj) {
                    if (RG) gv[m][bj] = glin ? ((const u32x4*)G)[((size_t)(u.pm * (lg / BM) + glin - 1 + u.pn) * 16 + ai * 8 + m * 2 + bj) * 512 + (wr * 4 + wc) * 64 + fq * 16 + fr] : *(const u32x4*)(G + offg + bj * HALF);
                    if (RO) ov[m][bj] = *(const u32x4*)(O + off + bj * HALF); } }
#pragma unroll
            for (int m = 0; m < 4; ++m) { const size_t off = (size_t)(row0 + ai * HALF + m * 16) * ld + col;
#pragma unroll
                for (int bj = 0; bj < 2; ++bj) { f32x4 v0 = acc[ai][bj][m][0], v1 = acc[ai][bj][m][1];
                    if (RG) { f32x4 g0, g1; unpack8(gv[m][bj], g0, g1);
                        if (MODE == 4) { v0 = g0 * act4<2>(v0); v1 = g1 * act4<2>(v1); } else { v0 = v0 * g0; v1 = v1 * g1; } }
                    if (RO) { f32x4 o0, o1; unpack8(ov[m][bj], o0, o1); v0 = v0 + o0; v1 = v1 + o1; }
                    *(u32x4*)(O + off + bj * HALF) = pack8(v0, v1); } }
            asm volatile("" ::: "memory"); }
    }
};
struct EpiF32 {
    static constexpr bool PERM = false;
    float* C; int ldc;
    __device__ __forceinline__ void operator()(const f32x4 (&acc)[2][2][4][2], const Unit& u, int wr, int wc, int fr, int fq) const {
        const int row0 = u.pm * BM + wr * 64 + fr, col0 = u.pn * BM + wc * 32 + 4 * fq;
#pragma unroll
        for (int ai = 0; ai < 2; ++ai)
#pragma unroll
            for (int m = 0; m < 4; ++m) { float* rowp = C + (size_t)(row0 + ai * HALF + m * 16) * ldc + col0;
#pragma unroll
                for (int bj = 0; bj < 2; ++bj)
#pragma unroll
                    for (int n = 0; n < 2; ++n) *(f32x4*)(rowp + bj * HALF + n * 16) = acc[ai][bj][m][n]; }
    }
};
struct EpiSwiGLU {
    static constexpr bool PERM = true;
    bf16_t* O; int ld;
    __device__ __forceinline__ void operator()(const f32x4 (&acc)[2][2][4][2], const Unit& u, int wr, int wc, int fr, int fq) const {
        const int row0 = u.pm * BM + wr * 64 + fr, col = u.pn * HALF + wc * 32 + 8 * fq;
#pragma unroll
        for (int ai = 0; ai < 2; ++ai)
#pragma unroll
            for (int m = 0; m < 4; ++m) { f32x4 v[2];
#pragma unroll
                for (int n = 0; n < 2; ++n) { const f32x4 gt = acc[ai][0][m][n], up = acc[ai][1][m][n];
#pragma unroll
                    for (int j = 0; j < 4; ++j) v[n][j] = gt[j] * sigmoidf_(gt[j]) * up[j]; }
                *(u32x4*)(O + (size_t)(row0 + ai * HALF + m * 16) * ld + col) = pack8(v[0], v[1]); }
    }
};
struct EpiSig8 {
    static constexpr bool PERM = true;
    bf16_t* O; int ld; float s;
    __device__ __forceinline__ void operator()(const f32x4 (&acc)[2][2][4][2], const Unit& u, int wr, int wc, int fr, int fq) const {
        const int tid = (wr * 4 + wc) * 64 + fq * 16 + fr; u32x4* Ot = (u32x4*)O + (size_t)(u.pm * (ld / BM) + u.pn) * 16 * 512 + tid;
#pragma unroll
        for (int ai = 0; ai < 2; ++ai)
#pragma unroll
            for (int m = 0; m < 4; ++m)
#pragma unroll
                for (int bj = 0; bj < 2; ++bj) Ot[(ai * 8 + m * 2 + bj) * 512] = pack8(act4<2>(acc[ai][bj][m][0] * s), act4<2>(acc[ai][bj][m][1] * s));
    }
};
struct EpiF8Out {
    static constexpr bool PERM = true;
    unsigned char* O; int ld; float s;
    __device__ __forceinline__ void operator()(const f32x4 (&acc)[2][2][4][2], const Unit& u, int wr, int wc, int fr, int fq) const {
        const int row0 = u.pm * BM + wr * 64 + fr, col = u.pn * BM + wc * 32 + 8 * fq;
#pragma unroll
        for (int ai = 0; ai < 2; ++ai)
#pragma unroll
            for (int m = 0; m < 4; ++m) { unsigned char* rowp = O + (size_t)(row0 + ai * HALF + m * 16) * ld + col;
#pragma unroll
                for (int bj = 0; bj < 2; ++bj) { const f32x4 v0 = acc[ai][bj][m][0], v1 = acc[ai][bj][m][1]; u32x2 w;
                    w.x = cvt4_fp8(v0[0], v0[1], v0[2], v0[3], s); w.y = cvt4_fp8(v1[0], v1[1], v1[2], v1[3], s); *(u32x2*)(rowp + bj * HALF) = w; } }
    }
};
struct EpiSwiGLU8 {
    static constexpr bool PERM = true;
    unsigned char* O; int ld;
    __device__ __forceinline__ void operator()(const f32x4 (&acc)[2][2][4][2], const Unit& u, int wr, int wc, int fr, int fq) const {
        const int row0 = u.pm * BM + wr * 64 + fr, col = u.pn * HALF + wc * 32 + 8 * fq;
#pragma unroll
        for (int ai = 0; ai < 2; ++ai)
#pragma unroll
            for (int m = 0; m < 4; ++m) { f32x4 v[2];
#pragma unroll
                for (int n = 0; n < 2; ++n) { const f32x4 gt = acc[ai][0][m][n], up = acc[ai][1][m][n];
#pragma unroll
                    for (int j = 0; j < 4; ++j) { const float gj = gt[j] * (1.f / 8192.f); v[n][j] = gj * sigmoidf_(gj) * up[j]; } }
                u32x2 w; w.x = cvt4_fp8(v[0][0], v[0][1], v[0][2], v[0][3], 1.f / 1024.f); w.y = cvt4_fp8(v[1][0], v[1][1], v[1][2], v[1][3], 1.f / 1024.f);
                *(u32x2*)(O + (size_t)(row0 + ai * HALF + m * 16) * ld + col) = w; }
    }
};
}

constexpr int DM = 1024, NBATCH = 8, SEQL = 4096, CTXL = 256, NLAYER = 2;
constexpr int ML = NBATCH * SEQL, MC = NBATCH * CTXL, MT = ML + MC;
constexpr int IN_COLS = 6016, INP_N = 3072;
constexpr int FFH = 2816, EXH = 3584, NEXP = 8, EXQ = 3584;
constexpr int MOE_CAP = 2 * ML + NEXP * 256;
constexpr int NCHAIN = 68;
constexpr int NWAVES = 8, NTHR = 512;

constexpr size_t KiB = 1024, MiB = 1u << 20;
constexpr size_t WS_CTL = 0, CTL_ZERO_BYTES = 128 * KiB;
constexpr size_t WS_MODV = 256 * KiB;
constexpr size_t WS_S5TAB = 768 * KiB;
constexpr size_t WS_MOEMETA = 1408 * KiB;
constexpr size_t WS_HFILTC = 2304 * KiB;
constexpr size_t WS_W_LORA = 3328 * KiB;
constexpr size_t WS_W_IN = 4 * MiB;
constexpr size_t WS_W_GATE = 16 * MiB;
constexpr size_t WS_W_BR = 28 * MiB;
constexpr size_t WS_W_OUT = 32 * MiB;
constexpr size_t WS_W_GLU = 36 * MiB;
constexpr size_t WS_W_G2 = 36 * MiB + 256 * KiB;
constexpr size_t WS_W_FGU = 37 * MiB;
constexpr size_t WS_W_FD = 48 * MiB;
constexpr size_t WS_S5TAB2 = 53 * MiB + 512 * KiB;
constexpr size_t WS_H = 54 * MiB;
constexpr size_t WS_U = 122 * MiB;
constexpr size_t WS_RKV = 139 * MiB;
constexpr size_t WS_LORA = 241 * MiB;
constexpr size_t WS_GL = 258 * MiB;
constexpr size_t WS_HY = 275 * MiB;
constexpr size_t WS_HYT = 326 * MiB;
constexpr size_t WS_HFILT = 374 * MiB;
constexpr size_t WS_KSPEC = 390 * MiB;
constexpr size_t WS_E = 422 * MiB;
constexpr size_t WS_CIN = 430 * MiB + 512 * KiB;
constexpr size_t WS_YPRE = 439 * MiB;
constexpr size_t WS_S5OUT = 456 * MiB;
constexpr size_t WS_HYOT = 473 * MiB;
constexpr size_t WS_HYOUT = 489 * MiB;
constexpr size_t WS_RWOUT = 506 * MiB;
constexpr size_t WS_CBON = 540 * MiB;
constexpr size_t WS_CTXX = 542 * MiB + 256 * KiB;
constexpr size_t WS_YD = 550 * MiB + 256 * KiB;
constexpr size_t WS_END = 619 * MiB;
constexpr size_t WS_XS_A = 4 * MiB, WS_XS_B = 601 * MiB; constexpr int XS_ROWS_A = 25600;
constexpr size_t WS_H8 = 413 * MiB;
constexpr size_t WS_RWG = WS_RWOUT;
constexpr size_t WS_RA = WS_HY;
constexpr size_t WS_SC = WS_RA + 104 * MiB;
constexpr size_t RA_UNIT = 24832;
constexpr size_t WS_G = WS_U;
constexpr size_t WS_MB = WS_HYT;
constexpr size_t WS_YF = WS_HYT + 68 * MiB;
constexpr size_t WS_ACT = WS_U;
constexpr size_t WS_XB = 88 * MiB;
constexpr size_t WS_ACTQ = 154 * MiB;
constexpr size_t WS_YB = 385 * MiB;
constexpr size_t WS_MOEW = 517 * MiB;
static_assert(WS_W_FD + (size_t)1024 * FFH * 2 <= WS_H, "W");
static_assert(WS_RA + (size_t)4 * 8 * 2 * NCHAIN * RA_UNIT <= WS_SC && WS_SC + (size_t)4 * 8 * 2 * NCHAIN * 8192 <= WS_E, "RA");
static_assert(WS_G + (size_t)MT * 3072 * 2 <= WS_HYT && WS_MB + (size_t)MT * 1024 * 2 <= WS_YF, "G/MB");
static_assert(WS_YF + (size_t)MT * 1024 * 2 <= WS_HYOT, "YF");
static_assert(WS_ACT + (size_t)MT * FFH * 2 <= WS_HYT, "ACT");
static_assert((size_t)ML * 1024 + WS_H <= WS_XB && WS_XB + (size_t)MOE_CAP * 1024 <= WS_ACTQ && WS_ACTQ + (size_t)MOE_CAP * EXQ <= WS_YB && WS_YB + (size_t)MOE_CAP * 1024 * 2 <= WS_MOEW, "MoE buffers");
static_assert(WS_MOEW + (size_t)8 * 7168 * 1024 + (size_t)8 * 1024 * 3584 <= WS_END, "MOEW");
static_assert(WS_YD + (size_t)2 * MT * 512 * 2 <= WS_END, "YD");
static_assert(WS_SC + (size_t)4 * 8 * 2 * NCHAIN * 8192 <= WS_H8 && WS_H8 + (size_t)MT * 1024 <= WS_S5OUT, "H8");
constexpr int CW_BAR = 4096;
constexpr int CW_MOECNT = 16384;

constexpr int LDS_BYTES = 147456;
constexpr int LDS_XB = LDS_BYTES - 16;

#define XB_TMO      128
#define XB_XCNT(j)  (256  + 64 * (j))
#define XB_XSUB(j)  (1280 + 64 * (j))
#define XB_XGEN(j)  (2304 + 64 * (j))
#define XB_TOP      3328
#define XB_TOPGEN   3392
#define XCD_BAR_WORDS 3456
#define XB_SPIN_CAP (1u << 18)

__device__ __forceinline__ unsigned xb_ld(unsigned* p)              { return __hip_atomic_load(p, __ATOMIC_RELAXED, __HIP_MEMORY_SCOPE_AGENT); }
__device__ __forceinline__ unsigned xb_add(unsigned* p, unsigned v) { return __hip_atomic_fetch_add(p, v, __ATOMIC_RELAXED, __HIP_MEMORY_SCOPE_AGENT); }
__device__ __forceinline__ unsigned xb_xcc_id() { return (unsigned)__builtin_amdgcn_s_getreg((3 << 11) | 20) & 0xFu; }
#define XB_SPIN(cond, bar) do { unsigned _sp = 0; while (cond) { __builtin_amdgcn_s_sleep(1); \
    if ((++_sp & 255u) == 0u) { if (xb_ld(&(bar)[XB_TMO])) break; if (_sp > XB_SPIN_CAP) { atomicAdd(&(bar)[XB_TMO], 1u); break; } } } } while (0)

struct XcdBarrier { unsigned* bar; unsigned x; volatile LAS unsigned* st; };

__device__ __forceinline__ XcdBarrier xcd_barrier_post(unsigned* bar, volatile LAS unsigned* st, int wave_s) {
    XcdBarrier b; b.bar = bar; b.x = xb_xcc_id(); b.st = st;
    if (wave_s == 0 && fresh_lane() == 0) (void)xb_add(&bar[XB_XCNT(b.x)], 1u);
    return b;
}
__device__ __forceinline__ void xcd_barrier_complete(unsigned* bar, unsigned x, unsigned& nloc, unsigned& nx) {
    const unsigned G = gridDim.x * gridDim.y * gridDim.z;
    unsigned sum, cnt, mine, sp = 0u;
    for (;;) {
        sum = 0u; cnt = 0u; mine = 0u;
#pragma unroll
        for (unsigned j = 0; j < 16; ++j) { const unsigned c = xb_ld(&bar[XB_XCNT(j)]); sum += c; cnt += (c > 0u) ? 1u : 0u; mine = (j == x) ? c : mine; }
        if (sum == G) break;
        __builtin_amdgcn_s_sleep(1);
        if ((++sp & 255u) == 0u) { if (xb_ld(&bar[XB_TMO])) break; if (sp > XB_SPIN_CAP) { atomicAdd(&bar[XB_TMO], 1u); break; } }
    }
    nloc = mine > 0u ? mine : 1u; nx = cnt > 0u ? cnt : 1u;
}
__device__ __forceinline__ void xcd_barrier(const XcdBarrier& b, int wave_s, unsigned* bar) {
    asm volatile("s_waitcnt vmcnt(0)" ::: "memory");
    __syncthreads();
    if (wave_s == 0 && fresh_lane() == 0) {
        __builtin_amdgcn_s_waitcnt(0);
        unsigned nloc = b.st[0], nx = b.st[1];
        if (nloc == 0u) { xcd_barrier_complete(bar, b.x, nloc, nx); b.st[0] = nloc; b.st[1] = nx; }
        const unsigned old = xb_add(&bar[XB_XSUB(b.x)], 1u);
        const unsigned gen = old / nloc;
        if (old + 1u == (gen + 1u) * nloc) {
            __builtin_amdgcn_fence(__ATOMIC_RELEASE, "agent");
            asm volatile("s_waitcnt vmcnt(0)" ::: "memory");
            const unsigned og = xb_add(&bar[XB_TOP], 1u);
            const unsigned tg = og / nx;
            if (og + 1u == (tg + 1u) * nx) xb_add(&bar[XB_TOPGEN], 1u);
            else XB_SPIN(xb_ld(&bar[XB_TOPGEN]) == tg, bar);
            __builtin_amdgcn_fence(__ATOMIC_ACQUIRE, "agent");
            xb_add(&bar[XB_XGEN(b.x)], 1u);
            asm volatile("s_waitcnt vmcnt(0)" ::: "memory");
        } else {
            XB_SPIN(xb_ld(&bar[XB_XGEN(b.x)]) == gen, bar);
            __builtin_amdgcn_fence(__ATOMIC_ACQUIRE, "agent");
            asm volatile("s_waitcnt vmcnt(0)" ::: "memory");
        }
    }
    __syncthreads();
}
__device__ __forceinline__ void block_self_sync() {
    asm volatile("s_waitcnt vmcnt(0)" ::: "memory");
    __syncthreads();
    __builtin_amdgcn_fence(__ATOMIC_ACQUIRE, "agent");
    asm volatile("s_waitcnt vmcnt(0)" ::: "memory");
    __syncthreads();
}

struct Params { const float* in[49]; float* out; unsigned char* ws; int ph_lo, ph_hi; };
#define CAS __attribute__((address_space(4)))
struct KA { const CAS unsigned char* p;
    __device__ __forceinline__ const float* in(int i) const { return *(const float* const CAS*)(p + 8 * i); }
    __device__ __forceinline__ float* out() const { return *(float* const CAS*)(p + 8 * 49); }
    __device__ __forceinline__ unsigned char* ws() const { return *(unsigned char* const CAS*)(p + 8 * 50); }
    __device__ __forceinline__ int ph_lo() const { return *(const int CAS*)(p + 8 * 51); }
    __device__ __forceinline__ int ph_hi() const { return *(const int CAS*)(p + 8 * 51 + 4); } };
static_assert(sizeof(Params) == 8 * 51 + 8, "Params layout");
enum { I_X = 0, I_C, I_CTX, I_CCTX, I_MODW, I_MODB, I_NORMG, I_INW, I_S5LRE, I_S5LIM, I_S5STEP, I_S5BRE, I_S5BIM, I_S5CRE, I_S5CIM, I_S5D, I_S5GLU,
       I_RWCONV, I_RWW0, I_RWW2, I_RWA0, I_RWA2, I_RWG2, I_RWKK, I_RWKA, I_RWRK, I_RWLNW, I_RWLNB, I_HYCONVW, I_HYCONVB, I_HYFW1, I_HYFB1, I_HYFF1, I_HYFW2, I_HYFB2, I_HYFF2,
       I_HYFW3, I_HYBIAS, I_BRS5, I_BRRW, I_BRHY, I_OUTW, I_FFNWG, I_FFNWU, I_FFNWD, I_MOER, I_MOEWG, I_MOEWU, I_MOEWD };

struct Frame { LAS unsigned char* lds; int tid, lane, wave, bid, G, gw, NGW; };
#define LDS_WAIT() asm volatile("s_waitcnt lgkmcnt(0)" ::: "memory")

__device__ __forceinline__ void wt_item(const float* W, int ldn, int k0, int n0, bf16_t* dst, int ldd, LAS float* scr, int lane) {
    { float tv[32];
#pragma unroll
      for (int i = 0; i < 32; ++i) tv[i] = W[(size_t)(k0 + 2 * i + (lane >> 5)) * ldn + n0 + (lane & 31)];
#pragma unroll
      for (int i = 0; i < 32; ++i) scr[(2 * i + (lane >> 5)) * 33 + (lane & 31)] = tv[i]; }
    LDS_WAIT();
    const int c = lane & 7;
#pragma unroll
    for (int j = 0; j < 4; ++j) { const int n = (lane >> 3) + 8 * j; const LAS float* s = scr + (8 * c) * 33 + n;
        u32x4 o; o.x = cvt_pk_bf16(s[0 * 33], s[1 * 33]); o.y = cvt_pk_bf16(s[2 * 33], s[3 * 33]); o.z = cvt_pk_bf16(s[4 * 33], s[5 * 33]); o.w = cvt_pk_bf16(s[6 * 33], s[7 * 33]);
        *(u32x4*)(dst + (size_t)n * ldd + 8 * c) = o; }
    LDS_WAIT();
}
__device__ __forceinline__ void wt_job(int r, const float* W, int ldn, int nbc, int nbeg, bf16_t* D, int ldd, int drow0, int il, int krow0, LAS float* scr, int lane) {
    const int kb = r / nbc, nb = r % nbc, rel = 32 * nb;
    const int drow = drow0 + (il ? 256 * (rel / 128) + (rel % 128) : rel);
    wt_item(W + (size_t)krow0 * ldn, ldn, 64 * kb, nbeg + rel, D + (size_t)drow * ldd + 64 * kb, ldd, scr, lane);
}

__device__ __forceinline__ void wt_item8(const float* W, int ldn, int k0, int n0, unsigned char* dst, int ldd, LAS float* scr, int lane) {
    { float tv[32];
#pragma unroll
      for (int i = 0; i < 32; ++i) tv[i] = W[(size_t)(k0 + 2 * i + (lane >> 5)) * ldn + n0 + (lane & 31)];
#pragma unroll
      for (int i = 0; i < 32; ++i) scr[(2 * i + (lane >> 5)) * 33 + (lane & 31)] = tv[i]; }
    LDS_WAIT();
    const int c = lane & 7;
#pragma unroll
    for (int j = 0; j < 4; ++j) { const int n = (lane >> 3) + 8 * j; const LAS float* s = scr + (8 * c) * 33 + n;
        u32x2 o; o.x = cvt4_fp8(s[0 * 33], s[1 * 33], s[2 * 33], s[3 * 33], 512.f); o.y = cvt4_fp8(s[4 * 33], s[5 * 33], s[6 * 33], s[7 * 33], 512.f);
        *(u32x2*)(dst + (size_t)n * ldd + 8 * c) = o; }
    LDS_WAIT();
}
__device__ __forceinline__ void wt_job8(int r, const float* W, int ldn, int nbc, int nbeg, unsigned char* D, int ldd, int drow0, int il, int krow0, LAS float* scr, int lane) {
    const int kb = r / nbc, nb = r % nbc, rel = 32 * nb;
    const int drow = drow0 + (il ? 256 * (rel / 128) + (rel % 128) : rel);
    wt_item8(W + (size_t)krow0 * ldn, ldn, 64 * kb, nbeg + rel, D + (size_t)drow * ldd + 64 * kb, ldd, scr, lane);
}

__device__ __forceinline__ void p0_prologue(const Frame& F, const KA& P) {
    unsigned char* ws = P.ws();
    {
        LAS float* sc = (LAS float*)F.lds;
        LAS float* part = (LAS float*)(F.lds + 40960);
        for (int i = F.tid; i < 9 * 1024; i += NTHR) { const float v = (i < 8192) ? P.in(I_C)[i] : P.in(I_CCTX)[i - 8192]; sc[i] = v * sigmoidf_(v); }
        __syncthreads();
        const int colbase = F.bid * 48;
        if (F.tid < 384 && colbase < 12288) {
            const int c4 = F.tid % 12, kq = F.tid / 12, col = colbase + 4 * c4, l = col / 6144, j = col % 6144;
            const f32x4* W = (const f32x4*)(P.in(I_MODW) + (size_t)l * 1024 * 6144 + j);
            f32x4 a[9];
#pragma unroll
            for (int r = 0; r < 9; ++r) a[r] = (f32x4){0.f, 0.f, 0.f, 0.f};
#pragma unroll 1
            for (int half = 0; half < 4; ++half) {
                f32x4 wv[8]; const f32x4* Wh = W + (size_t)(kq + 256 * half) * 1536;
#pragma unroll
                for (int u = 0; u < 8; ++u) wv[u] = Wh[(size_t)(32 * u) * 1536];
#pragma unroll
                for (int u = 0; u < 8; ++u) { const int k = kq + 32 * (8 * half + u);
#pragma unroll
                    for (int r = 0; r < 9; ++r) a[r] += wv[u] * sc[r * 1024 + k]; }
            }
#pragma unroll
            for (int r = 0; r < 9; ++r) *(LAS f32x4*)(part + (kq * 9 + r) * 48 + 4 * c4) = a[r];
        }
        __syncthreads();
        if (F.tid < 432 && colbase < 12288) { const int r = F.tid / 48, cl = F.tid % 48, col = colbase + cl, l = col / 6144, j = col % 6144; float s = P.in(I_MODB)[l * 6144 + j];
#pragma unroll 8
            for (int kq = 0; kq < 32; ++kq) s += part[(kq * 9 + r) * 48 + cl];
            ((float*)(ws + WS_MODV))[((size_t)l * 9 + r) * 6144 + j] = s; }
        __syncthreads();
    }
    if (F.gw < 64) {
        const int ldg = F.gw, p = F.lane;
        const float lr = P.in(I_S5LRE)[ldg * 64 + p], li = P.in(I_S5LIM)[ldg * 64 + p], step = expf(P.in(I_S5STEP)[ldg]);
        const float mag = expf(lr * step), ang = li * step, ar = mag * cosf(ang), ai = mag * sinf(ang);
        const float den = lr * lr + li * li, nr = ar - 1.0f, ni = ai;
        const float qr = (nr * lr + ni * li) / den, qi = (ni * lr - nr * li) / den;
        float* T = (float*)(ws + WS_S5TAB) + (size_t)ldg * 2304;
        T[p] = ar; T[64 + p] = ai;
        float pr = ar, pi = ai;
#pragma unroll
        for (int s = 0; s < 6; ++s) { const float t = pr * pr - pi * pi; pi = 2.f * pr * pi; pr = t; }
        T[128 + p] = pr; T[192 + p] = pi;
        const float* br = P.in(I_S5BRE) + ((size_t)ldg * 64 + p) * 16; const float* bi = P.in(I_S5BIM) + ((size_t)ldg * 64 + p) * 16;
#pragma unroll
        for (int i = 0; i < 16; ++i) { T[256 + p * 16 + i] = qr * br[i] - qi * bi[i]; T[1280 + p * 16 + i] = qr * bi[i] + qi * br[i]; }
        bf16_t* T2 = (bf16_t*)(ws + WS_S5TAB2) + (size_t)ldg * 4096;
        const float* cre = P.in(I_S5CRE) + (size_t)ldg * 1024; const float* cim = P.in(I_S5CIM) + (size_t)ldg * 1024;
#pragma unroll
        for (int i = 0; i < 16; ++i) { T2[p * 16 + i] = f2bf(qr * br[i] - qi * bi[i]); T2[(64 + p) * 16 + i] = f2bf(qr * bi[i] + qi * br[i]);
            T2[2048 + i * 128 + 2 * p] = f2bf(cre[i * 64 + p]); T2[2048 + i * 128 + 2 * p + 1] = f2bf(-cim[i * 64 + p]); }
    }
    LAS float* scr = (LAS float*)(F.lds + F.wave * 16384);
    constexpr int PER_LAYER = 896 + 384 + 192 + 1536 + 128 + 256 + 128 + 512 + 32 + 32 + 64;
    constexpr int NITEMS = 2 * PER_LAYER + 3 * 1408;
    for (int it = F.gw; it < NITEMS; it += F.NGW) {
        int r = it;
        if (r < 2 * PER_LAYER) {
            const int l = r / PER_LAYER; r -= l * PER_LAYER;
            const float* inw = P.in(I_INW) + (size_t)l * 1024 * IN_COLS;
            bf16_t* Win = (bf16_t*)(ws + WS_W_IN) + (size_t)l * INP_N * 1024; unsigned char* Wg = ws + WS_W_GATE + (size_t)l * 3072 * 1024;
            bf16_t* Wbr = (bf16_t*)(ws + WS_W_BR + (size_t)l * 2 * MiB);
            if (r < 896) { wt_job(r, inw, IN_COLS, 56, 0, Win, 1024, 0, 0, 0, scr, F.lane); continue; } r -= 896;
            if (r < 384) { wt_job(r, inw, IN_COLS, 24, 2176, Win, 1024, 1792, 0, 0, scr, F.lane); continue; } r -= 384;
            if (r < 192) { wt_job(r, inw, IN_COLS, 12, 1792, Win, 1024, 2560, 0, 0, scr, F.lane); continue; } r -= 192;
            if (r < 1536) { wt_job8(r, inw, IN_COLS, 96, 2944, Wg, 1024, 0, 0, 0, scr, F.lane); continue; } r -= 1536;
            if (r < 128) { wt_job(r, P.in(I_BRS5) + (size_t)l * 256 * 1024, 1024, 32, 0, Wbr, 256, 0, 0, 0, scr, F.lane); continue; } r -= 128;
            if (r < 256) { wt_job(r, P.in(I_BRRW) + (size_t)l * 512 * 1024, 1024, 32, 0, Wbr + 1024 * 256, 512, 0, 0, 0, scr, F.lane); continue; } r -= 256;
            if (r < 128) { wt_job(r, P.in(I_BRHY) + (size_t)l * 256 * 1024, 1024, 32, 0, Wbr + 1024 * 256 + 1024 * 512, 256, 0, 0, 0, scr, F.lane); continue; } r -= 128;
            if (r < 512) { wt_job(r, P.in(I_OUTW) + (size_t)l * 1024 * 1024, 1024, 32, 0, (bf16_t*)(ws + WS_W_OUT) + (size_t)l * 1024 * 1024, 1024, 0, 0, 0, scr, F.lane); continue; } r -= 512;
            if (r < 32) { wt_job(r, P.in(I_S5GLU) + (size_t)l * 256 * 256, 256, 8, 0, (bf16_t*)(ws + WS_W_GLU) + (size_t)l * 256 * 256, 256, 0, 0, 0, scr, F.lane); continue; } r -= 32;
            if (r >= 32) { r -= 32;
                const int dd = r >> 5, which = (r >> 4) & 1, it2 = r & 15;
                wt_job(it2, (which ? P.in(I_RWA2) : P.in(I_RWW2)) + (size_t)(l * 2 + dd) * 64 * 512, 512, 16, 0, (bf16_t*)(ws + WS_W_LORA) + (size_t)((l * 2 + dd) * 2 + which) * 512 * 64, 64, 0, 0, 0, scr, F.lane);
                continue; }
            { bf16_t* G2 = (bf16_t*)(ws + WS_W_G2) + (size_t)l * 512 * 256;
              wt_job(r, P.in(I_RWG2) + (size_t)l * 128 * 512, 512, 16, 0, G2, 256, 0, 0, 0, scr, F.lane);
              const int nb = r % 16, kb = r / 16;
              for (int i = F.lane; i < 32 * 8; i += 64) *(u32x4*)(G2 + (size_t)(32 * nb + (i >> 3)) * 256 + 128 + 64 * kb + (i & 7) * 8) = (u32x4){0u, 0u, 0u, 0u}; }
            continue;
        }
        r -= 2 * PER_LAYER;
        if (r < 1408) { wt_job(r, P.in(I_FFNWG), FFH, 88, 0, (bf16_t*)(ws + WS_W_FGU), 1024, 0, 1, 0, scr, F.lane); continue; } r -= 1408;
        if (r < 1408) { wt_job(r, P.in(I_FFNWU), FFH, 88, 0, (bf16_t*)(ws + WS_W_FGU), 1024, 128, 1, 0, scr, F.lane); continue; } r -= 1408;
        wt_job(r, P.in(I_FFNWD), 1024, 32, 0, (bf16_t*)(ws + WS_W_FD), FFH, 0, 0, 0, scr, F.lane);
    }
}
__device__ __forceinline__ void moe_convert_quarter(const Frame& F, const KA& P, int q, int which) {
    LAS float* scr = (LAS float*)(F.lds + F.wave * 16384);
    unsigned char* Wgu = P.ws() + WS_MOEW; unsigned char* Wd = Wgu + (size_t)8 * 2 * EXQ * 1024;
    constexpr int NGU = (EXQ / 32) * 16, ND = 32 * (EXQ / 64);
#pragma unroll 1
    for (int it = F.gw; it < 8 * (2 * NGU + ND); it += F.NGW) {
        const int e = it / (2 * NGU + ND); int r = it % (2 * NGU + ND);
        const float* wg = P.in(I_MOEWG) + (size_t)e * 1024 * EXH; const float* wu = P.in(I_MOEWU) + (size_t)e * 1024 * EXH; const float* wd = P.in(I_MOEWD) + (size_t)e * EXH * 1024;
        if (r < NGU) { if (which & 1) wt_job8(r, wg, EXH, EXQ / 32, q * EXQ, Wgu + (size_t)e * 2 * EXQ * 1024, 1024, 0, 1, 0, scr, F.lane); continue; } r -= NGU;
        if (r < NGU) { if (which & 1) wt_job8(r, wu, EXH, EXQ / 32, q * EXQ, Wgu + (size_t)e * 2 * EXQ * 1024, 1024, 128, 1, 0, scr, F.lane); continue; } r -= NGU;
        if (which & 2) wt_job8(r, wd, 1024, 32, 0, Wd + (size_t)e * 1024 * EXQ, EXQ, 0, 0, q * EXQ, scr, F.lane);
    }
}

template <int MODE_Y, bool ROUTE>
__device__ __forceinline__ void resid_norm_row(const Frame& F, const KA& P, int row, const void* xin, bool xin_bf, const float* Yp, const f32x4 (&pa)[4], const f32x4 (&pb)[4], const f32x4 (&psh)[4], void* xout, bool xout_bf,
                                               bf16_t* Hout, f32x4 (&hv)[4], int s0 = 0, int s1 = 0, float g0 = 0.f, float g1 = 0.f) {
    f32x4 v[4];
    if (xin_bf) { const bf16_t* xb = (const bf16_t*)xin + 4 * F.lane;
#pragma unroll
        for (int j = 0; j < 4; ++j) { const u32x2 a = *(const u32x2*)(xb + 256 * j); v[j] = (f32x4){bflo(a.x), bfhi(a.x), bflo(a.y), bfhi(a.y)}; } }
    else { const f32x4* xr = (const f32x4*)(xin) + F.lane;
#pragma unroll
        for (int j = 0; j < 4; ++j) v[j] = xr[64 * j]; }
    if (MODE_Y != 0) {
        f32x4 y[4];
        if (MODE_Y == 1) { const bf16_t* yr = (const bf16_t*)(Yp) + 4 * F.lane;
#pragma unroll
            for (int j = 0; j < 4; ++j) { const u32x2 a = *(const u32x2*)(yr + 256 * j); y[j] = (f32x4){bflo(a.x), bfhi(a.x), bflo(a.y), bfhi(a.y)}; } }
        else {
            const unsigned char* yb = P.ws() + WS_YB;
#pragma unroll
            for (int j = 0; j < 4; ++j) { const int a = *(const int*)(yb + (size_t)s0 * 1024 + 4 * F.lane + 256 * j), b = *(const int*)(yb + (size_t)s1 * 1024 + 4 * F.lane + 256 * j);
                y[j] = (f32x4){g0 * __builtin_amdgcn_cvt_f32_fp8(a, 0) + g1 * __builtin_amdgcn_cvt_f32_fp8(b, 0), g0 * __builtin_amdgcn_cvt_f32_fp8(a, 1) + g1 * __builtin_amdgcn_cvt_f32_fp8(b, 1),
                               g0 * __builtin_amdgcn_cvt_f32_fp8(a, 2) + g1 * __builtin_amdgcn_cvt_f32_fp8(b, 2), g0 * __builtin_amdgcn_cvt_f32_fp8(a, 3) + g1 * __builtin_amdgcn_cvt_f32_fp8(b, 3)}; }
        }
        float s = 0.f;
#pragma unroll
        for (int j = 0; j < 4; ++j) s += (y[j].x * y[j].x + y[j].y * y[j].y) + (y[j].z * y[j].z + y[j].w * y[j].w);
        const float rs = rsqrtf(wave_sum(s) * (1.f / 1024.f) + 1e-6f);
#pragma unroll
        for (int j = 0; j < 4; ++j) v[j] = v[j] + pa[j] * (y[j] * rs);
    }
    if (xout) {
        if (xout_bf) { bf16_t* xo = (bf16_t*)xout + 4 * F.lane;
#pragma unroll
            for (int j = 0; j < 4; ++j) { u32x2 w; w.x = cvt_pk_bf16(v[j].x, v[j].y); w.y = cvt_pk_bf16(v[j].z, v[j].w); *(u32x2*)(xo + 256 * j) = w; } }
        else { f32x4* xo = (f32x4*)(xout) + F.lane;
#pragma unroll
            for (int j = 0; j < 4; ++j) xo[64 * j] = v[j]; } }
    if (Hout) {
        float s = 0.f;
#pragma unroll
        for (int j = 0; j < 4; ++j) s += (v[j].x * v[j].x + v[j].y * v[j].y) + (v[j].z * v[j].z + v[j].w * v[j].w);
        const float rs = rsqrtf(wave_sum(s) * (1.f / 1024.f) + 1e-6f);
#pragma unroll
        for (int j = 0; j < 4; ++j) { const f32x4 h = (v[j] * rs) * pb[j] + psh[j]; hv[j] = h;
            if (ROUTE) *(unsigned*)((unsigned char*)Hout + 4 * F.lane + 256 * j) = cvt4_fp8(h.x, h.y, h.z, h.w, 16.f);
            else { u32x2 w; w.x = cvt_pk_bf16(h.x, h.y); w.y = cvt_pk_bf16(h.z, h.w); *(u32x2*)(Hout + 4 * F.lane + 256 * j) = w; } }
    }
}

template <int MODE_Y, bool ROUTE>
__device__ __forceinline__ void phase_resid_norm(const Frame& F, const KA& P, int lmod_gate, int lmod_norm, const float* xin_lat, const float* xin_ctx, const float* Y, int gate_i, const float* gpost,
                                                 float* xout_lat, float* xout_ctx, const float* gpre, int shift_i, bf16_t* Hout, int nrows, const float* router, int xi_mode = 0, int xo_mode = 0) {
    const float* modv_g = (const float*)(P.ws() + WS_MODV) + (size_t)lmod_gate * 9 * 6144; const float* modv_n = (const float*)(P.ws() + WS_MODV) + (size_t)lmod_norm * 9 * 6144;
    LAS int* lcnt = (LAS int*)F.lds;
    int my_e = 0, my_r0 = 0, my_r1 = 0; float my_g0 = 0.f, my_g1 = 0.f;
    LAS float* rl = (LAS float*)(F.lds + 1024);
    if (ROUTE) { if (F.tid < 16) lcnt[F.tid] = 0;
        for (int i = F.tid; i < 8 * 1024; i += NTHR) rl[(i & 7) * 1024 + (i >> 3)] = router[i];
        __syncthreads(); }
    const int RPW = (nrows + F.NGW - 1) / F.NGW, r0 = F.gw * RPW, r1 = (r0 + RPW < nrows) ? r0 + RPW : nrows;
    int jrow = 0, cur_mod = -1;
    f32x4 pa[4], pb[4], psh[4];
#pragma unroll
    for (int j = 0; j < 4; ++j) { pa[j] = (f32x4){0.f, 0.f, 0.f, 0.f}; pb[j] = pa[j]; psh[j] = pa[j]; }
    const int* toks_c = (const int*)(P.ws() + WS_MOEMETA) + (size_t)ML * 2; const float* tokg_c = (const float*)(P.ws() + WS_MOEMETA) + (size_t)ML * 4;
    int ns0 = 0, ns1 = 0; float ng0 = 0.f, ng1 = 0.f;
    if (MODE_Y == 2 && r0 < r1) { ns0 = toks_c[r0 * 2]; ns1 = toks_c[r0 * 2 + 1]; ng0 = tokg_c[r0 * 2]; ng1 = tokg_c[r0 * 2 + 1]; }
    for (int row = r0; row < r1; ++row, ++jrow) {
        const int cs0 = ns0, cs1 = ns1; const float cg0 = ng0 * (1.f / 32.f), cg1 = ng1 * (1.f / 32.f);
        if (MODE_Y == 2) { const int rn = (row + 1 < r1) ? row + 1 : row; ns0 = toks_c[rn * 2]; ns1 = toks_c[rn * 2 + 1]; ng0 = tokg_c[rn * 2]; ng1 = tokg_c[rn * 2 + 1]; }
        const bool isc = row >= ML; const int modrow = isc ? 8 : row / SEQL;
        if (modrow != cur_mod) { cur_mod = modrow;
            if (MODE_Y != 0) { const f32x4* gt = (const f32x4*)(modv_g + (size_t)modrow * 6144 + gate_i * 1024) + F.lane; const f32x4* gp = (const f32x4*)(gpost) + F.lane;
#pragma unroll
                for (int j = 0; j < 4; ++j) pa[j] = gt[64 * j] * gp[64 * j]; }
            if (Hout) { const f32x4* gp = (const f32x4*)(gpre) + F.lane; const f32x4* sh = (const f32x4*)(modv_n + (size_t)modrow * 6144 + shift_i * 1024) + F.lane; const f32x4* sc = sh + 256;
#pragma unroll
                for (int j = 0; j < 4; ++j) { pb[j] = gp[64 * j] * (sc[64 * j] + 1.0f); psh[j] = sh[64 * j]; } } }
        const unsigned char* xs_row = P.ws() + (row < XS_ROWS_A ? WS_XS_A + (size_t)row * 2048 : WS_XS_B + (size_t)(row - XS_ROWS_A) * 2048);
        const void* xin = isc ? (const void*)(xin_ctx + (size_t)(row - ML) * 1024) : xi_mode == 0 ? (const void*)(xin_lat + (size_t)row * 1024) : xi_mode == 1 ? (const void*)((const unsigned char*)xin_lat + (size_t)row * 2048) : (const void*)xs_row;
        void* xout = isc ? (xout_ctx ? (void*)(xout_ctx + (size_t)(row - ML) * 1024) : nullptr) : !xout_lat ? nullptr : xo_mode == 0 ? (void*)(xout_lat + (size_t)row * 1024) : xo_mode == 1 ? (void*)((unsigned char*)xout_lat + (size_t)row * 2048) : (void*)xs_row;
        const bool xin_bf = !isc && xi_mode != 0, xout_bf = !isc && xo_mode != 0;
        f32x4 hv[4];
        resid_norm_row<MODE_Y, ROUTE>(F, P, row, xin, xin_bf, Y ? (const float*)((const bf16_t*)Y + (size_t)row * 1024) : nullptr, pa, pb, psh, xout, xout_bf, Hout ? Hout + (size_t)row * (ROUTE ? 512 : 1024) : nullptr, hv, cs0, cs1, cg0, cg1);
        if (ROUTE) {
            float lg[8];
#pragma unroll
            for (int e = 0; e < 8; ++e) lg[e] = 0.f;
#pragma unroll
            for (int j = 0; j < 4; ++j)
#pragma unroll
                for (int e = 0; e < 8; ++e) { const f32x4 rv = *(const LAS f32x4*)(rl + e * 1024 + 4 * F.lane + 256 * j);
                    lg[e] += (hv[j].x * rv.x + hv[j].y * rv.y) + (hv[j].z * rv.z + hv[j].w * rv.w); }
#pragma unroll
            for (int e = 0; e < 8; ++e) lg[e] = wave_sum(lg[e]);
            int e0 = 0; float b0 = lg[0];
#pragma unroll
            for (int e = 1; e < 8; ++e) if (lg[e] > b0) { b0 = lg[e]; e0 = e; }
            int e1 = -1; float b1 = -3.0e38f;
#pragma unroll
            for (int e = 0; e < 8; ++e) if (e != e0 && lg[e] > b1) { b1 = lg[e]; e1 = e; }
            const float g0 = 1.0f / (1.0f + __expf(b1 - b0)), g1 = 1.0f - g0;
            int r0 = 0, r1 = 0;
            if (F.lane == 0) { r0 = __hip_atomic_fetch_add(&lcnt[e0], 1, __ATOMIC_RELAXED, __HIP_MEMORY_SCOPE_WORKGROUP); r1 = __hip_atomic_fetch_add(&lcnt[e1], 1, __ATOMIC_RELAXED, __HIP_MEMORY_SCOPE_WORKGROUP); }
            r0 = __builtin_amdgcn_readfirstlane(r0); r1 = __builtin_amdgcn_readfirstlane(r1);
            if (F.lane == jrow) { my_e = e0 | (e1 << 8); my_r0 = r0; my_r1 = r1; my_g0 = g0; my_g1 = g1; }
        }
    }
    if (ROUTE) {
        __syncthreads();
        unsigned* gcnt = (unsigned*)(P.ws() + WS_CTL) + CW_MOECNT;
        if (F.tid < 8) lcnt[8 + F.tid] = (int)atomicAdd(&gcnt[64 * F.tid], (unsigned)lcnt[F.tid]);
        __syncthreads();
        const int row = r0 + F.lane;
        if (F.lane < jrow && row < nrows) {
            int* toke = (int*)(P.ws() + WS_MOEMETA); int* toks = toke + (size_t)ML * 2; float* tokg = (float*)(P.ws() + WS_MOEMETA) + (size_t)ML * 4;
            const int e0 = my_e & 255, e1 = my_e >> 8;
            toke[row * 2] = e0; toke[row * 2 + 1] = e1; toks[row * 2] = my_r0 + lcnt[8 + e0]; toks[row * 2 + 1] = my_r1 + lcnt[8 + e1]; tokg[row * 2] = my_g0; tokg[row * 2 + 1] = my_g1;
        }
        __syncthreads();
    }
}

__device__ __forceinline__ void phase_h8(const Frame& F, const KA& P, int nrows) {
    if (F.bid < 128) return;
    const bf16_t* H = (const bf16_t*)(P.ws() + WS_H); unsigned char* H8 = P.ws() + WS_H8;
    const int nw = (F.G - 128) * NWAVES;
#pragma unroll 4
    for (int row = (F.bid - 128) * NWAVES + F.wave; row < nrows; row += nw) {
        const u32x4* src = (const u32x4*)(H + (size_t)row * 1024) + 2 * F.lane; const u32x4 a = src[0], b = src[1];
        u32x4 o; o.x = cvt4_fp8(bflo(a.x), bfhi(a.x), bflo(a.y), bfhi(a.y), 16.f); o.y = cvt4_fp8(bflo(a.z), bfhi(a.z), bflo(a.w), bfhi(a.w), 16.f);
        o.z = cvt4_fp8(bflo(b.x), bfhi(b.x), bflo(b.y), bfhi(b.y), 16.f); o.w = cvt4_fp8(bflo(b.z), bfhi(b.z), bflo(b.w), bfhi(b.w), 16.f);
        *((u32x4*)(H8 + (size_t)row * 1024) + F.lane) = o;
    }
}

__device__ __forceinline__ void moe_pad_ends(const KA& P, int (&pe)[8]) {
    const unsigned* gcnt = (const unsigned*)(P.ws() + WS_CTL) + CW_MOECNT; int acc = 0;
#pragma unroll
    for (int e = 0; e < 8; ++e) { const int sz = __builtin_amdgcn_readfirstlane((int)__hip_atomic_load(&gcnt[64 * e], __ATOMIC_RELAXED, __HIP_MEMORY_SCOPE_AGENT)); acc += (sz + 255) / 256 * 256; pe[e] = acc; }
}
__device__ __forceinline__ void phase_moe_gather(const Frame& F, const KA& P) {
    int pe[8]; moe_pad_ends(P, pe);
    const int* toke = (const int*)(P.ws() + WS_MOEMETA); int* toks = (int*)(P.ws() + WS_MOEMETA) + (size_t)ML * 2;
    const unsigned char* H = P.ws() + WS_H; unsigned char* XB = P.ws() + WS_XB;
#pragma unroll 4
    for (int row = F.gw; row < ML; row += F.NGW) {
        const u32x4 a = *((const u32x4*)(H + (size_t)row * 1024) + F.lane);
#pragma unroll
        for (int k = 0; k < 2; ++k) {
            const int e = __builtin_amdgcn_readfirstlane(toke[row * 2 + k]); int ps = 0;
#pragma unroll
            for (int j = 1; j < 8; ++j) if (j == e) ps = pe[j - 1];
            const int slot = ps + toks[row * 2 + k];
            *((u32x4*)(XB + (size_t)slot * 1024) + F.lane) = a;
            if (F.lane == 0) toks[row * 2 + k] = slot;
        }
    }
}

__device__ __forceinline__ void phase_hyena_filter_mlp(const Frame& F, const KA& P, int l, int ntok, float* out) {
    LAS float* feats = (LAS float*)F.lds;
    LAS float* h1 = feats + 8 * 36;
    LAS float* h2 = h1 + 8 * 64;
    const float* w1 = P.in(I_HYFW1) + (size_t)l * 33 * 64; const float* b1 = P.in(I_HYFB1) + l * 64; const float* f1 = P.in(I_HYFF1) + l * 64;
    const float* w2 = P.in(I_HYFW2) + (size_t)l * 64 * 64; const float* b2 = P.in(I_HYFB2) + l * 64; const float* f2 = P.in(I_HYFF2) + l * 64;
    const float* w3 = P.in(I_HYFW3) + (size_t)l * 64 * 1024;
    const int pl = F.tid >> 6, j = F.tid & 63;
    const float TWO_PI = 6.283185307179586f;
    for (int u = F.bid; u < ntok / 8; u += F.G) {
        const int pos = u * 8 + pl; const float t = (float)pos / (float)(ntok - 1); const float w = (TWO_PI / (float)ntok) * (float)pos;
        if (j < 33) { float v;
            if (j == 0) v = t;
            else { const int b = (j - 1) & 15; const float f = 1e-4f + (float)b * ((15.0f - 1e-4f) / 15.0f); const float a = f * w; v = (j <= 16) ? cosf(a) : -sinf(a); }
            feats[pl * 36 + j] = v; }
        __syncthreads();
        { float s = b1[j];
          for (int i = 0; i < 33; ++i) s += feats[pl * 36 + i] * w1[i * 64 + j];
          h1[pl * 64 + j] = sinf(f1[j] * s); }
        __syncthreads();
        { float s = b2[j];
          for (int i = 0; i < 64; ++i) s += h1[pl * 64 + i] * w2[i * 64 + j];
          h2[pl * 64 + j] = sinf(f2[j] * s); }
        __syncthreads();
#pragma unroll
        for (int half = 0; half < 2; ++half) {
            const int oc = F.tid + 512 * half;
            float a[8];
#pragma unroll
            for (int p = 0; p < 8; ++p) a[p] = 0.f;
#pragma unroll 1
            for (int i0 = 0; i0 < 64; i0 += 16) { float wv[16];
#pragma unroll
                for (int k = 0; k < 16; ++k) wv[k] = w3[(i0 + k) * 1024 + oc];
#pragma unroll
                for (int k = 0; k < 16; ++k)
#pragma unroll
                    for (int p = 0; p < 8; ++p) a[p] += h2[p * 64 + i0 + k] * wv[k]; }
            const int ch = oc & 255; const float ra = -15.350567286626973f, rb = -3.0701134573253946f;
            const float rate = fabsf(ra + (float)ch * ((rb - ra) / 255.0f));
            float* o = out + (size_t)oc * ntok + u * 8;
#pragma unroll
            for (int p = 0; p < 8; ++p) { const float tt = (float)(u * 8 + p) / (float)(ntok - 1); o[p] = a[p] * __expf(-tt * rate); }
        }
        __syncthreads();
    }
}

constexpr int FN = 8192;
__device__ __forceinline__ f32x2 cmul(f32x2 a, f32x2 b) { return (f32x2){a.x * b.x - a.y * b.y, a.x * b.y + a.y * b.x}; }
__device__ __forceinline__ f32x2 cmulc(f32x2 a, f32x2 b) { return (f32x2){a.x * b.x + a.y * b.y, a.y * b.x - a.x * b.y}; }
__device__ __forceinline__ void fft_make_twiddles(LAS f32x2* TW, int tid) {
    for (int k = tid; k < FN / 2; k += NTHR) {
        const int q = k >> 10, r = k & 1023; const float a = (float)r * (6.283185307179586f / 8192.0f);
        const float a2 = a * a;
        const float s = a + a * a2 * (-1.6666654611e-1f + a2 * (8.3321608736e-3f + a2 * (-1.9515295891e-4f)));
        const float c = 1.0f - 0.5f * a2 + a2 * a2 * (4.166664568298827e-2f + a2 * (-1.388731625493765e-3f + a2 * 2.443315711809948e-5f));
        const float R = 0.70710678118654752f;
        float cr, sr;
        if (q == 0) { cr = c; sr = s; } else if (q == 1) { cr = R * (c - s); sr = R * (c + s); } else if (q == 2) { cr = -s; sr = c; } else { cr = -R * (c + s); sr = R * (c - s); }
        TW[k] = (f32x2){cr, -sr};
        if ((k & 15) == 0 && k < 512) TW[FN / 2 + (k >> 4)] = (f32x2){cr, -sr};
    }
}
__device__ __forceinline__ void pw16(const f32x2 w, f32x2 (&p)[16]) {
    p[0] = (f32x2){1.f, 0.f}; p[1] = w; p[2] = cmul(w, w); p[4] = cmul(p[2], p[2]); p[8] = cmul(p[4], p[4]);
    p[3] = cmul(p[2], w); p[5] = cmul(p[4], w); p[6] = cmul(p[4], p[2]); p[7] = cmul(p[4], p[3]);
#pragma unroll
    for (int k = 1; k < 8; ++k) p[8 + k] = cmul(p[8], p[k]);
}
#define XI(e) ((e) + ((e) >> 5))
constexpr int FFT_X_BYTES = (FN + FN / 32) * 8;
__device__ __forceinline__ f32x2 tw_get(const LAS f32x2* TW, int idx) { const f32x2 w = TW[idx & (FN / 2 - 1)]; return (idx & (FN / 2)) ? (f32x2){-w.x, -w.y} : w; }
template <int K> __device__ __forceinline__ f32x2 w16c() {
    constexpr float c[8] = {1.f, 0.92387953251f, 0.70710678119f, 0.38268343237f, 0.f, -0.38268343237f, -0.70710678119f, -0.92387953251f};
    constexpr float s[8] = {0.f, -0.38268343237f, -0.70710678119f, -0.92387953251f, -1.f, -0.92387953251f, -0.70710678119f, -0.38268343237f};
    return (f32x2){c[K], s[K]}; }
template <int H, int B, int J> __device__ __forceinline__ void bf_dif(f32x2 (&x)[16]) { const f32x2 a = x[B + J], c = x[B + J + H]; x[B + J] = a + c; x[B + J + H] = cmul(a - c, w16c<J * (8 / H)>()); }
template <int H, int B, int J> __device__ __forceinline__ void bf_dit(f32x2 (&x)[16]) { const f32x2 a = x[B + J], c = cmulc(x[B + J + H], w16c<J * (8 / H)>()); x[B + J] = a + c; x[B + J + H] = a - c; }
template <int H, int B, int J> struct Bf16Loop {
    static __device__ __forceinline__ void dif(f32x2 (&x)[16]) { bf_dif<H, B, J>(x); if constexpr (J + 1 < H) Bf16Loop<H, B, J + 1>::dif(x); else if constexpr (B + 2 * H < 16) Bf16Loop<H, B + 2 * H, 0>::dif(x); }
    static __device__ __forceinline__ void dit(f32x2 (&x)[16]) { bf_dit<H, B, J>(x); if constexpr (J + 1 < H) Bf16Loop<H, B, J + 1>::dit(x); else if constexpr (B + 2 * H < 16) Bf16Loop<H, B + 2 * H, 0>::dit(x); }
};
__device__ __forceinline__ void dif16(f32x2 (&x)[16]) { Bf16Loop<8, 0, 0>::dif(x); Bf16Loop<4, 0, 0>::dif(x); Bf16Loop<2, 0, 0>::dif(x); Bf16Loop<1, 0, 0>::dif(x); }
__device__ __forceinline__ void dit16(f32x2 (&x)[16]) { Bf16Loop<1, 0, 0>::dit(x); Bf16Loop<2, 0, 0>::dit(x); Bf16Loop<4, 0, 0>::dit(x); Bf16Loop<8, 0, 0>::dit(x); }
__device__ __forceinline__ constexpr int rev4(int r) { return ((r & 1) << 3) | ((r & 2) << 1) | ((r & 4) >> 1) | ((r & 8) >> 3); }
__device__ __forceinline__ void fft_dif(LAS f32x2* X, const LAS f32x2* TW, int tid) {
    f32x2 x[16];
#pragma unroll
    for (int j = 0; j < 16; ++j) x[j] = X[XI(tid + 512 * j)];
    dif16(x);
    { f32x2 pw[16]; pw16(TW[tid], pw);
#pragma unroll
      for (int r = 1; r < 16; ++r) x[r] = cmul(x[r], pw[rev4(r)]); }
#pragma unroll
    for (int r = 0; r < 16; ++r) X[XI(tid + 512 * r)] = x[r];
    __syncthreads();
    { const int base = (tid >> 5) * 512 + (tid & 31), ip = tid & 31;
#pragma unroll
      for (int j = 0; j < 16; ++j) x[j] = X[XI(base + 32 * j)];
      dif16(x);
      { f32x2 pw[16]; pw16(TW[FN / 2 + ip], pw);
#pragma unroll
        for (int r = 1; r < 16; ++r) x[r] = cmul(x[r], pw[rev4(r)]); }
#pragma unroll
      for (int r = 0; r < 16; ++r) X[XI(base + 32 * r)] = x[r]; }
    __syncthreads();
    if (tid < 256) { const int base = 33 * tid;
        f32x2 y[16];
#pragma unroll
        for (int j = 0; j < 16; ++j) { const f32x2 a = X[base + j], c = X[base + 16 + j]; x[j] = a + c; y[j] = cmul(a - c, tw_get(TW, 256 * j)); }
        dif16(x); dif16(y);
#pragma unroll
        for (int j = 0; j < 16; ++j) { X[base + j] = x[j]; X[base + 16 + j] = y[j]; } }
    __syncthreads();
}
__device__ __forceinline__ void fft_dit_inv(LAS f32x2* X, const LAS f32x2* TW, int tid) {
    f32x2 x[16];
    if (tid < 256) { const int base = 33 * tid; f32x2 y[16];
#pragma unroll
        for (int j = 0; j < 16; ++j) { x[j] = X[base + j]; y[j] = X[base + 16 + j]; }
        dit16(x); dit16(y);
#pragma unroll
        for (int j = 0; j < 16; ++j) { const f32x2 c = cmulc(y[j], tw_get(TW, 256 * j)); X[base + j] = x[j] + c; X[base + 16 + j] = x[j] - c; } }
    __syncthreads();
    { const int base = (tid >> 5) * 512 + (tid & 31), ip = tid & 31;
#pragma unroll
      for (int r = 0; r < 16; ++r) x[r] = X[XI(base + 32 * r)];
      { f32x2 pw[16]; pw16(TW[FN / 2 + ip], pw);
#pragma unroll
        for (int r = 1; r < 16; ++r) x[r] = cmulc(x[r], pw[rev4(r)]); }
      dit16(x);
#pragma unroll
      for (int j = 0; j < 16; ++j) X[XI(base + 32 * j)] = x[j]; }
    __syncthreads();
#pragma unroll
    for (int r = 0; r < 16; ++r) x[r] = X[XI(tid + 512 * r)];
    { f32x2 pw[16]; pw16(TW[tid], pw);
#pragma unroll
      for (int r = 1; r < 16; ++r) x[r] = cmulc(x[r], pw[rev4(r)]); }
    dit16(x);
#pragma unroll
    for (int j = 0; j < 16; ++j) X[XI(tid + 512 * j)] = x[j];
    __syncthreads();
}

__device__ __forceinline__ void phase_hyena_filter_fft(const Frame& F, const KA& P) {
    LAS f32x2* X = (LAS f32x2*)F.lds; LAS f32x2* TW = (LAS f32x2*)(F.lds + FFT_X_BYTES);
    fft_make_twiddles(TW, F.tid);
    const float* hf = (const float*)(P.ws() + WS_HFILT); f32x2* KS = (f32x2*)(P.ws() + WS_KSPEC);
    for (int u = F.bid; u < 512; u += F.G) {
        const int o = u >> 8, ch = u & 255;
        const float* fw = hf + ((size_t)(o * 2 + 0) * 256 + ch) * 4096; const float* bw = hf + ((size_t)(o * 2 + 1) * 256 + ch) * 4096;
        __syncthreads();
        { float fv[8], bv[8];
#pragma unroll
          for (int k = 0; k < 8; ++k) { const int i = F.tid + NTHR * k; fv[k] = fw[i]; bv[k] = bw[i == 0 ? 0 : 4096 - i]; }
#pragma unroll
          for (int k = 0; k < 8; ++k) { const int i = F.tid + NTHR * k; X[XI(i)] = (f32x2){fv[k], 0.f}; X[XI(4096 + i)] = (f32x2){i == 0 ? 0.f : bv[k], 0.f}; } }
        __syncthreads();
        fft_dif(X, TW, F.tid);
        for (int i = F.tid; i < FN; i += NTHR) KS[(size_t)u * FN + i] = X[XI(i)];
    }
    __syncthreads();
}

__device__ __forceinline__ void phase_hyena_transpose_in(const Frame& F, const KA& P, int l) {
    constexpr int LD = 768;
    LAS bf16_t* T = (LAS bf16_t*)F.lds;
    const bf16_t* HY = (const bf16_t*)(P.ws() + WS_HY); bf16_t* HYT = (bf16_t*)(P.ws() + WS_HYT);
    const float* cw = P.in(I_HYCONVW) + (size_t)l * 3 * 768; const float* cb = P.in(I_HYCONVB) + (size_t)l * 768;
    LAS float* WL = (LAS float*)(F.lds + 64 * LD * 2);
    for (int i = F.tid; i < 4 * 768; i += NTHR) WL[i] = (i < 3 * 768) ? cw[i] : cb[i - 3 * 768];
    for (int u = F.bid; u < NBATCH * 64; u += F.G) {
        const int b = u >> 6, gr = u & 63; const size_t row0 = (size_t)b * SEQL + gr * 64;
        __syncthreads();
        { u32x4 tv[12];
#pragma unroll
          for (int k = 0; k < 12; ++k) { const int i = F.tid + NTHR * k, t = i / 96, c8 = i % 96; tv[k] = *(const u32x4*)(HY + (row0 + t) * 768 + c8 * 8); }
#pragma unroll
          for (int k = 0; k < 12; ++k) { const int i = F.tid + NTHR * k, t = i / 96, c8 = i % 96; *(LAS u32x4*)(T + t * LD + ((c8 ^ ((t >> 3) & 7)) * 8)) = tv[k]; } }
        __syncthreads();
#pragma unroll 2
        for (int i = F.tid; i < 768 * 8; i += NTHR) {
            const int piece = i & 7, c = i >> 3, t0 = piece * 8;
            const float w0 = WL[c], w1 = WL[768 + c], w2 = WL[1536 + c], bb = WL[2304 + c];
            float x[10];
#pragma unroll
            for (int k = 0; k < 10; ++k) { const int t = t0 - 1 + k; x[k] = (t >= 0 && t < 64) ? bf2f(T[t * LD + ((((c >> 3) ^ ((t >> 3) & 7)) << 3) | (c & 7))]) : 0.f; }
            float y[8];
#pragma unroll
            for (int k = 0; k < 8; ++k) y[k] = w0 * x[k] + w1 * x[k + 1] + w2 * x[k + 2] + bb;
            u32x4 o; o.x = cvt_pk_bf16(y[0], y[1]); o.y = cvt_pk_bf16(y[2], y[3]); o.z = cvt_pk_bf16(y[4], y[5]); o.w = cvt_pk_bf16(y[6], y[7]);
            *(u32x4*)(HYT + ((size_t)b * 768 + c) * SEQL + gr * 64 + t0) = o;
        }
    }
    __syncthreads();
}
__device__ __forceinline__ void phase_hyena_transpose_out(const Frame& F, const KA& P) {
    constexpr int LD = 72;
    LAS bf16_t* T = (LAS bf16_t*)F.lds;
    const bf16_t* HYOT = (const bf16_t*)(P.ws() + WS_HYOT); bf16_t* HYOUT = (bf16_t*)(P.ws() + WS_HYOUT);
    for (int u = F.bid; u < NBATCH * 64; u += F.G) {
        const int b = u >> 6, gr = u & 63;
        __syncthreads();
        { u32x4 tv[4];
#pragma unroll
          for (int k = 0; k < 4; ++k) { const int i = F.tid + NTHR * k, ch = i >> 3, p = i & 7; tv[k] = *(const u32x4*)(HYOT + ((size_t)b * 256 + ch) * SEQL + gr * 64 + p * 8); }
#pragma unroll
          for (int k = 0; k < 4; ++k) { const int i = F.tid + NTHR * k, ch = i >> 3, p = i & 7; *(LAS u32x4*)(T + ch * LD + p * 8) = tv[k]; } }
        __syncthreads();
        for (int i = F.tid; i < 64 * 32; i += NTHR) { const int t = i & 63, c8 = i >> 6;
            unsigned w[4];
#pragma unroll
            for (int k = 0; k < 4; ++k) w[k] = (unsigned)T[(c8 * 8 + 2 * k) * LD + t] | ((unsigned)T[(c8 * 8 + 2 * k + 1) * LD + t] << 16);
            *(u32x4*)(HYOUT + ((size_t)b * SEQL + gr * 64 + t) * 256 + c8 * 8) = (u32x4){w[0], w[1], w[2], w[3]}; }
    }
    __syncthreads();
}

__device__ __forceinline__ void phase_hyena_main(const Frame& F, const KA& P, int l) {
    LAS f32x2* X = (LAS f32x2*)F.lds; LAS f32x2* TW = (LAS f32x2*)(F.lds + FFT_X_BYTES);
    fft_make_twiddles(TW, F.tid);
    const bf16_t* HYT = (const bf16_t*)(P.ws() + WS_HYT); bf16_t* HYOT = (bf16_t*)(P.ws() + WS_HYOT); const f32x2* KS = (const f32x2*)(P.ws() + WS_KSPEC);
    const float inv = 1.0f / (float)FN;
    const int t0 = F.tid * 8;
    for (int u = F.bid; u < 4 * 256; u += F.G) {
        const int bp = u >> 8, ch = u & 255, b0 = 2 * bp, b1 = 2 * bp + 1;
        const float bias0 = __int_as_float(__builtin_amdgcn_readfirstlane(__float_as_int(P.in(I_HYBIAS)[(size_t)l * 512 + ch])));
        const float bias1 = __int_as_float(__builtin_amdgcn_readfirstlane(__float_as_int(P.in(I_HYBIAS)[(size_t)l * 512 + 256 + ch])));
        const bf16_t* r0 = HYT + ((size_t)b0 * 768 + ch) * SEQL + t0; const bf16_t* r1 = HYT + ((size_t)b1 * 768 + ch) * SEQL + t0;
        f32x4 va0, va1, vb0, vb1;
        const u32x4 gx1a = *(const u32x4*)(r0 + (size_t)256 * SEQL), gx1b = *(const u32x4*)(r1 + (size_t)256 * SEQL);
        unpack8(*(const u32x4*)(r0), va0, va1); unpack8(*(const u32x4*)(r1), vb0, vb1);
        f32x2 ksv[16];
        { const f32x2* ks = KS + (size_t)(0 * 256 + ch) * FN;
#pragma unroll
          for (int k = 0; k < 16; ++k) ksv[k] = ks[F.tid + NTHR * k]; }
        __syncthreads();
#pragma unroll
        for (int k = 0; k < 4; ++k) { X[XI(t0 + k)] = (f32x2){va0[k], vb0[k]}; X[XI(t0 + 4 + k)] = (f32x2){va1[k], vb1[k]}; }
#pragma unroll
        for (int k = 0; k < 8; ++k) X[XI(4096 + t0 + k)] = (f32x2){0.f, 0.f};
        __syncthreads();
        fft_dif(X, TW, F.tid);
#pragma unroll
        for (int k = 0; k < 16; ++k) { const int i = F.tid + NTHR * k; X[XI(i)] = cmul(X[XI(i)], ksv[k]) * inv; }
        { const f32x2* ks = KS + (size_t)(1 * 256 + ch) * FN;
#pragma unroll
          for (int k = 0; k < 16; ++k) ksv[k] = ks[F.tid + NTHR * k]; }
        __syncthreads();
        fft_dit_inv(X, TW, F.tid);
        f32x4 za0, za1, zb0, zb1;
        { f32x4 xa0, xa1, xb0, xb1; unpack8(gx1a, xa0, xa1); unpack8(gx1b, xb0, xb1);
#pragma unroll
          for (int k = 0; k < 4; ++k) { const f32x2 y = X[XI(t0 + k)], y2 = X[XI(t0 + 4 + k)];
              za0[k] = xa0[k] * fmaf(va0[k], bias0, y.x); zb0[k] = xb0[k] * fmaf(vb0[k], bias0, y.y);
              za1[k] = xa1[k] * fmaf(va1[k], bias0, y2.x); zb1[k] = xb1[k] * fmaf(vb1[k], bias0, y2.y); } }
        const u32x4 gx2a = *(const u32x4*)(r0 + (size_t)512 * SEQL), gx2b = *(const u32x4*)(r1 + (size_t)512 * SEQL);
        __syncthreads();
#pragma unroll
        for (int k = 0; k < 4; ++k) { X[XI(t0 + k)] = (f32x2){za0[k], zb0[k]}; X[XI(t0 + 4 + k)] = (f32x2){za1[k], zb1[k]}; }
#pragma unroll
        for (int k = 0; k < 8; ++k) X[XI(4096 + t0 + k)] = (f32x2){0.f, 0.f};
        __syncthreads();
        fft_dif(X, TW, F.tid);
#pragma unroll
        for (int k = 0; k < 16; ++k) { const int i = F.tid + NTHR * k; X[XI(i)] = cmul(X[XI(i)], ksv[k]) * inv; }
        __syncthreads();
        fft_dit_inv(X, TW, F.tid);
        { f32x4 xa0, xa1, xb0, xb1; unpack8(gx2a, xa0, xa1); unpack8(gx2b, xb0, xb1);
          f32x4 oa0, oa1, ob0, ob1;
#pragma unroll
          for (int k = 0; k < 4; ++k) { const f32x2 y = X[XI(t0 + k)], y2 = X[XI(t0 + 4 + k)];
              oa0[k] = xa0[k] * fmaf(za0[k], bias1, y.x); ob0[k] = xb0[k] * fmaf(zb0[k], bias1, y.y);
              oa1[k] = xa1[k] * fmaf(za1[k], bias1, y2.x); ob1[k] = xb1[k] * fmaf(zb1[k], bias1, y2.y); }
          *(u32x4*)(HYOT + ((size_t)b0 * 256 + ch) * SEQL + t0) = pack8(oa0, oa1); *(u32x4*)(HYOT + ((size_t)b1 * 256 + ch) * SEQL + t0) = pack8(ob0, ob1); }
    }
    __syncthreads();
}
__device__ __forceinline__ void phase_hyena_ctx(const Frame& F, const KA& P, int l) {
    LAS float* Z = (LAS float*)F.lds;
    const int half = F.tid >> 8, t = F.tid & 255;
    LAS float* z = Z + half * 2048; LAS float* gf = z + 256;
    const bf16_t* HY = (const bf16_t*)(P.ws() + WS_HY); bf16_t* HYOUT = (bf16_t*)(P.ws() + WS_HYOUT);
    const float* hfc = (const float*)(P.ws() + WS_HFILTC);
    const float* cw = P.in(I_HYCONVW) + (size_t)l * 3 * 768; const float* cb = P.in(I_HYCONVB) + (size_t)l * 768;
    for (int u0 = F.bid * 2; u0 < NBATCH * 256; u0 += F.G * 2) {
        const int u = u0 + half, b = u >> 8, ch = u & 255; const size_t row0 = (size_t)ML + b * CTXL;
        float s[3];
#pragma unroll
        for (int k = 0; k < 3; ++k) { const int c = k * 256 + ch; float a = cb[c];
#pragma unroll
            for (int j = 0; j < 3; ++j) { const int tt = t - 1 + j; if (tt >= 0 && tt < CTXL) a += cw[j * 768 + c] * bf2f(HY[(row0 + tt) * 768 + c]); }
            s[k] = a; }
        float zc = s[0];
#pragma unroll
        for (int o = 0; o < 2; ++o) {
            __syncthreads();
            z[t] = zc; gf[255 + t] = hfc[((size_t)(o * 2 + 0) * 256 + ch) * 256 + t]; if (t > 0) gf[255 - t] = hfc[((size_t)(o * 2 + 1) * 256 + ch) * 256 + t];
            __syncthreads();
            float y0 = 0.f, y1 = 0.f, y2 = 0.f, y3 = 0.f; const LAS float* gp = gf + 255 + t;
#pragma unroll 8
            for (int q = 0; q < CTXL; q += 4) { const f32x4 z4 = *(const LAS f32x4*)(z + q);
                y0 += gp[-q] * z4.x; y1 += gp[-q - 1] * z4.y; y2 += gp[-q - 2] * z4.z; y3 += gp[-q - 3] * z4.w; }
            const float y = (y0 + y1) + (y2 + y3);
            const float bias = P.in(I_HYBIAS)[(size_t)l * 512 + o * 256 + ch];
            zc = s[1 + o] * (y + zc * bias);
        }
        HYOUT[(row0 + t) * 256 + ch] = f2bf(zc);
    }
    __syncthreads();
}

__device__ __forceinline__ int chain_row(int b, int d, int c) {
    if (c < 4) { const int j = d ? 3 - c : c; return ML + b * CTXL + 64 * j; }
    const int j = d ? 67 - c : c - 4; return b * SEQL + 64 * j;
}
__device__ __forceinline__ void ld8bf(const bf16_t* p, float (&o)[8]) { const u32x4 w = *(const u32x4*)p; o[0] = bflo(w.x); o[1] = bfhi(w.x); o[2] = bflo(w.y); o[3] = bfhi(w.y); o[4] = bflo(w.z); o[5] = bfhi(w.z); o[6] = bflo(w.w); o[7] = bfhi(w.w); }
__device__ __forceinline__ void ld8f(const float* p, float (&o)[8]) { const f32x4 a = *(const f32x4*)p, b = *(const f32x4*)(p + 4); o[0] = a.x; o[1] = a.y; o[2] = a.z; o[3] = a.w; o[4] = b.x; o[5] = b.y; o[6] = b.z; o[7] = b.w; }
__device__ __forceinline__ void lds_ld8(const LAS float* p, float (&o)[8]) { const f32x4 a = *(const LAS f32x4*)p, b = *(const LAS f32x4*)(p + 4); o[0] = a.x; o[1] = a.y; o[2] = a.z; o[3] = a.w; o[4] = b.x; o[5] = b.y; o[6] = b.z; o[7] = b.w; }
__device__ __forceinline__ void lds_st8(LAS float* p, const float (&o)[8]) { *(LAS f32x4*)p = (f32x4){o[0], o[1], o[2], o[3]}; *(LAS f32x4*)(p + 4) = (f32x4){o[4], o[5], o[6], o[7]}; }
#define WAVE_LDS_SYNC() do { asm volatile("s_waitcnt lgkmcnt(0)" ::: "memory"); } while (0)

__device__ __forceinline__ float gelu_as(float v) {
    const float t = __builtin_amdgcn_rcpf(fabsf(v) * 0.2316418882f + 1.0f);
    float q = t * 0.5307027145f + (-0.7265760135f); q = q * t + 0.7107068705f; q = q * t + (-0.142248368f); q = q * t + 0.127414796f; q = q * t;
    const float m = v * (q * __builtin_amdgcn_exp2f((v * v) * (-0.72134752044f)));
    return v < 0.f ? m : v - m;
}
typedef float f32x16s __attribute__((ext_vector_type(16)));
constexpr int HBP = 68;
struct S5Tab { float ar, ai; u32x4 bfr[4], cf[4]; };
template <bool OUT>
__device__ __forceinline__ void s5_tab_load(S5Tab& t, const KA& P, int l, int d, int g, int lane) {
    const int ldg = (l * 2 + d) * 16 + g, r = lane & 31, hb = lane >> 5;
    const float* tab = (const float*)(P.ws() + WS_S5TAB) + (size_t)ldg * 2304;
    t.ar = tab[lane]; t.ai = tab[64 + lane];
    const bf16_t* T2 = (const bf16_t*)(P.ws() + WS_S5TAB2) + (size_t)ldg * 4096;
#pragma unroll
    for (int tn = 0; tn < 4; ++tn) t.bfr[tn] = *(const u32x4*)(T2 + (32 * tn + r) * 16 + 8 * hb);
#pragma unroll
    for (int q = 0; q < 4; ++q) t.cf[q] = OUT ? *(const u32x4*)(T2 + 2048 + (lane & 15) * 128 + 32 * q + 8 * (lane >> 4)) : (u32x4){0u, 0u, 0u, 0u};
}
template <bool OUT>
__device__ __forceinline__ void s5_task(const S5Tab& t, const KA& P, int d, int g, int rowbase, float& hr, float& hi, LAS unsigned* HB, LAS float* yt, int lane) {
    const int r = lane & 31, hb = lane >> 5, p = lane;
    const float ar = t.ar, ai = t.ai;
    const bf16_t* U = (const bf16_t*)(P.ws() + WS_U);
#pragma unroll 1
    for (int hf = 0; hf < 2; ++hf) {
        const int sr = 32 * hf + r, tr = d ? 63 - sr : sr;
        const u32x4 afr = *(const u32x4*)(U + (size_t)(rowbase + tr) * 256 + g * 16 + 8 * hb);
        f32x16s acc[4];
#pragma unroll
        for (int tn = 0; tn < 4; ++tn) {
#pragma unroll
            for (int i = 0; i < 16; ++i) acc[tn][i] = 0.f;
            acc[tn] = __builtin_amdgcn_mfma_f32_32x32x16_bf16(__builtin_bit_cast(bf16x8, afr), __builtin_bit_cast(bf16x8, t.bfr[tn]), acc[tn], 0, 0, 0); }
        asm volatile("s_waitcnt lgkmcnt(0)" ::: "memory");
#pragma unroll
        for (int i = 0; i < 16; ++i) { const int s = 8 * (i >> 2) + 4 * hb + (i & 3);
            HB[s * HBP + r] = cvt_pk_bf16(acc[0][i], acc[2][i]); HB[s * HBP + 32 + r] = cvt_pk_bf16(acc[1][i], acc[3][i]); }
        asm volatile("s_waitcnt lgkmcnt(0)" ::: "memory");
#pragma unroll 8
        for (int s = 0; s < 32; ++s) { const unsigned w = HB[s * HBP + p];
            const float nr = ar * hr - ai * hi + bflo(w), ni = ar * hi + ai * hr + bfhi(w); hr = nr; hi = ni;
            if (OUT) HB[s * HBP + p] = cvt_pk_bf16(hr, hi); }
        if (OUT) {
            asm volatile("s_waitcnt lgkmcnt(0)" ::: "memory");
#pragma unroll
            for (int tm = 0; tm < 2; ++tm) { f32x4 y = (f32x4){0.f, 0.f, 0.f, 0.f};
#pragma unroll
                for (int q = 0; q < 4; ++q) y = __builtin_amdgcn_mfma_f32_16x16x32_bf16(__builtin_bit_cast(bf16x8, *(const LAS u32x4*)(HB + (16 * tm + (lane & 15)) * HBP + 16 * q + 4 * (lane >> 4))), __builtin_bit_cast(bf16x8, t.cf[q]), y, 0, 0, 0);
#pragma unroll
                for (int j = 0; j < 4; ++j) { const int s = 32 * hf + 16 * tm + 4 * (lane >> 4) + j, t = d ? 63 - s : s;
                    yt[t * 68 + (g & 3) * 16 + (lane & 15)] = y[j]; } }
        }
    }
}
__device__ __forceinline__ void phase_s5_local(const Frame& F, const KA& P, int l) {
    f32x2* E = (f32x2*)(P.ws() + WS_E);
    LAS unsigned* HB = (LAS unsigned*)(F.lds + F.wave * (32 * HBP * 4));
    const int dg = F.gw & 31, d = dg >> 4, g = dg & 15;
    S5Tab tb; s5_tab_load<false>(tb, P, l, d, g, fresh_lane());
    for (int bc = F.gw >> 5; bc < NBATCH * NCHAIN; bc += F.NGW >> 5) {
        const int lane = fresh_lane();
        const int c = bc % NCHAIN, b = bc / NCHAIN;
        float hr = 0.f, hi = 0.f;
        s5_task<false>(tb, P, d, g, chain_row(b, d, c), hr, hi, HB, nullptr, lane);
        E[((size_t)(((b * 2 + d) * 16 + g) * NCHAIN + c)) * 64 + lane] = (f32x2){hr, hi};
    }
    __syncthreads();
}
__device__ __forceinline__ void phase_s5_carry(const Frame& F, const KA& P, int l) {
    const f32x2* E = (const f32x2*)(P.ws() + WS_E); f32x2* CIN = (f32x2*)(P.ws() + WS_CIN);
    LAS f32x2* XS = (LAS f32x2*)F.lds;
    const int p = F.lane, w = F.wave, n = (w < 4) ? 9 : 8, c0 = (w < 4) ? 9 * w : 36 + 8 * (w - 4);
    for (int bdg = F.bid; bdg < NBATCH * 32; bdg += F.G) {
        const int d = (bdg >> 4) & 1, g = bdg & 15;
        const float* tab = (const float*)(P.ws() + WS_S5TAB) + (size_t)((l * 2 + d) * 16 + g) * 2304;
        const float tr = tab[128 + p], ti = tab[192 + p];
        f32x2 e[9];
#pragma unroll
        for (int k = 0; k < 9; ++k) { const int c = (c0 + k < NCHAIN) ? c0 + k : NCHAIN - 1; e[k] = E[((size_t)bdg * NCHAIN + c) * 64 + p]; }
        float lr[9], li[9]; float cr = 0.f, ci = 0.f;
#pragma unroll
        for (int k = 0; k < 9; ++k) { lr[k] = cr; li[k] = ci;
            if (k < n) { const float nr = tr * cr - ti * ci + e[k].x, ni = tr * ci + ti * cr + e[k].y; cr = nr; ci = ni; } }
        __syncthreads();
        XS[w * 64 + p] = (f32x2){cr, ci};
        __syncthreads();
        const float t2r = tr * tr - ti * ti, t2i = 2.f * tr * ti, t4r = t2r * t2r - t2i * t2i, t4i = 2.f * t2r * t2i, t8r = t4r * t4r - t4i * t4i, t8i = 2.f * t4r * t4i;
        const float t9r = t8r * tr - t8i * ti, t9i = t8r * ti + t8i * tr;
        float hr = 0.f, hi = 0.f;
#pragma unroll
        for (int v = 0; v < 7; ++v) if (v < w) { const float ar = (v < 4) ? t9r : t8r, ai = (v < 4) ? t9i : t8i; const f32x2 bv = XS[v * 64 + p];
            const float nr = ar * hr - ai * hi + bv.x, ni = ar * hi + ai * hr + bv.y; hr = nr; hi = ni; }
        float pr = hr, pi = hi;
#pragma unroll
        for (int k = 0; k < 9; ++k) if (k < n) { CIN[((size_t)bdg * NCHAIN + c0 + k) * 64 + p] = (f32x2){pr + lr[k], pi + li[k]};
            const float nr = tr * pr - ti * pi, ni = tr * pi + ti * pr; pr = nr; pi = ni; }
    }
}
__device__ __forceinline__ void phase_s5_out(const Frame& F, const KA& P, int l) {
    LAS unsigned* HB = (LAS unsigned*)(F.lds + F.wave * (32 * HBP * 4));
    LAS float* yt2 = (LAS float*)(F.lds + 8 * (32 * HBP * 4));
    const bf16_t* U = (const bf16_t*)(P.ws() + WS_U); const f32x2* CIN = (const f32x2*)(P.ws() + WS_CIN); bf16_t* YPRE = (bf16_t*)(P.ws() + WS_YPRE);
    const int d = F.wave & 1;
    const int gq = F.bid & 3, g = gq * 4 + (F.wave >> 1);
    S5Tab tb; s5_tab_load<true>(tb, P, l, d, g, fresh_lane());
    for (int bt = F.bid >> 2; bt < NBATCH * NCHAIN; bt += F.G >> 2) {
        const int lane = fresh_lane(), tid = F.wave * 64 + lane;
        const int tc = bt % NCHAIN, b = bt / NCHAIN;
        const bool isc = tc < 4; const int j = isc ? tc : tc - 4; const int rowbase = isc ? ML + b * CTXL + 64 * j : b * SEQL + 64 * j;
        const int c = isc ? (d ? 3 - j : j) : (d ? 67 - j : 4 + j);
        __syncthreads();
        const f32x2 h0 = CIN[((size_t)(((b * 2 + d) * 16 + g) * NCHAIN + c)) * 64 + lane];
        float hr = h0.x, hi = h0.y;
        const int ft = tid >> 3, fcs = tid & 7;
        const u32x4 fu = *(const u32x4*)(U + (size_t)(rowbase + ft) * 256 + gq * 64 + fcs * 8);
        float Dv[8]; ld8f(P.in(I_S5D) + (size_t)l * 256 + gq * 64 + fcs * 8, Dv);
        __syncthreads();
        s5_task<true>(tb, P, d, g, rowbase, hr, hi, HB, yt2 + d * (64 * 68), lane);
        __syncthreads();
        { const int t = ft, cs = fcs;
          f32x4 u0, u1; unpack8(fu, u0, u1);
          f32x4 y0, y1;
#pragma unroll
          for (int k = 0; k < 4; ++k) { float a = yt2[t * 68 + cs * 8 + k] + yt2[64 * 68 + t * 68 + cs * 8 + k] + Dv[k] * u0[k], bq = yt2[t * 68 + cs * 8 + 4 + k] + yt2[64 * 68 + t * 68 + cs * 8 + 4 + k] + Dv[4 + k] * u1[k];
              y0[k] = gelu_as(a); y1[k] = gelu_as(bq); }
          *(u32x4*)(YPRE + (size_t)(rowbase + t) * 256 + gq * 64 + cs * 8) = pack8(y0, y1); }
    }
    __syncthreads();
}

__device__ __forceinline__ float softplusf_(float x) { return fmaxf(x, 0.f) + log1pf(__expf(-fabsf(x))); }
__device__ __forceinline__ void conv8(const bf16_t* X, int ld, size_t row, int col, bool lo, bool hi, const float* cw, int cwld, float (&y)[8]) {
    float x0[8], xm[8], xp[8], w0[8], w1[8], w2[8];
    ld8bf(X + row * ld + col, x0);
    if (lo) ld8bf(X + (row - 1) * ld + col, xm); else { for (int i = 0; i < 8; ++i) xm[i] = 0.f; }
    if (hi) ld8bf(X + (row + 1) * ld + col, xp); else { for (int i = 0; i < 8; ++i) xp[i] = 0.f; }
    ld8f(cw + col, w0); ld8f(cw + cwld + col, w1); ld8f(cw + 2 * cwld + col, w2);
#pragma unroll
    for (int i = 0; i < 8; ++i) y[i] = w0[i] * xm[i] + w1[i] * x0[i] + w2[i] * xp[i];
}
__device__ __forceinline__ void phase_rwkv_naive(const Frame& F, const KA& P, int l) {
    LAS float* Rr = (LAS float*)F.lds; LAS float* Ww = Rr + 4096; LAS float* Kd = Ww + 4096; LAS float* Aa = Kd + 4096; LAS float* Bb = Aa + 4096; LAS float* Vv = Bb + 4096;
    LAS float* Lo = Vv + 2048; LAS float* Yl = Lo;
    const bf16_t* RKV = (const bf16_t*)(P.ws() + WS_RKV); const bf16_t* LORA = (const bf16_t*)(P.ws() + WS_LORA);
    bf16_t* YD = (bf16_t*)(P.ws() + WS_YD); float* CBON = (float*)(P.ws() + WS_CBON);
    const float* cw = P.in(I_RWCONV) + (size_t)l * 3 * 1536;
    for (int ci = F.bid; ci < 256; ci += F.G) {
        const int b = ci >> 5, h = (ci >> 2) & 7, d = (ci >> 1) & 1, vh = ci & 1;
        const int t = F.tid >> 3, cg = F.tid & 7, hc = h * 64 + cg * 8;
        const float* w2p = P.in(I_RWW2) + (size_t)(l * 2 + d) * 64 * 512 + hc; const float* a2p = P.in(I_RWA2) + (size_t)(l * 2 + d) * 64 * 512 + hc;
        float st[8];
#pragma unroll
        for (int i = 0; i < 8; ++i) st[i] = 0.f;
        const int sv = F.tid >> 3, kq = F.tid & 7;
#pragma unroll 1
        for (int c = 0; c < NCHAIN; ++c) {
            const int rowbase = chain_row(b, d, c); const bool isc = c < 4;
            const size_t row = (size_t)rowbase + t;
            int hcx = hc; asm volatile("" : "+v"(hcx));
            bool lo = t > 0, hi = t < 63;
            if (isc) { const int tt = rowbase - (ML + b * CTXL) + t; lo = tt > 0; hi = tt < CTXL - 1; }
            float r8[8], k8[8], v8[8];
            conv8(RKV, 1536, row, hc, lo, hi, cw, 1536, r8); conv8(RKV, 1536, row, 512 + hc, lo, hi, cw, 1536, k8);
            if ((cg >> 2) == vh) { conv8(RKV, 1536, row, 1024 + hc, lo, hi, cw, 1536, v8); lds_st8(Vv + t * 32 + (cg & 3) * 8, v8); }
            lds_st8(Rr + t * 64 + cg * 8, r8);
            float kk[8]; float ss = 0.f;
            { float kkw[8]; ld8f(P.in(I_RWKK) + l * 512 + hcx, kkw);
#pragma unroll
              for (int i = 0; i < 8; ++i) { kk[i] = k8[i] * kkw[i]; ss += kk[i] * kk[i]; } }
            ss = red8(ss); { const float inv = rsqrtf(fmaxf(ss, 1e-24f));
#pragma unroll
              for (int i = 0; i < 8; ++i) kk[i] *= inv; }
            { float na[8];
#pragma unroll
              for (int i = 0; i < 8; ++i) na[i] = -kk[i];
              lds_st8(Aa + t * 64 + cg * 8, na); }
            { float lw[8], la[8]; ld8bf(LORA + row * 256 + d * 64 + cg * 8, lw); ld8bf(LORA + row * 256 + 128 + d * 64 + cg * 8, la);
              lds_st8(Lo + t * 128 + cg * 8, lw); lds_st8(Lo + t * 128 + 64 + cg * 8, la); }
            __syncthreads();
            float wa[8], aa[8];
            ld8f(P.in(I_RWW0) + (l * 2 + d) * 512 + hcx, wa); ld8f(P.in(I_RWA0) + (l * 2 + d) * 512 + hcx, aa);
#pragma unroll 2
            for (int j = 0; j < 64; ++j) { const float lw = Lo[t * 128 + j], la = Lo[t * 128 + 64 + j]; float w2r[8], a2r[8]; ld8f(w2p + (size_t)j * 512, w2r); ld8f(a2p + (size_t)j * 512, a2r);
#pragma unroll
                for (int i = 0; i < 8; ++i) { wa[i] += lw * w2r[i]; aa[i] += la * a2r[i]; } }
            float cb = 0.f;
            { float dec[8], kd[8], bb[8], kaw[8], rkw[8]; ld8f(P.in(I_RWKA) + l * 512 + hcx, kaw); ld8f(P.in(I_RWRK) + l * 512 + hcx, rkw);
#pragma unroll
              for (int i = 0; i < 8; ++i) { const float wl = -softplusf_(-wa[i]) - 0.5f; dec[i] = __expf(-__expf(wl)); const float as = sigmoidf_(aa[i]);
                  kd[i] = k8[i] * (1.0f + (as - 1.0f) * kaw[i]); bb[i] = kk[i] * as; cb += r8[i] * rkw[i] * kd[i]; }
              lds_st8(Ww + t * 64 + cg * 8, dec); lds_st8(Kd + t * 64 + cg * 8, kd); lds_st8(Bb + t * 64 + cg * 8, bb); }
            cb = red8(cb);
            if (cg == 0 && vh == 0) CBON[((size_t)d * MT + row) * 8 + h] = cb;
            __syncthreads();
            if (F.tid < 256) {
#pragma unroll 2
                for (int s = 0; s < 64; ++s) {
                    const int tt = d ? 63 - s : s;
                    float a8[8], w8[8], b8[8], q8[8], rr8[8];
                    lds_ld8(Aa + tt * 64 + kq * 8, a8); lds_ld8(Ww + tt * 64 + kq * 8, w8); lds_ld8(Bb + tt * 64 + kq * 8, b8); lds_ld8(Kd + tt * 64 + kq * 8, q8); lds_ld8(Rr + tt * 64 + kq * 8, rr8);
                    const float vt = Vv[tt * 32 + sv];
                    float sa = 0.f;
#pragma unroll
                    for (int i = 0; i < 8; ++i) sa += st[i] * a8[i];
                    sa = red8(sa);
                    float y = 0.f;
#pragma unroll
                    for (int i = 0; i < 8; ++i) { st[i] = st[i] * w8[i] + sa * b8[i] + vt * q8[i]; y += st[i] * rr8[i]; }
                    y = red8(y);
                    if (kq == 0) Yl[tt * 32 + sv] = y;
                }
            }
            __syncthreads();
            { const int seg = F.tid & 7; const f32x4 y = *(const LAS f32x4*)(Yl + t * 32 + seg * 4);
              u32x2 w; w.x = cvt_pk_bf16(y.x, y.y); w.y = cvt_pk_bf16(y.z, y.w);
              *(u32x2*)(YD + ((size_t)d * MT + row) * 512 + h * 64 + vh * 32 + seg * 4) = w; }
            __syncthreads();
        }
    }
}
__device__ __forceinline__ void phase_rwkv_final(const Frame& F, const KA& P, int l) {
    LAS float* stt = (LAS float*)F.lds;
    const bf16_t* RKV = (const bf16_t*)(P.ws() + WS_RKV); const bf16_t* YD = (const bf16_t*)(P.ws() + WS_YD); const bf16_t* RWG = (const bf16_t*)(P.ws() + WS_RWG);
    const float* CBON = (const float*)(P.ws() + WS_CBON); bf16_t* RWOUT = (bf16_t*)(P.ws() + WS_RWOUT);
    const float* cw = P.in(I_RWCONV) + (size_t)l * 3 * 1536;
    const int c = F.tid, head = c >> 6;
    const float lnw = P.in(I_RWLNW)[l * 512 + c], lnb = P.in(I_RWLNB)[l * 512 + c];
    const float cw0 = cw[1024 + c], cw1 = cw[1536 + 1024 + c], cw2 = cw[3072 + 1024 + c];
    for (int tile = F.bid; tile < MT / 64; tile += F.G) {
        const int rowbase = tile * 64; const bool isc = rowbase >= ML;
        __syncthreads();
#pragma unroll 1
        for (int k = 0; k < 8; ++k) { const int t = F.wave * 8 + k; const size_t row = (size_t)rowbase + t;
            float y0[8], y1[8]; ld8bf(YD + row * 512 + F.lane * 8, y0); ld8bf(YD + ((size_t)MT + row) * 512 + F.lane * 8, y1);
            float s = 0.f;
#pragma unroll
            for (int i = 0; i < 8; ++i) {
#ifdef DBG_SAN2
                if (!(fabsf(y0[i]) < 1e30f)) y0[i] = 0.f; if (!(fabsf(y1[i]) < 1e30f)) y1[i] = 0.f;
#endif
                y0[i] += y1[i]; s += y0[i]; }
            const float mu = red8(s) * (1.0f / 64.0f); float q = 0.f;
#pragma unroll
            for (int i = 0; i < 8; ++i) { const float dd = y0[i] - mu; q += dd * dd; }
            const float rstd = rsqrtf(red8(q) * (1.0f / 64.0f) + 64e-5f);
            if ((F.lane & 7) == 0) { stt[(t * 8 + (F.lane >> 3)) * 2] = mu; stt[(t * 8 + (F.lane >> 3)) * 2 + 1] = rstd; } }
        __syncthreads();
        float xm = 0.f, x0 = bf2f(RKV[(size_t)rowbase * 1536 + 1024 + c]);
        if (isc && (rowbase - ML) % CTXL != 0) xm = bf2f(RKV[(size_t)(rowbase - 1) * 1536 + 1024 + c]);
#pragma unroll 2
        for (int t = 0; t < 64; ++t) { const size_t row = (size_t)rowbase + t;
            bool hi = t < 63; if (isc) hi = ((int)(row - ML) % CTXL) != CTXL - 1;
            const float xp = hi ? bf2f(RKV[(row + 1) * 1536 + 1024 + c]) : 0.f;
            const float v = cw0 * xm + cw1 * x0 + cw2 * xp; xm = x0; x0 = xp;
            float wk0 = bf2f(YD[row * 512 + c]), wk1 = bf2f(YD[((size_t)MT + row) * 512 + c]);
#ifdef DBG_SAN2
            if (!(fabsf(wk0) < 1e30f)) wk0 = 0.f; if (!(fabsf(wk1) < 1e30f)) wk1 = 0.f;
#endif
            const float wkv = wk0 + wk1;
            const float mu = stt[(t * 8 + head) * 2], rstd = stt[(t * 8 + head) * 2 + 1];
            const float cb = CBON[row * 8 + head] + CBON[((size_t)MT + row) * 8 + head];
            const float o = (wkv - mu) * rstd * lnw + lnb + cb * v;
            RWOUT[row * 512 + c] = f2bf(o * bf2f(RWG[row * 512 + c]));
        }
    }
    __syncthreads();
}

typedef float f32x16 __attribute__((ext_vector_type(16)));
constexpr int MP = 72, MSZ = 64 * MP * 2;
__device__ __forceinline__ int mi(int row, int col) { return row * MP + (col ^ (((row >> 3) & 7) << 3)); }
__device__ __forceinline__ int acc_row(int i, int hb) { return 8 * (i >> 2) + 4 * hb + (i & 3); }
__device__ __forceinline__ bf16x8 as_bf16x8(u32x4 w) { return __builtin_bit_cast(bf16x8, w); }
__device__ __forceinline__ unsigned pk_bf16_c(float lo, float hi) { unsigned a = __float_as_uint(lo), b = __float_as_uint(hi);
    a += 0x7fffu + ((a >> 16) & 1u); b += 0x7fffu + ((b >> 16) & 1u); return (a >> 16) | (b & 0xffff0000u); }
__device__ __forceinline__ void mm_tile(f32x16& acc, const LAS bf16_t* A, int row0, const LAS bf16_t* B, int col0, int lane, int q0, int q1) {
    const int r = lane & 31, hb = lane >> 5;
    for (int q = q0; q < q1; ++q) {
        const bf16x8 a = *(const LAS bf16x8*)(A + mi(row0 + r, 16 * q + 8 * hb)), b = *(const LAS bf16x8*)(B + mi(col0 + r, 16 * q + 8 * hb));
        acc = __builtin_amdgcn_mfma_f32_32x32x16_bf16(a, b, acc, 0, 0, 0);
    }
}
__device__ __forceinline__ void st_tile_T(LAS bf16_t* D, int col0, int row0, const f32x16& acc, int lane) {
    const int r = lane & 31, hb = lane >> 5;
#pragma unroll
    for (int g = 0; g < 4; ++g) { u32x2 w; w.x = cvt_pk_bf16(acc[4 * g], acc[4 * g + 1]); w.y = cvt_pk_bf16(acc[4 * g + 2], acc[4 * g + 3]);
        *(LAS u32x2*)(D + mi(col0 + r, row0 + 8 * g + 4 * hb)) = w; }
}
#define TOFF(i) ((8 * ((i) >> 2) + ((i) & 3)) * MP)
__device__ __forceinline__ void tile_base(int row0, int col0, int lane, int (&tb)[4]) {
    const int r = lane & 31, hb = lane >> 5, b0 = (row0 + 4 * hb) * MP + (col0 ^ row0);
#pragma unroll
    for (int g = 0; g < 4; ++g) tb[g] = b0 + (r ^ (8 * g));
}
__device__ __forceinline__ void st_tile_tb(LAS bf16_t* D, const int (&tb)[4], const f32x16& acc) {
#pragma unroll
    for (int i = 0; i < 16; i += 2) { const unsigned w = cvt_pk_bf16(acc[i], acc[i + 1]); D[tb[i >> 2] + TOFF(i)] = (bf16_t)(w & 0xffffu); D[tb[i >> 2] + TOFF(i + 1)] = (bf16_t)(w >> 16); }
}
__device__ __forceinline__ void st_tile(LAS bf16_t* D, int row0, int col0, const f32x16& acc, int lane) { int tb[4]; tile_base(row0, col0, lane, tb); st_tile_tb(D, tb, acc); }
__device__ __forceinline__ void write_permuted(const LAS bf16_t* X, unsigned char* dst, int tid) {
    const int tmq = tid >> 6, lane = tid & 63, tm = tmq >> 2, q = tmq & 3, r = lane & 31, hb = lane >> 5;
    const u32x2 lo = *(const LAS u32x2*)(X + mi(32 * tm + r, 16 * q + 4 * hb)), hi = *(const LAS u32x2*)(X + mi(32 * tm + r, 16 * q + 8 + 4 * hb));
    *(u32x4*)(dst + (size_t)tid * 16) = (u32x4){lo.x, lo.y, hi.x, hi.y};
}

struct RaIn { u32x4 x[9]; u32x4 a[4]; };
__device__ __forceinline__ void ra_unit_decode(int u, int bh, int& c, int& d, int& h, int& b) { c = u % NCHAIN; d = (u / NCHAIN) & 1; h = (u / (2 * NCHAIN)) & 7; b = bh * 4 + u / (16 * NCHAIN); }
__device__ __forceinline__ void ra_prefetch(RaIn& in, const bf16_t* RKV, const bf16_t* LORA, int u, int bh, int tid, int w, int lane) {
    int c, d, h, b; ra_unit_decode(u, bh, c, d, h, b);
    const int rowbase = chain_row(b, d, c); const bool isc = c < 4;
    const int s = tid >> 3, cg = tid & 7, t = d ? 63 - s : s, hc = h * 64 + cg * 8; const size_t row = (size_t)rowbase + t;
    bool lo = t > 0, hi = t < 63;
    if (isc) { const int tt = rowbase - (ML + b * CTXL) + t; lo = tt > 0; hi = tt < CTXL - 1; }
    const u32x4 z = (u32x4){0u, 0u, 0u, 0u};
#pragma unroll
    for (int sec = 0; sec < 3; ++sec) { const bf16_t* p = RKV + row * 1536 + sec * 512 + hc;
        const u32x4 xm = *(const u32x4*)(lo ? p - 1536 : p), xp = *(const u32x4*)(hi ? p + 1536 : p);
        in.x[sec * 3 + 0] = *(const u32x4*)p; in.x[sec * 3 + 1] = lo ? xm : z; in.x[sec * 3 + 2] = hi ? xp : z; }
    const int r = lane & 31, hb = lane >> 5, which = w >> 2, tm = (w >> 1) & 1, sp = 32 * tm + r, tp = d ? 63 - sp : sp;
    const bf16_t* ap = LORA + (size_t)(rowbase + tp) * 256 + which * 128 + d * 64 + 8 * hb;
#pragma unroll
    for (int q = 0; q < 4; ++q) in.a[q] = *(const u32x4*)(ap + 16 * q);
}
__device__ __forceinline__ void conv8_raw(const u32x4 x0v, const u32x4 xmv, const u32x4 xpv, int col, const float* cw, int cwld, float (&y)[8]) {
    f32x4 a0, a1, m0, m1, p0, p1; unpack8(x0v, a0, a1); unpack8(xmv, m0, m1); unpack8(xpv, p0, p1);
    float w0[8], w1[8], w2[8]; ld8f(cw + col, w0); ld8f(cw + cwld + col, w1); ld8f(cw + 2 * cwld + col, w2);
#pragma unroll
    for (int i = 0; i < 4; ++i) { y[i] = w0[i] * m0[i] + w1[i] * a0[i] + w2[i] * p0[i]; y[4 + i] = w0[4 + i] * m1[i] + w1[4 + i] * a1[i] + w2[4 + i] * p1[i]; }
}
__device__ __forceinline__ void conv8_lds(const u32x4 x0v, const u32x4 xmv, const u32x4 xpv, const LAS float* w, int cg, float (&y)[8]) {
    f32x4 a0, a1, m0, m1, p0, p1; unpack8(x0v, a0, a1); unpack8(xmv, m0, m1); unpack8(xpv, p0, p1);
    float w0[8], w1[8], w2[8]; lds_ld8(w + cg * 8, w0); lds_ld8(w + 64 + cg * 8, w1); lds_ld8(w + 128 + cg * 8, w2);
#pragma unroll
    for (int i = 0; i < 4; ++i) { y[i] = w0[i] * m0[i] + w1[i] * a0[i] + w2[i] * p0[i]; y[4 + i] = w0[4 + i] * m1[i] + w1[4 + i] * a1[i] + w2[4 + i] * p1[i]; }
}
__device__ __forceinline__ void phase_rwkv_chunkA(const Frame& F, const KA& P, int l, int bh) {
#define MAT(i) ((LAS bf16_t*)(F.lds + (i) * MSZ))
    LAS float* AAB = (LAS float*)(F.lds + 12 * MSZ);
    LAS float* PTl = AAB + 64 * 68;
    LAS float* LW = (LAS float*)(F.lds + 8 * MSZ);
    LAS float* CP = LW + 4096; LAS float* AS = CP + 4096; LAS float* SEG = AS + 4096; LAS float* SEGX = SEG + 512;
    const bf16_t* RKV = (const bf16_t*)(P.ws() + WS_RKV); const bf16_t* LORA = (const bf16_t*)(P.ws() + WS_LORA);
    bf16_t* YD = (bf16_t*)(P.ws() + WS_YD); float* CBON = (float*)(P.ws() + WS_CBON);
    const float* cw = P.in(I_RWCONV) + (size_t)l * 3 * 1536;
    const int w = F.wave;
    RaIn rin;
    const int hh = F.bid & 7, slot = F.bid >> 3, nslot = F.G >> 3; constexpr int NPH = 4 * 2 * NCHAIN;
    LAS float* WT = (LAS float*)(F.lds + 128512);
    for (int i = F.tid; i < 768; i += NTHR) { float v;
        if (i < 576) { const int sec = i / 192, tap = (i / 64) % 3, ch = i & 63; v = cw[tap * 1536 + sec * 512 + hh * 64 + ch]; }
        else { const int which = (i - 576) >> 6, ch = i & 63; v = (which == 0 ? P.in(I_RWKK) : which == 1 ? P.in(I_RWKA) : P.in(I_RWRK))[l * 512 + hh * 64 + ch]; }
        WT[i] = v; }
#define RA_UNIT_OF(idx) (((((idx) / (2 * NCHAIN)) * 8 + hh) * 2 + (((idx) / NCHAIN) & 1)) * NCHAIN + (idx) % NCHAIN)
    if (slot < NPH) { const int l0 = fresh_lane(); ra_prefetch(rin, RKV, LORA, RA_UNIT_OF(slot), bh, w * 64 + l0, w, l0); }
    for (int uidx = slot; uidx < NPH; uidx += nslot) {
        const int u = RA_UNIT_OF(uidx);
        const int lane = fresh_lane(), tid = w * 64 + lane, r = lane & 31, hb = lane >> 5;
        const int c = u % NCHAIN, d = (u / NCHAIN) & 1, h = (u / (2 * NCHAIN)) & 7, b = bh * 4 + u / (16 * NCHAIN);
        const int rowbase = chain_row(b, d, c); const bool isc = c < 4;
        unsigned char* ra = P.ws() + WS_RA + (size_t)u * RA_UNIT;
        __syncthreads();
        const int p2_which = w >> 2, p2_tm = (w >> 1) & 1, p2_tn = w & 1;
        u32x4 p2a[4], p2b[4]; float p2bias;
        { const int sp = 32 * p2_tm + r, tp = d ? 63 - sp : sp;
          (void)tp;
          const bf16_t* bp = (const bf16_t*)(P.ws() + WS_W_LORA) + ((size_t)((l * 2 + d) * 2 + p2_which) * 512 + h * 64 + 32 * p2_tn + r) * 64 + 8 * hb;
#pragma unroll
          for (int q = 0; q < 4; ++q) { p2a[q] = rin.a[q]; p2b[q] = *(const u32x4*)(bp + 16 * q); }
          p2bias = (p2_which ? P.in(I_RWA0) : P.in(I_RWW0))[(l * 2 + d) * 512 + h * 64 + 32 * p2_tn + r]; }
        const int s = tid >> 3, cg = tid & 7, t = d ? 63 - s : s, hc = h * 64 + cg * 8; const size_t row = (size_t)rowbase + t;
        float kkw[8], kaw[8], rkw[8]; lds_ld8(WT + 576 + cg * 8, kkw); lds_ld8(WT + 640 + cg * 8, kaw); lds_ld8(WT + 704 + cg * 8, rkw);
        bool lo = t > 0, hi = t < 63;
        if (isc) { const int tt = rowbase - (ML + b * CTXL) + t; lo = tt > 0; hi = tt < CTXL - 1; }
        float r8[8], k8[8], kk[8];
        { float v8[8]; conv8_lds(rin.x[6], rin.x[7], rin.x[8], WT + 384, cg, v8);
#pragma unroll
          for (int i = 0; i < 8; ++i) MAT(5)[mi(cg * 8 + i, s)] = f2bf(v8[i]); }
        conv8_lds(rin.x[0], rin.x[1], rin.x[2], WT, cg, r8); conv8_lds(rin.x[3], rin.x[4], rin.x[5], WT + 192, cg, k8);
        (void)lo; (void)hi;
        { float ss = 0.f;
#pragma unroll
          for (int i = 0; i < 8; ++i) { kk[i] = k8[i] * kkw[i]; ss += kk[i] * kk[i]; }
          ss = red8(ss); const float inv = rsqrtf(fmaxf(ss, 1e-24f));
#pragma unroll
          for (int i = 0; i < 8; ++i) kk[i] *= inv; }
        { const int which = p2_which, tm = p2_tm, tn = p2_tn;
          f32x16 acc;
#pragma unroll
          for (int i = 0; i < 16; ++i) acc[i] = 0.f;
#pragma unroll
          for (int q = 0; q < 4; ++q) acc = __builtin_amdgcn_mfma_f32_32x32x16_bf16(as_bf16x8(p2a[q]), as_bf16x8(p2b[q]), acc, 0, 0, 0);
          const float bias = p2bias;
          LAS float* dst = which ? AS : LW;
          LAS float* dp = dst + (32 * tm + 4 * hb) * 64 + 32 * tn + r;
          if (which) {
#pragma unroll
              for (int i = 0; i < 16; ++i) dp[(8 * (i >> 2) + (i & 3)) * 64] = sigmoidf_(acc[i] + bias);
          } else {
#pragma unroll
              for (int i = 0; i < 16; ++i) dp[(8 * (i >> 2) + (i & 3)) * 64] = -0.60653066f * sigmoidf_(acc[i] + bias); } }
        asm volatile("" ::: "memory");
        { const int un = (uidx + nslot < NPH) ? RA_UNIT_OF(uidx + nslot) : u;
          ra_prefetch(rin, RKV, LORA, un, bh, tid, w, lane); }
        __syncthreads();
        { const int k = tid & 63, seg = tid >> 6; float p = 0.f;
#pragma unroll
          for (int i = 0; i < 8; ++i) { p += LW[(8 * seg + i) * 64 + k]; CP[(8 * seg + i) * 64 + k] = p; }
          SEG[seg * 64 + k] = p; }
        __syncthreads();
        if (w == 0) { float a = 0.f;
#pragma unroll
          for (int g = 0; g < 8; ++g) { SEGX[g * 64 + lane] = a; a += SEG[g * 64 + lane]; }
          SEGX[512 + lane] = a; PTl[lane] = __expf(a); }
        __syncthreads();
        { float lw[8], cp[8], as[8], off[8], tot[8];
          lds_ld8(LW + s * 64 + cg * 8, lw); lds_ld8(CP + s * 64 + cg * 8, cp); lds_ld8(AS + s * 64 + cg * 8, as);
          lds_ld8(SEGX + (s >> 3) * 64 + cg * 8, off); lds_ld8(SEGX + 512 + cg * 8, tot);
          float at[8], rt[8], bt[8], kt[8], bhv[8], khv[8]; float cb = 0.f;
#pragma unroll
          for (int i = 0; i < 8; ++i) { const float cum = cp[i] + off[i]; const float e2 = __expf(cum), e1 = __expf(cum - lw[i]), e3 = __expf(-cum), e4 = __expf(tot[i] - cum);
              const float kd = k8[i] * (1.0f + (as[i] - 1.0f) * kaw[i]), bb = kk[i] * as[i];
              at[i] = -kk[i] * e1; rt[i] = r8[i] * e2; bt[i] = bb * e3; kt[i] = kd * e3; bhv[i] = bb * e4; khv[i] = kd * e4; cb += r8[i] * rkw[i] * kd;
              }
          *(LAS u32x4*)(MAT(0) + mi(s, cg * 8)) = pack8((f32x4){at[0], at[1], at[2], at[3]}, (f32x4){at[4], at[5], at[6], at[7]});
          *(LAS u32x4*)(MAT(1) + mi(s, cg * 8)) = pack8((f32x4){rt[0], rt[1], rt[2], rt[3]}, (f32x4){rt[4], rt[5], rt[6], rt[7]});
          *(LAS u32x4*)(MAT(6) + mi(s, cg * 8)) = pack8((f32x4){bt[0], bt[1], bt[2], bt[3]}, (f32x4){bt[4], bt[5], bt[6], bt[7]});
          *(LAS u32x4*)(MAT(7) + mi(s, cg * 8)) = pack8((f32x4){kt[0], kt[1], kt[2], kt[3]}, (f32x4){kt[4], kt[5], kt[6], kt[7]});
#pragma unroll
          for (int i = 0; i < 8; ++i) { MAT(2)[mi(cg * 8 + i, s)] = f2bf(at[i]); MAT(3)[mi(cg * 8 + i, s)] = f2bf(bhv[i]); MAT(4)[mi(cg * 8 + i, s)] = f2bf(khv[i]); }
          cb = red8(cb);
          if (cg == 0) CBON[((size_t)d * MT + row) * 8 + h] = cb; }
        __syncthreads();
        { const int am = w >> 1, tm = w & 1;
          const LAS bf16_t* A = (am < 2) ? MAT(0) : MAT(1); const LAS bf16_t* B = (am & 1) ? MAT(7) : MAT(6);
#pragma unroll
          for (int tn = 0; tn < 2; ++tn) {
              f32x16 acc;
#pragma unroll
              for (int i = 0; i < 16; ++i) acc[i] = 0.f;
              if (!(tm == 0 && tn == 1)) mm_tile(acc, A, 32 * tm, B, 32 * tn, lane, 0, 4);
              const int dl = 32 * tn + r - (32 * tm + 4 * hb) - ((am < 2) ? 0 : 1);
              if (am == 0) { LAS float* dp = AAB + (32 * tn + r) * 68 + 8 * tm + hb;
#pragma unroll
                  for (int i = 0; i < 16; ++i) { const int ci = 8 * (i >> 2) + (i & 3); dp[(i & 3) * 16 + 2 * (i >> 2)] = (dl < ci) ? acc[i] : 0.f; }
              } else { int tb[4]; tile_base(32 * tm, 32 * tn, lane, tb); f32x16 mv;
#pragma unroll
                  for (int i = 0; i < 16; ++i) { const int ci = 8 * (i >> 2) + (i & 3); mv[i] = (dl < ci) ? acc[i] : 0.f; }
                  st_tile_tb(MAT(7 + am), tb, mv); } } }
        __syncthreads();
        f32x16 pre_y, pre_s;
        { float z = 0.f; asm volatile("" : "+v"(z)); pre_y = (f32x16){z, z, z, z, z, z, z, z, z, z, z, z, z, z, z, z}; pre_s = pre_y; }
        if (w < 4) {
            const int cc = tid >> 2, jq = tid & 3; float x[16];
#pragma unroll
            for (int i = 0; i < 16; ++i) x[i] = (4 * i + jq == cc) ? 1.0f : 0.f;
            const LAS float* ap = AAB + jq * 16;
#pragma unroll
            for (int g = 0; g < 16; ++g) {
#pragma unroll
                for (int k = 0; k < 4; ++k) {
                    if (g == 15 && k == 3) continue;
                    const int sst = 4 * g + k;
                    f32x4 a[4];
#pragma unroll
                    for (int q = 0; q < 4; ++q) if (q >= (g >> 2)) a[q] = *(const LAS f32x4*)(ap + sst * 68 + 4 * q);
                    float xs;
                    if (k == 0) xs = dpp_f<0x00>(x[g]); else if (k == 1) xs = dpp_f<0x55>(x[g]); else if (k == 2) xs = dpp_f<0xAA>(x[g]); else xs = dpp_f<0xFF>(x[g]);
#pragma unroll
                    for (int i = 0; i < 16; ++i) if (i >= g) x[i] = fmaf(a[i >> 2][i & 3], xs, x[i]);
                }
            }
#pragma unroll
            for (int i = 0; i < 16; ++i) MAT(11)[mi(4 * i + jq, cc)] = f2bf(x[i]);
        } else {
            const int tm = (w - 4) >> 1, tn = (w - 4) & 1; f32x16 acc;
#pragma unroll
            for (int i = 0; i < 16; ++i) acc[i] = 0.f;
            mm_tile(acc, MAT(8), 32 * tm, MAT(5), 32 * tn, lane, 0, tm ? 4 : 2);
            st_tile_T(MAT(6), 32 * tn, 32 * tm, acc, lane);
#pragma unroll
            for (int i = 0; i < 16; ++i) { pre_y[i] = 0.f; pre_s[i] = 0.f; }
            mm_tile(pre_y, MAT(10), 32 * tm, MAT(5), 32 * tn, lane, 0, tm ? 4 : 2);
            mm_tile(pre_s, MAT(4), 32 * tm, MAT(5), 32 * tn, lane, 0, 4);
        }
        __syncthreads();
        { const int tm = w & 1, tn = w >> 1; f32x16 acc;
#pragma unroll
          for (int i = 0; i < 16; ++i) acc[i] = 0.f;
          mm_tile(acc, MAT(11), 32 * tm, (tn < 2) ? MAT(2) : MAT(6), 32 * (tn & 1), lane, 0, tm ? 4 : 2);
          st_tile_T((tn < 2) ? MAT(7) : MAT(8), 32 * (tn & 1), 32 * tm, acc, lane); }
        __syncthreads();
        if (w < 4) { const int tm = w >> 1, tn = w & 1; f32x16 acc; int tb[4]; tile_base(32 * tm, 32 * tn, lane, tb);
#pragma unroll
            for (int i = 0; i < 16; ++i) acc[i] = bf2f(MAT(1)[tb[i >> 2] + TOFF(i)]);
            mm_tile(acc, MAT(9), 32 * tm, MAT(7), 32 * tn, lane, 0, tm ? 4 : 2);
            st_tile_tb(MAT(11), tb, acc);
        } else { const int tm = (w - 4) >> 1, tn = (w - 4) & 1; f32x16 acc = pre_y;
            mm_tile(acc, MAT(9), 32 * tm, MAT(8), 32 * tn, lane, 0, tm ? 4 : 2);
            u32x4* yd = (u32x4*)((unsigned char*)YD + (size_t)u * 8192 + (size_t)((tm * 2 + tn) * 64 + lane) * 32);
            yd[0] = pack8((f32x4){acc[0], acc[1], acc[2], acc[3]}, (f32x4){acc[4], acc[5], acc[6], acc[7]});
            yd[1] = pack8((f32x4){acc[8], acc[9], acc[10], acc[11]}, (f32x4){acc[12], acc[13], acc[14], acc[15]});
        }
        if (w < 4) { const int tm = w >> 1, tn = w & 1; f32x16 acc;
#pragma unroll
            for (int i = 0; i < 16; ++i) acc[i] = 0.f;
            mm_tile(acc, MAT(3), 32 * tm, MAT(7), 32 * tn, lane, 0, 4);
            st_tile(MAT(10), 32 * tm, 32 * tn, acc, lane);
        } else { const int tm = (w - 4) >> 1, tn = (w - 4) & 1; f32x16 acc = pre_s;
            mm_tile(acc, MAT(3), 32 * tm, MAT(8), 32 * tn, lane, 0, 4);
#ifdef DBG_NANQ
            { float z = 0.f;
#pragma unroll
              for (int i = 0; i < 16; ++i) {
                  if (DBG_NANQ & 1) z += 0.f * bf2f(MAT(11)[mi(32 * tm + acc_row(i, hb), 32 * tn + r)]);
                  if (DBG_NANQ & 2) z += 0.f * acc[i];
              }
              const int ss0 = 32 * tm + acc_row(0, hb), tt0 = d ? 63 - ss0 : ss0;
              bf16_t* yq = YD + ((size_t)d * MT + rowbase + tt0) * 512 + h * 64 + 32 * tn + r; *yq = f2bf(bf2f(*yq) + z); }
#endif
            u32x4* dst = (u32x4*)(ra + 16384 + ((size_t)((tn * 2 + tm) * 64 + lane)) * 32);
            dst[0] = pack8((f32x4){acc[0], acc[1], acc[2], acc[3]}, (f32x4){acc[4], acc[5], acc[6], acc[7]});
            dst[1] = pack8((f32x4){acc[8], acc[9], acc[10], acc[11]}, (f32x4){acc[12], acc[13], acc[14], acc[15]});
        }
        __syncthreads();
        write_permuted(MAT(11), ra, tid);
        write_permuted(MAT(10), ra + 8192, tid);
        if (tid < 64) ((float*)(ra + 24576))[tid] = PTl[tid];
    }
    __syncthreads();
#undef MAT
#undef RA_UNIT_OF
}
constexpr int RB_SLOT = 12800, RB_RING = 12288, RB_NSLOT = 8;
__device__ __forceinline__ void rb_spin(volatile LAS int* w, int need) { unsigned spins = 0; while (*w < need) { __builtin_amdgcn_s_sleep(1); if (++spins > (1u << 22)) break; } asm volatile("" ::: "memory"); }
struct RbOps { u32x4 ogm[2], ogo[2], osl[2]; f32x4 opt[4]; };
__device__ __forceinline__ void rb_read_ops(RbOps& o, const LAS unsigned char* slot, int tk, int lane, int hb) {
#pragma unroll
    for (int s2 = 0; s2 < 2; ++s2) { o.ogm[s2] = *(const LAS u32x4*)(slot + ((tk * 4 + 2 * tk + s2) * 64 + lane) * 16); o.ogo[s2] = *(const LAS u32x4*)(slot + ((tk * 4 + 2 * (1 - tk) + s2) * 64 + lane) * 16); }
    o.osl[0] = *(const LAS u32x4*)(slot + 8192 + (tk * 64 + lane) * 32); o.osl[1] = *(const LAS u32x4*)(slot + 8192 + (tk * 64 + lane) * 32 + 16);
#pragma unroll
    for (int g = 0; g < 4; ++g) o.opt[g] = *(const LAS f32x4*)(slot + 12288 + (32 * tk + 8 * g + 4 * hb) * 4);
}
__device__ __forceinline__ void rb_spin_fast(volatile LAS int* w, int need) { unsigned spins = 0; while (*w < need) { if (++spins > (1u << 24)) break; } asm volatile("" ::: "memory"); }
__device__ __forceinline__ void phase_rwkv_chunkB(const Frame& F, const KA& P, int bh) {
    LAS unsigned char* xb = F.lds;
    volatile LAS int* flg = (volatile LAS int*)(F.lds + 8192);
    if (F.tid < 16) flg[F.tid] = 0;
    __syncthreads();
    const int lane = F.lane, hb = lane >> 5, w = F.wave;
    const int ci = F.bid;
    float z = 0.f; asm volatile("" : "+v"(z));
    f32x16 S = (f32x16){z, z, z, z, z, z, z, z, z, z, z, z, z, z, z, z};
    if (ci < 128) {
    const int bl = ci >> 5, h = (ci >> 2) & 7, d = (ci >> 1) & 1, vh = ci & 1;
    const size_t u0 = (size_t)(((bl * 8 + h) * 2 + d) * NCHAIN);
    const unsigned char* ra = P.ws() + WS_RA + u0 * RA_UNIT;
    if (w >= 2) {
        for (int c = w - 2; c < NCHAIN; c += 6) {
            if (c >= RB_NSLOT) { rb_spin(flg + 10, c - RB_NSLOT + 1); rb_spin(flg + 11, c - RB_NSLOT + 1); }
            const unsigned char* src = ra + (size_t)c * RA_UNIT;
            u32x4 g[8], s4[4];
#pragma unroll
            for (int i = 0; i < 8; ++i) g[i] = *(const u32x4*)(src + 8192 + (size_t)(i * 64 + lane) * 16);
#pragma unroll
            for (int tk = 0; tk < 2; ++tk) { const u32x4* sl = (const u32x4*)(src + 16384 + (size_t)((vh * 2 + tk) * 64 + lane) * 32); s4[2 * tk] = sl[0]; s4[2 * tk + 1] = sl[1]; }
            const float ptv = ((const float*)(src + 24576))[lane];
            LAS unsigned char* slot = F.lds + RB_RING + (c & (RB_NSLOT - 1)) * RB_SLOT;
#pragma unroll
            for (int i = 0; i < 8; ++i) *(LAS u32x4*)(slot + (i * 64 + lane) * 16) = g[i];
#pragma unroll
            for (int tk = 0; tk < 2; ++tk) { *(LAS u32x4*)(slot + 8192 + (tk * 64 + lane) * 32) = s4[2 * tk]; *(LAS u32x4*)(slot + 8192 + (tk * 64 + lane) * 32 + 16) = s4[2 * tk + 1]; }
            *(LAS float*)(slot + 12288 + lane * 4) = ptv;
            asm volatile("s_waitcnt lgkmcnt(0)" ::: "memory");
            if (lane == 0) flg[c & (RB_NSLOT - 1)] = c + 1;
        }
    } else {
    const int tk = w;
    unsigned char* sc = P.ws() + WS_SC + (u0 * 2 + vh) * 4096;
    S = (f32x16){z, z, z, z, z, z, z, z, z, z, z, z, z, z, z, z};
    RbOps opA, opB;
    rb_spin(flg + 0, 1); rb_read_ops(opA, F.lds + RB_RING, tk, lane, hb);
    asm volatile("s_waitcnt lgkmcnt(0)" ::: "memory");
    if (lane == 0) flg[10 + tk] = 1;
#define RB_STEP(cc, CUR, NXT) do { const int c_ = (cc); \
        u32x4 mine[2], other[2]; LAS u32x4* buf = (LAS u32x4*)(xb + (c_ & 1) * 4096); unsigned char* scc = sc + (size_t)c_ * 8192; \
        _Pragma("unroll") for (int s2 = 0; s2 < 2; ++s2) { const int b0 = 8 * s2, q = 2 * tk + s2; \
            const u32x4 wv = (u32x4){cvt_pk_bf16(S[b0], S[b0 + 1]), cvt_pk_bf16(S[b0 + 2], S[b0 + 3]), cvt_pk_bf16(S[b0 + 4], S[b0 + 5]), cvt_pk_bf16(S[b0 + 6], S[b0 + 7])}; \
            mine[s2] = wv; buf[q * 64 + lane] = wv; *(u32x4*)(scc + (size_t)(q * 64 + lane) * 16) = wv; } \
        asm volatile("s_waitcnt lgkmcnt(0)" ::: "memory");                \
        if (lane == 0) flg[8 + tk] = c_ + 1; \
        f32x4 a0, a1, a2, a3; unpack8(CUR.osl[0], a0, a1); unpack8(CUR.osl[1], a2, a3); \
        f32x16 n; \
        _Pragma("unroll") for (int i = 0; i < 4; ++i) { n[i] = a0[i] + CUR.opt[0][i] * S[i]; n[4 + i] = a1[i] + CUR.opt[1][i] * S[4 + i]; n[8 + i] = a2[i] + CUR.opt[2][i] * S[8 + i]; n[12 + i] = a3[i] + CUR.opt[3][i] * S[12 + i]; } \
        _Pragma("unroll") for (int s2 = 0; s2 < 2; ++s2) n = __builtin_amdgcn_mfma_f32_32x32x16_bf16(as_bf16x8(CUR.ogm[s2]), as_bf16x8(mine[s2]), n, 0, 0, 0);     \
        if (c_ + 1 < NCHAIN) { rb_spin(flg + ((c_ + 1) & (RB_NSLOT - 1)), c_ + 2); rb_read_ops(NXT, F.lds + RB_RING + ((c_ + 1) & (RB_NSLOT - 1)) * RB_SLOT, tk, lane, hb); } \
        rb_spin_fast(flg + 8 + (1 - tk), c_ + 1); \
        _Pragma("unroll") for (int s2 = 0; s2 < 2; ++s2) { const int q = 2 * (1 - tk) + s2; other[s2] = buf[q * 64 + lane]; } \
        _Pragma("unroll") for (int s2 = 0; s2 < 2; ++s2) n = __builtin_amdgcn_mfma_f32_32x32x16_bf16(as_bf16x8(CUR.ogo[s2]), as_bf16x8(other[s2]), n, 0, 0, 0); \
        S = n; \
        asm volatile("s_waitcnt lgkmcnt(0)" ::: "memory");                \
        if (lane == 0) flg[10 + tk] = c_ + 2; \
    } while (0)
#pragma unroll 1
    for (int c = 0; c < NCHAIN; c += 2) { RB_STEP(c, opA, opB); RB_STEP(c + 1, opB, opA); }
#undef RB_STEP
    } }
}
struct RcIn { u32x4 yv[2]; u32x4 q[4]; u32x4 s[4]; };
__device__ __forceinline__ void rc_prefetch(RcIn& in, const KA& P, const bf16_t* YD, int u, int bh, int w, int lane) {
    const int r = lane & 31, hb = lane >> 5;
    const int tc = u % NCHAIN, h = (u / NCHAIN) & 7, bl = u / (8 * NCHAIN), b = bh * 4 + bl;
    const bool isc = tc < 4; const int j = isc ? tc : tc - 4; const int rowbase = isc ? ML + b * CTXL + 64 * j : b * SEQL + 64 * j;
    const int d = w >> 2, vh = (w >> 1) & 1, tm = w & 1;
    const int c = isc ? (d ? 3 - j : j) : (d ? 67 - j : 4 + j);
    const size_t uu = (size_t)(((bl * 8 + h) * 2 + d) * NCHAIN + c);
    const unsigned char* ra = P.ws() + WS_RA + uu * RA_UNIT; const unsigned char* sc = P.ws() + WS_SC + (uu * 2 + vh) * 4096;
    { const u32x4* yd = (const u32x4*)((const unsigned char*)YD + uu * 8192 + (size_t)((tm * 2 + vh) * 64 + lane) * 32); in.yv[0] = yd[0]; in.yv[1] = yd[1]; }
#pragma unroll
    for (int q = 0; q < 4; ++q) { in.q[q] = *(const u32x4*)(ra + (size_t)((tm * 4 + q) * 64 + lane) * 16); in.s[q] = *(const u32x4*)(sc + (size_t)(q * 64 + lane) * 16); }
}
__device__ __forceinline__ void phase_rwkv_chunkC(const Frame& F, const KA& P, int l, int bh, bool dummy = false) {
    constexpr int YP = 68;
    LAS float* Ys = (LAS float*)F.lds;
    const bf16_t* RKV = (const bf16_t*)(P.ws() + WS_RKV); const bf16_t* YD = (const bf16_t*)(P.ws() + WS_YD); const bf16_t* RWG = (const bf16_t*)(P.ws() + WS_RWG);
    const float* CBON = (const float*)(P.ws() + WS_CBON); bf16_t* RWOUT = (bf16_t*)(P.ws() + WS_RWOUT);
    const float* cw = P.in(I_RWCONV) + (size_t)l * 3 * 1536;
    const int w = F.wave;
    RcIn cin;
    const int hh = F.bid & 7, slot = F.bid >> 3, nslot = F.G >> 3; constexpr int NPH = 4 * NCHAIN;
    LAS float* WT = (LAS float*)(F.lds + 36864);
    for (int i = F.tid; i < 320; i += NTHR) { const int ch = i & 63;
        WT[i] = (i < 192) ? cw[(i >> 6) * 1536 + 1024 + hh * 64 + ch] : (i < 256) ? P.in(I_RWLNW)[l * 512 + hh * 64 + ch] : P.in(I_RWLNB)[l * 512 + hh * 64 + ch]; }
    __syncthreads();
#define RC_UNIT_OF(idx) ((((idx) / NCHAIN) * 8 + hh) * NCHAIN + (idx) % NCHAIN)
    if (slot < NPH) rc_prefetch(cin, P, YD, RC_UNIT_OF(slot), bh, w, fresh_lane());
    for (int uidx = slot; uidx < NPH; uidx += nslot) {
        const int u = RC_UNIT_OF(uidx);
        const int lane = fresh_lane(), tid = w * 64 + lane, r = lane & 31, hb = lane >> 5;
        const int tc = u % NCHAIN, h = (u / NCHAIN) & 7, bl = u / (8 * NCHAIN), b = bh * 4 + bl;
        const bool isc = tc < 4; const int j = isc ? tc : tc - 4; const int rowbase = isc ? ML + b * CTXL + 64 * j : b * SEQL + 64 * j;
        const int ft = tid >> 3, fcg = tid & 7, fhc = h * 64 + fcg * 8; const size_t frow = (size_t)rowbase + ft;
        float v8[8], lnw[8], lnb[8], g8[8]; float cb;
        { bool lo = ft > 0, hi = ft < 63;
          if (isc) { const int tt = rowbase - (ML + b * CTXL) + ft; lo = tt > 0; hi = tt < CTXL - 1; }
          { float x0[8], xm[8], xp[8], w0[8], w1[8], w2[8];
            ld8bf(RKV + frow * 1536 + 1024 + fhc, x0);
            if (lo) ld8bf(RKV + (frow - 1) * 1536 + 1024 + fhc, xm); else { for (int i = 0; i < 8; ++i) xm[i] = 0.f; }
            if (hi) ld8bf(RKV + (frow + 1) * 1536 + 1024 + fhc, xp); else { for (int i = 0; i < 8; ++i) xp[i] = 0.f; }
            lds_ld8(WT + fcg * 8, w0); lds_ld8(WT + 64 + fcg * 8, w1); lds_ld8(WT + 128 + fcg * 8, w2);
#pragma unroll
            for (int i = 0; i < 8; ++i) v8[i] = w0[i] * xm[i] + w1[i] * x0[i] + w2[i] * xp[i]; }
          cb = CBON[frow * 8 + h] + CBON[((size_t)MT + frow) * 8 + h];
          lds_ld8(WT + 192 + fcg * 8, lnw); lds_ld8(WT + 256 + fcg * 8, lnb); ld8bf(RWG + frow * 512 + fhc, g8); }
        __syncthreads();
        { const int d = w >> 2, vh = (w >> 1) & 1, tm = w & 1;
          f32x16 y;
#pragma unroll
          for (int i = 0; i < 1; ++i) { f32x4 y0, y1, y2, y3; unpack8(cin.yv[0], y0, y1); unpack8(cin.yv[1], y2, y3);
#pragma unroll
              for (int k = 0; k < 4; ++k) { y[k] = y0[k]; y[4 + k] = y1[k]; y[8 + k] = y2[k]; y[12 + k] = y3[k]; } }
#pragma unroll
          for (int q = 0; q < 4; ++q) y = __builtin_amdgcn_mfma_f32_32x32x16_bf16(as_bf16x8(cin.q[q]), as_bf16x8(cin.s[q]), y, 0, 0, 0);
          rc_prefetch(cin, P, YD, (uidx + nslot < NPH) ? RC_UNIT_OF(uidx + nslot) : u, bh, w, lane);
          { LAS float* yp0 = Ys + (d * 64 + (d ? 63 - 32 * tm - 4 * hb : 32 * tm + 4 * hb)) * YP + 32 * vh + r; const int ys = d ? -YP : YP;
#pragma unroll
            for (int i = 0; i < 16; ++i) yp0[(8 * (i >> 2) + (i & 3)) * ys] = y[i]; } }
        __syncthreads();
        { const int t = ft, cg = fcg, hc = fhc; const size_t row = frow;
          float wk[8], a1[8];
          lds_ld8(Ys + t * YP + cg * 8, wk); lds_ld8(Ys + (64 + t) * YP + cg * 8, a1);
          float s = 0.f;
#pragma unroll
          for (int i = 0; i < 8; ++i) { wk[i] += a1[i]; s += wk[i]; }
          const float mu = red8(s) * (1.0f / 64.0f); float q2 = 0.f;
#pragma unroll
          for (int i = 0; i < 8; ++i) { const float dd = wk[i] - mu; q2 += dd * dd; }
          const float rstd = rsqrtf(red8(q2) * (1.0f / 64.0f) + 64e-5f);
          f32x4 o0, o1;
#pragma unroll
          for (int i = 0; i < 4; ++i) { o0[i] = ((wk[i] - mu) * rstd * lnw[i] + lnb[i] + cb * v8[i]) * g8[i]; o1[i] = ((wk[4 + i] - mu) * rstd * lnw[4 + i] + lnb[4 + i] + cb * v8[4 + i]) * g8[4 + i]; }
          if (dummy) *(u32x4*)((bf16_t*)(P.ws() + WS_U) + (row & 16383) * 512 + hc) = pack8(o0, o1);
          else *(u32x4*)(RWOUT + row * 512 + hc) = pack8(o0, o1); }
    }
    __syncthreads();
}

#ifndef PROBE
#define PROBE 0
#endif
#define PREP(k) for (int _rep = 0; _rep < ((PROBE == (k)) ? 2 : 1); ++_rep)
#ifndef GEN
#define GEN 0xffffffff
#endif
#ifndef EN
#define EN 0xffffffff
#endif
#ifndef MK_PER_PHASE
#define MK_PER_PHASE 0
#endif
constexpr int MAX_PHASES = 35;

__device__ __forceinline__ void ka_opq(KA& P, Frame& F, int& ph) { asm volatile("" : "+s"(P.p), "+s"(F.wave), "+s"(F.bid), "+s"(F.G), "+s"(ph)); F.gw = F.bid * NWAVES + F.wave; F.NGW = F.G * NWAVES; }
__global__ void __launch_bounds__(NTHR, 2) mega_fwd(Params P_unused) {
    KA P; P.p = (const CAS unsigned char*)__builtin_amdgcn_kernarg_segment_ptr();
    extern __shared__ __attribute__((aligned(16))) unsigned char lds_raw[];
    Frame F; F.lds = (LAS unsigned char*)lds_raw;
    F.wave = __builtin_amdgcn_readfirstlane((int)threadIdx.x >> 6); F.lane = fresh_lane(); F.tid = F.wave * 64 + F.lane; F.bid = blockIdx.x; F.G = gridDim.x; F.gw = F.bid * NWAVES + F.wave; F.NGW = F.G * NWAVES;
    #define ws (P.ws())
    if (F.tid == 0) *(LAS u32x4*)(F.lds + LDS_XB) = (u32x4){0u, 0u, 0u, 0u};
    __syncthreads();
    XcdBarrier bar; bar.bar = (unsigned*)(ws + WS_CTL) + CW_BAR; bar.x = 0; bar.st = nullptr;
    const bool use_bar = (P.ph_hi() - P.ph_lo()) > 1;
    if (use_bar) bar = xcd_barrier_post((unsigned*)(ws + WS_CTL) + CW_BAR, (volatile LAS unsigned*)(F.lds + LDS_XB), F.wave);
    int ph = 0;
#define PH_ON (ka_opq(P, F, ph), F.lane = fresh_lane(), F.tid = F.wave * 64 + F.lane, (ph >= P.ph_lo() && ph < P.ph_hi()))
#define PH_END do { if (PH_ON && (ph + 1) < P.ph_hi()) xcd_barrier(bar, F.wave, (unsigned*)(ws + WS_CTL) + CW_BAR); ++ph; } while (0)

    bf16_t* H = (bf16_t*)(ws + WS_H);
    float* YF = (float*)(ws + WS_YF);
    float* CTXX = (float*)(ws + WS_CTXX);

    if (PROBE == 30 && use_bar) { for (int i = 0; i < 40; ++i) xcd_barrier(bar, F.wave, (unsigned*)(ws + WS_CTL) + CW_BAR); }
    if (PH_ON) { PREP(20) { PREP(34) { if (EN & 1) p0_prologue(F, P); __syncthreads(); } } }
    PH_END;

#pragma unroll 1
    for (int l = 0; l < NLAYER; ++l) {
        const float* ng = P.in(I_NORMG) + (size_t)l * 4 * 1024;
        const int Mrows = (l == 0) ? MT : ML;
        if (PH_ON) {
            if (l == 0) {
                if (EN & 4096) phase_resid_norm<0, false>(F, P, 0, 0, P.in(I_X), P.in(I_CTX), nullptr, 0, nullptr, nullptr, nullptr, ng, 0, H, MT, nullptr);
                __syncthreads();
                PREP(20) { PREP(35) { if (EN & 8192) phase_hyena_filter_mlp(F, P, 0, SEQL, (float*)(ws + WS_HFILT));
                if (EN & 8192) phase_hyena_filter_mlp(F, P, 0, CTXL, (float*)(ws + WS_HFILTC)); } }
            }
        }
        if (l == 0) PH_END;
        if (PH_ON) {
            if (l == 1) { if (EN & 8192) phase_hyena_filter_mlp(F, P, 1, SEQL, (float*)(ws + WS_HFILT)); __syncthreads(); }
            PREP(1) {
            pg8::Gemm g{H, (const bf16_t*)(ws + WS_W_IN) + (size_t)l * INP_N * 1024, MT, INP_N, 1024}; pg8::StaticOrder S; S.init(MT, INP_N, F.G, F.bid);
            pg8::EpiInProj E{(bf16_t*)(ws + WS_U), (bf16_t*)(ws + WS_RKV), (bf16_t*)(ws + WS_HY), (bf16_t*)(ws + WS_LORA), (bf16_t*)(ws + WS_GL)};
            if (GEN & 1) pg8::gemm_phase(F.lds, g, S, E, F.wave);
            }
        }
        PH_END;
        if (PH_ON) { PREP(20) { PREP(31) { if (EN & 4) phase_hyena_transpose_in(F, P, l); } PREP(32) { if (EN & 8) phase_s5_local(F, P, l); } PREP(33) { if (EN & 16) phase_hyena_filter_fft(F, P); } } }
        PH_END;
        if (PH_ON) { PREP(21) { if (EN & 32) phase_s5_carry(F, P, l); __syncthreads(); } PREP(7) { if (EN & 64) phase_hyena_main(F, P, l); } PREP(21) { if ((EN & 128) && l == 0) phase_hyena_ctx(F, P, l); } }
        PH_END;
        if (PH_ON) { PREP(3) { phase_s5_out(F, P, l); } PREP(21) { phase_hyena_transpose_out(F, P); }
            __syncthreads();
            { pg8::Gemm g{(const bf16_t*)(ws + WS_GL), (const bf16_t*)(ws + WS_W_G2) + (size_t)l * 512 * 256, MT, 512, 256}; pg8::StaticOrder S; S.init(MT, 512, F.G, F.bid);
              pg8::EpiBf16<0> E{(bf16_t*)(ws + WS_RWG), 512}; pg8::gemm_phase(F.lds, g, S, E, F.wave); }
            __syncthreads();
            PREP(2) { phase_rwkv_chunkA(F, P, l, 0); } }
        PH_END;
        if (PH_ON) { PREP(36) { phase_rwkv_chunkB(F, P, 0); }
            __syncthreads();
            pg8::Gemm g{(const bf16_t*)(ws + WS_YPRE), (const bf16_t*)(ws + WS_W_GLU) + (size_t)l * 256 * 256, MT, 256, 256}; pg8::StaticOrder S; S.init(MT, 256, F.G, (F.bid + 128) % F.G);
            pg8::EpiComb<4> E{(bf16_t*)(ws + WS_S5OUT), (const bf16_t*)(ws + WS_YPRE), 256, 0};
            pg8::gemm_phase(F.lds, g, S, E, F.wave); }
        PH_END;
        if (PH_ON) { if (PROBE == 25) phase_rwkv_chunkC(F, P, l, 0, true); phase_rwkv_chunkC(F, P, l, 0); }
        PH_END;
        if (PH_ON) { PREP(2) { phase_rwkv_chunkA(F, P, l, 1); } }
        PH_END;
        if (PH_ON) { PREP(36) { phase_rwkv_chunkB(F, P, 1); } PREP(29) { phase_h8(F, P, Mrows); } }
        PH_END;
        if (PH_ON) { if (PROBE == 25) phase_rwkv_chunkC(F, P, l, 1, true); phase_rwkv_chunkC(F, P, l, 1); }
        PH_END;
        if (PH_ON) {
            pg8::Gemm g{(const bf16_t*)(ws + WS_H8), (const bf16_t*)(ws + WS_W_GATE + (size_t)l * 3072 * 1024), Mrows, 3072, 512}; pg8::StaticOrder S; S.init(Mrows, 3072, F.G, F.bid);
            pg8::EpiSig8 E{(bf16_t*)(ws + WS_G), 3072, 1.f / 8192.f}; PREP(27) { pg8::gemm_phase<pg8::EpiSig8, pg8::StaticOrder, true>(F.lds, g, S, E, F.wave); }
        }
        PH_END;
        if (PH_ON) {
            const bf16_t* Wbr = (const bf16_t*)(ws + WS_W_BR + (size_t)l * 2 * MiB);
            const bf16_t* G3 = (const bf16_t*)(ws + WS_G); bf16_t* MB = (bf16_t*)(ws + WS_MB);
            pg8::StaticOrder S; S.init(Mrows, 1024, F.G, F.bid);
            PREP(26) {
            { pg8::Gemm g{(const bf16_t*)(ws + WS_S5OUT), Wbr, Mrows, 1024, 256}; pg8::EpiComb<0> E{MB, G3, 1024, 3072, 1}; pg8::gemm_phase(F.lds, g, S, E, F.wave); }
            block_self_sync();
            { pg8::Gemm g{(const bf16_t*)(ws + WS_RWOUT), Wbr + 1024 * 256, Mrows, 1024, 512}; pg8::EpiComb<1> E{MB, G3, 1024, 3072, 1 + 4}; pg8::gemm_phase(F.lds, g, S, E, F.wave); }
            block_self_sync();
            { pg8::Gemm g{(const bf16_t*)(ws + WS_HYOUT), Wbr + 1024 * 256 + 1024 * 512, Mrows, 1024, 256}; pg8::EpiComb<1> E{MB, G3, 1024, 3072, 1 + 8}; pg8::gemm_phase(F.lds, g, S, E, F.wave); }
            if (PROBE == 26 && _rep == 0) block_self_sync();
            }
        }
        PH_END;
        if (PH_ON) {
            pg8::Gemm g{(const bf16_t*)(ws + WS_MB), (const bf16_t*)(ws + WS_W_OUT) + (size_t)l * 1024 * 1024, Mrows, 1024, 1024}; pg8::StaticOrder S; S.init(Mrows, 1024, F.G, F.bid);
            pg8::EpiBf16<0> E{(bf16_t*)YF, 1024}; PREP(24) { if (GEN & 256) pg8::gemm_phase(F.lds, g, S, E, F.wave); }
        }
        PH_END;
        if (PH_ON) {
            if (l == 0) { if (PROBE == 22) { phase_resid_norm<1, false>(F, P, 0, 0, P.in(I_X), P.in(I_CTX), YF, 2, ng + 1024, (float*)(ws + WS_U), (float*)(ws + WS_U + 129 * MiB), ng + 2048, 3, nullptr, MT, nullptr); __syncthreads(); }
                          if (EN & 4096) phase_resid_norm<1, false>(F, P, 0, 0, P.in(I_X), P.in(I_CTX), YF, 2, ng + 1024, P.out(), CTXX, ng + 2048, 3, H, MT, nullptr, 0, 1); }
            else        { if (EN & 4096) phase_resid_norm<1, true>(F, P, 1, 1, P.out(), CTXX, YF, 2, ng + 1024, P.out(), CTXX, ng + 2048, 3, H, ML, P.in(I_MOER), 1, 2); }
        }
        PH_END;
        if (l == 0) {
            if (PH_ON) {
                pg8::Gemm g{H, (const bf16_t*)(ws + WS_W_FGU), MT, 2 * FFH, 1024}; pg8::StaticOrder S; S.init(MT, 2 * FFH, F.G, F.bid);
                pg8::EpiSwiGLU E{(bf16_t*)(ws + WS_ACT), FFH}; PREP(5) { if (GEN & 512) pg8::gemm_phase(F.lds, g, S, E, F.wave); }
            }
            PH_END;
            if (PH_ON) {
                pg8::Gemm g{(const bf16_t*)(ws + WS_ACT), (const bf16_t*)(ws + WS_W_FD), MT, 1024, FFH}; pg8::StaticOrder S; S.init(MT, 1024, F.G, F.bid);
                pg8::EpiBf16<0> E{(bf16_t*)YF, 1024}; PREP(24) { if (GEN & 1024) pg8::gemm_phase(F.lds, g, S, E, F.wave); }
            }
            PH_END;
            if (PH_ON) {
                if (EN & 4096) phase_resid_norm<1, false>(F, P, 0, 1, P.out(), CTXX, YF, 5, ng + 3072, P.out(), CTXX, P.in(I_NORMG) + (size_t)4 * 1024, 0, H, MT, nullptr, 1, 1);
            }
            PH_END;
        } else {
            unsigned char* Wgu = ws + WS_MOEW; unsigned char* Wd = Wgu + (size_t)8 * 2 * EXQ * 1024;
            if (PH_ON) { if (EN & 16384) phase_moe_gather(F, P); __syncthreads(); PREP(23) { if (EN & 32768) moe_convert_quarter(F, P, 0, 3); } }
            PH_END;
            if (PH_ON) {
                pg8::MoeOrder S; moe_pad_ends(P, S.pe); S.init(S.pe[7], 2 * EXQ, F.G, F.bid); S.estride = (size_t)2 * EXQ * 1024;
                pg8::Gemm g{(const bf16_t*)(ws + WS_XB), (const bf16_t*)Wgu, S.pe[7], 2 * EXQ, 512};
                pg8::EpiSwiGLU8 E{ws + WS_ACTQ, EXQ}; PREP(10) { if (GEN & 2048) pg8::gemm_phase<pg8::EpiSwiGLU8, pg8::MoeOrder, true>(F.lds, g, S, E, F.wave); }
            }
            PH_END;
            if (PH_ON) {
                pg8::MoeOrder S; moe_pad_ends(P, S.pe); S.init(S.pe[7], 1024, F.G, F.bid); S.estride = (size_t)1024 * EXQ;
                pg8::Gemm g{(const bf16_t*)(ws + WS_ACTQ), (const bf16_t*)Wd, S.pe[7], 1024, EXQ / 2};
                pg8::EpiF8Out E{ws + WS_YB, 1024, 1.f / 128.f}; PREP(28) { if (GEN & 4096) pg8::gemm_phase<pg8::EpiF8Out, pg8::MoeOrder, true>(F.lds, g, S, E, F.wave); }
            }
            PH_END;
            if (PH_ON) if (EN & 4096) phase_resid_norm<2, false>(F, P, 1, 1, P.out(), nullptr, nullptr, 5, ng + 3072, P.out(), nullptr, nullptr, 0, nullptr, ML, nullptr, 2, 0);
            PH_END;
        }
    }
#undef PH_ON
#undef PH_END
}

#undef ws
extern "C" void kernel_launch(void* const* d_in, const int* in_sizes, int n_in, void* d_out, int out_size, void* d_ws, size_t ws_size, hipStream_t stream) {
    static int grid = 0;
    if (grid == 0) {
        if (n_in != 49 || in_sizes[0] != ML * DM || out_size != ML * DM || ws_size < WS_END) {
            fprintf(stderr, "kernel_launch: unexpected problem: n_in %d in0 %d out %d ws %zu (need %zu); nothing launched\n", n_in, n_in > 0 ? in_sizes[0] : -1, out_size, ws_size, (size_t)WS_END); grid = -1; return; }
        int dev = 0, cus = 0, per_cu = 0;
        if (hipGetDevice(&dev) != hipSuccess || hipDeviceGetAttribute(&cus, hipDeviceAttributeMultiprocessorCount, dev) != hipSuccess) { grid = -1; return; }
        if (hipFuncSetAttribute((const void*)mega_fwd, hipFuncAttributeMaxDynamicSharedMemorySize, LDS_BYTES) != hipSuccess) { fprintf(stderr, "kernel_launch: hipFuncSetAttribute failed\n"); grid = -1; return; }
        if (hipOccupancyMaxActiveBlocksPerMultiprocessor(&per_cu, (const void*)mega_fwd, NTHR, LDS_BYTES) != hipSuccess || per_cu < 1) { fprintf(stderr, "kernel_launch: occupancy query reports %d\n", per_cu); }
        (void)hipGetLastError();
        grid = cus;
        if (grid > 256) grid = 256;
    }
    if (grid < 0) return;
    if (hipMemsetAsync((char*)d_ws + WS_CTL, 0, CTL_ZERO_BYTES, stream) != hipSuccess) return;
    Params p{};
    for (int i = 0; i < 49; ++i) p.in[i] = (const float*)d_in[i];
    p.out = (float*)d_out; p.ws = (unsigned char*)d_ws;
#if MK_PER_PHASE
    for (int k = 0; k < MAX_PHASES; ++k) { p.ph_lo = k; p.ph_hi = k + 1; hipLaunchKernelGGL(mega_fwd, dim3(grid), dim3(NTHR), LDS_BYTES, stream, p); }
#else
    p.ph_lo = 0; p.ph_hi = MAX_PHASES;
    hipLaunchKernelGGL(mega_fwd, dim3(grid), dim3(NTHR), LDS_BYTES, stream, p);
#endif
}
```

```cpp
#include <hip/hip_runtime.h>
#include <cstdio>
#include <cstdint>

#define LAS __attribute__((address_space(3)))
typedef unsigned short bf16_t;
typedef short bf16x8 __attribute__((ext_vector_type(8)));
typedef float f32x4 __attribute__((ext_vector_type(4)));
typedef float f32x2 __attribute__((ext_vector_type(2)));
typedef unsigned u32x4 __attribute__((ext_vector_type(4)));
typedef unsigned u32x2 __attribute__((ext_vector_type(2)));

__device__ __forceinline__ float bf2f(unsigned b) { return __uint_as_float(b << 16); }
__device__ __forceinline__ float bflo(unsigned w) { return __uint_as_float(w << 16); }
__device__ __forceinline__ float bfhi(unsigned w) { return __uint_as_float(w & 0xffff0000u); }
typedef __bf16 bf16v2_t __attribute__((ext_vector_type(2)));
__device__ __forceinline__ unsigned cvt_pk_bf16(float lo, float hi) { const f32x2 v = {lo, hi}; return __builtin_bit_cast(unsigned, __builtin_convertvector(v, bf16v2_t)); }
typedef int i32x8 __attribute__((ext_vector_type(8)));
typedef int i32x4 __attribute__((ext_vector_type(4)));
__device__ __forceinline__ float clamp8(float x) { return __builtin_amdgcn_fmed3f(x, -448.f, 448.f); }
__device__ __forceinline__ unsigned cvt4_fp8(float a, float b, float c, float d, float s) {
    int p = __builtin_amdgcn_cvt_pk_fp8_f32(clamp8(a * s), clamp8(b * s), 0, false); p = __builtin_amdgcn_cvt_pk_fp8_f32(clamp8(c * s), clamp8(d * s), p, true); return (unsigned)p; }
__device__ __forceinline__ i32x8 cat8(const bf16x8 lo, const bf16x8 hi) { const i32x4 a = __builtin_bit_cast(i32x4, lo), b = __builtin_bit_cast(i32x4, hi); return __builtin_shufflevector(a, b, 0, 1, 2, 3, 4, 5, 6, 7); }
__device__ __forceinline__ bf16_t f2bf(float f) { return (bf16_t)(cvt_pk_bf16(f, 0.f) & 0xffffu); }
__device__ __forceinline__ float sigmoidf_(float x) { return __builtin_amdgcn_rcpf(1.0f + __expf(-x)); }
__device__ __forceinline__ float tanhf_(float x) { const float e = __expf(2.0f * x); return 1.0f - 2.0f * __builtin_amdgcn_rcpf(e + 1.0f); }
__device__ __forceinline__ int fresh_lane() { int l; asm volatile("v_mbcnt_lo_u32_b32 %0, -1, 0\n\tv_mbcnt_hi_u32_b32 %0, -1, %0" : "=v"(l)); return l; }
template <int CTRL> __device__ __forceinline__ float dpp_f(float v) { return __int_as_float(__builtin_amdgcn_update_dpp(0, __float_as_int(v), CTRL, 0xf, 0xf, true)); }
__device__ __forceinline__ float red8(float v) { v += dpp_f<0xB1>(v); v += dpp_f<0x4E>(v); v += dpp_f<0x141>(v); return v; }
__device__ __forceinline__ float wave_sum(float v) {
    v = red8(v); v += dpp_f<0x140>(v);
    v += __int_as_float(__builtin_amdgcn_ds_swizzle(__float_as_int(v), 0x401F));
    return __int_as_float(__builtin_amdgcn_readlane(__float_as_int(v), 0)) + __int_as_float(__builtin_amdgcn_readlane(__float_as_int(v), 32));
}

__device__ __forceinline__ u32x4 pack8(const f32x4 v0, const f32x4 v1) { u32x4 w; w.x = cvt_pk_bf16(v0[0], v0[1]); w.y = cvt_pk_bf16(v0[2], v0[3]); w.z = cvt_pk_bf16(v1[0], v1[1]); w.w = cvt_pk_bf16(v1[2], v1[3]); return w; }
__device__ __forceinline__ void unpack8(const u32x4 w, f32x4& v0, f32x4& v1) { v0 = (f32x4){bflo(w.x), bfhi(w.x), bflo(w.y), bfhi(w.y)}; v1 = (f32x4){bflo(w.z), bfhi(w.z), bflo(w.w), bfhi(w.w)}; }
template <int ACT> __device__ __forceinline__ f32x4 act4(f32x4 v) {
    if (ACT == 1) { for (int j = 0; j < 4; ++j) v[j] = tanhf_(v[j]); }
    if (ACT == 2) { for (int j = 0; j < 4; ++j) v[j] = sigmoidf_(v[j]); }
    return v; }


namespace pg8 {
constexpr int BM = 256, BK = 64, HALF = 128, HTB = HALF * BK * 2, STAGE_BYTES = 8 * HTB, NXCD = 8, WGM = 8;
__host__ __device__ __forceinline__ int lds_byte(int r, int c) { const int st = (r >> 4) * 2 + (c >> 5), rr = r & 15, cc = c & 31, ob = rr * 64 + cc * 2; return st * 1024 + (ob ^ (((ob >> 9) & 1) << 5)); }
__host__ __device__ __forceinline__ void stage_rc(int b, int& R, int& C) { const int st = b / 1024, sb = b % 1024, swz = sb ^ (((sb >> 9) & 1) << 5); R = (st >> 1) * 16 + swz / 64; C = (st & 1) * 32 + (swz % 64) / 2; }
__host__ __device__ __forceinline__ int perm32(int rho) { const int n = rho >> 4, i = rho & 15; return 8 * (i >> 2) + 4 * n + (i & 3); }

struct Unit { int pm, pn; };
struct Gemm { const bf16_t* A; const bf16_t* Bt; int M, N, K; };

struct StaticOrder {
    int nM, nN, nwg, G, c;
    __device__ void init(int M, int N, int G_, int c_) { nM = M / BM; nN = N / BM; nwg = nM * nN; G = G_; c = c_; }
    __device__ bool next(int i, Unit& u) const {
        const long L = (long)i * G + c; if (L >= nwg) return false;
        int wgid = (int)L; { const int q = nwg / NXCD, r = nwg % NXCD, xcd = wgid % NXCD, off = wgid / NXCD; wgid = (xcd < r ? xcd * (q + 1) : r * (q + 1) + (xcd - r) * q) + off; }
        const int nig = WGM * nN, gid = wgid / nig, fm = gid * WGM, gsz = (nM - fm) < WGM ? (nM - fm) : WGM;
        u.pm = fm + ((wgid % nig) % gsz); u.pn = (wgid % nig) / gsz; return true;
    }
    __device__ __forceinline__ size_t boff(const Unit&) const { return 0; }
    __device__ __forceinline__ void a_ready(const Unit&) const {}
    __device__ __forceinline__ void done(const Unit&) const {}
};
struct MoeOrder : StaticOrder {
    int pe[8]; size_t estride;
    __device__ __forceinline__ size_t boff(const Unit& u) const { const int r = u.pm * BM; int e = 0;
#pragma unroll
        for (int j = 0; j < 8; ++j) e += (r >= pe[j]) ? 1 : 0;
        e = e > 7 ? 7 : e; return (size_t)e * estride; }
};

template <class Epi, class Sched, bool F8 = false, bool ALIGN_EPI = true, bool SP2 = true>
__device__ __forceinline__ void gemm_phase(LAS unsigned char* lds, const Gemm g, const Sched& S, const Epi& E, int wave_s) {
    const int wid = wave_s, lane = fresh_lane(), tid = wid * 64 + lane, wr = wid >> 2, wc = wid & 3, fr = lane & 15, fq = lane >> 4;
    const int K = g.K, nt = K / BK;
    unsigned voffA[2], voffB[2];
#pragma unroll
    for (int i = 0; i < 2; ++i) { int R, C; stage_rc(tid * 16 + i * 8192, R, C); const int Rb = Epi::PERM ? ((R & ~31) + perm32(R & 31)) : R;
        voffA[i] = (unsigned)(R * K + C) * 2u; voffB[i] = (unsigned)(Rb * K + C) * 2u; }
    const size_t kstep = (size_t)(BK * 2);
    const size_t hstep = (size_t)HALF * K * 2;
    const size_t tstep = 2 * hstep;
    const unsigned ldsw = (unsigned)wid * 1024u;
    const int aoff = lds_byte(wr * 64 + fr, fq * 8), boff = lds_byte(wc * 32 + fr, fq * 8);
#define PG8_SA(b, h) (((b) * 2 + (h)) * HTB)
#define PG8_SB(b, h) ((4 + (b) * 2 + (h)) * HTB)
#define PG8_STAGE(bufoff, gbase, voff) do { _Pragma("unroll") for (int _i = 0; _i < 2; ++_i) { unsigned _vo = (voff)[_i]; if constexpr (F8 || Epi::PERM) asm volatile("" : "+v"(_vo)); \
        __builtin_amdgcn_global_load_lds((const unsigned*)((const char*)(gbase) + _vo), (LAS unsigned*)(lds + (bufoff) + ldsw + _i * 8192), 16, 0, 0); } } while (0)
#define PG8_LDA(dst, b, h) do { _Pragma("unroll") for (int m = 0; m < 4; ++m) _Pragma("unroll") for (int k = 0; k < 2; ++k) dst[m][k] = *(const LAS bf16x8*)(lds + PG8_SA(b, h) + aoff + m * 2048 + k * 1024); } while (0)
#define PG8_LDB(dst, b, h) do { _Pragma("unroll") for (int n = 0; n < 2; ++n) _Pragma("unroll") for (int k = 0; k < 2; ++k) dst[n][k] = *(const LAS bf16x8*)(lds + PG8_SB(b, h) + boff + n * 2048 + k * 1024); } while (0)
#define PG8_MMA(ai, bj, At, Bt) do { __builtin_amdgcn_s_setprio(1); _Pragma("unroll") for (int m = 0; m < 4; ++m) _Pragma("unroll") for (int n = 0; n < 2; ++n) { \
        if constexpr (F8) { const i32x8 _b = cat8(Bt[n][0], Bt[n][1]), _a = cat8(At[m][0], At[m][1]); asm volatile("v_mfma_f32_16x16x128_f8f6f4 %0, %1, %2, %0" : "+v"(acc[ai][bj][m][n]) : "v"(_b), "v"(_a)); } \
        else { _Pragma("unroll") for (int k = 0; k < 2; ++k) acc[ai][bj][m][n] = __builtin_amdgcn_mfma_f32_16x16x32_bf16(Bt[n][k], At[m][k], acc[ai][bj][m][n], 0, 0, 0); } } __builtin_amdgcn_s_setprio(0); } while (0)
#define PG8_WAIT_V(n) asm volatile("s_waitcnt vmcnt(" #n ")" ::: "memory")
#define PG8_WAIT_L(n) asm volatile("s_waitcnt lgkmcnt(" #n ")" ::: "memory")
#define PG8_BAR __builtin_amdgcn_s_barrier()
#define PG8_SCHED __builtin_amdgcn_sched_barrier(0)
    Unit cur, nxt; int ui = 0;
    if (!S.next(0, cur)) return;
    f32x4 acc[2][2][4][2];
    float zf = 0.f; if constexpr (F8) asm volatile("" : "+v"(zf));
#pragma unroll
    for (int a = 0; a < 2; ++a)
#pragma unroll
        for (int b = 0; b < 2; ++b)
#pragma unroll
            for (int m = 0; m < 4; ++m)
#pragma unroll
                for (int n = 0; n < 2; ++n) acc[a][b][m][n] = (f32x4){zf, zf, zf, zf};
    bf16x8 At[4][2], B0[2][2], B1[2][2];
    const char* cA = (const char*)g.A + (size_t)cur.pm * tstep; const char* cB = (const char*)g.Bt + S.boff(cur) + (size_t)cur.pn * tstep;
    S.a_ready(cur);
    if constexpr (SP2) {
        PG8_STAGE(PG8_SB(0, 0), cB, voffB); PG8_STAGE(PG8_SB(0, 1), cB + hstep, voffB); PG8_STAGE(PG8_SA(0, 0), cA, voffA); PG8_STAGE(PG8_SA(0, 1), cA + hstep, voffA);
        if (wr == 1) PG8_BAR;
        PG8_WAIT_V(2); PG8_BAR;
        PG8_STAGE(PG8_SB(1, 0), cB + kstep, voffB); PG8_STAGE(PG8_SA(1, 0), cA + kstep, voffA); PG8_STAGE(PG8_SB(1, 1), cB + hstep + kstep, voffB);
        PG8_WAIT_V(6); PG8_BAR;
    } else {
        PG8_STAGE(PG8_SB(0, 0), cB, voffB); PG8_STAGE(PG8_SA(0, 0), cA, voffA); PG8_STAGE(PG8_SB(0, 1), cB + hstep, voffB); PG8_STAGE(PG8_SA(0, 1), cA + hstep, voffA);
        if (wr == 1) PG8_BAR;
        PG8_WAIT_V(4); PG8_BAR;
        PG8_STAGE(PG8_SB(1, 0), cB + kstep, voffB); PG8_STAGE(PG8_SA(1, 0), cA + kstep, voffA); PG8_STAGE(PG8_SB(1, 1), cB + hstep + kstep, voffB);
        PG8_WAIT_V(6); PG8_BAR;
    }
    for (;;) {
        const bool has_next = S.next(ui + 1, nxt);
        const char* nA = has_next ? (const char*)g.A + (size_t)nxt.pm * tstep : cA; const char* nB = has_next ? (const char*)g.Bt + S.boff(nxt) + (size_t)nxt.pn * tstep : cB;
        for (int t = 0; t < nt; t += 2) {
            const bool last = (t == nt - 2);
            const char* a1 = cA + (size_t)(t + 1) * kstep;
            const char* a2 = last ? nA : cA + (size_t)(t + 2) * kstep; const char* b2 = last ? nB : cB + (size_t)(t + 2) * kstep;
            const char* a3 = a2 + kstep; const char* b3 = b2 + kstep;
            if (last && has_next) S.a_ready(nxt);
            if constexpr (SP2) {
            PG8_LDB(B0, 0, 0); PG8_LDB(B1, 0, 1); PG8_SCHED; PG8_LDA(At, 0, 0); PG8_STAGE(PG8_SA(1, 1), a1 + hstep, voffA);
            PG8_WAIT_V(8); PG8_WAIT_L(0); PG8_BAR; PG8_MMA(0, 0, At, B0); PG8_MMA(0, 1, At, B1); PG8_BAR; PG8_SCHED;
            PG8_LDA(At, 0, 1); PG8_STAGE(PG8_SB(0, 0), b2, voffB); PG8_STAGE(PG8_SB(0, 1), b2 + hstep, voffB); PG8_STAGE(PG8_SA(0, 0), a2, voffA);
            PG8_WAIT_V(8); PG8_WAIT_L(0); PG8_BAR; PG8_MMA(1, 0, At, B0); PG8_MMA(1, 1, At, B1); PG8_BAR; PG8_SCHED;
            PG8_LDB(B0, 1, 0); PG8_LDB(B1, 1, 1); PG8_SCHED; PG8_LDA(At, 1, 0); PG8_STAGE(PG8_SA(0, 1), a2 + hstep, voffA);
            PG8_WAIT_V(8); PG8_WAIT_L(0); PG8_BAR; PG8_MMA(0, 0, At, B0); PG8_MMA(0, 1, At, B1); PG8_BAR; PG8_SCHED;
            PG8_LDA(At, 1, 1); PG8_STAGE(PG8_SB(1, 0), b3, voffB); PG8_STAGE(PG8_SB(1, 1), b3 + hstep, voffB); PG8_STAGE(PG8_SA(1, 0), a3, voffA);
            PG8_WAIT_V(8); PG8_WAIT_L(0); PG8_BAR; PG8_MMA(1, 0, At, B0); PG8_MMA(1, 1, At, B1); PG8_BAR; PG8_SCHED;
            } else {
            PG8_LDB(B0, 0, 0); PG8_SCHED; PG8_LDA(At, 0, 0); PG8_STAGE(PG8_SA(1, 1), a1 + hstep, voffA);
            PG8_WAIT_L(8); PG8_BAR; PG8_WAIT_L(0); PG8_MMA(0, 0, At, B0); PG8_BAR; PG8_SCHED;
            PG8_LDB(B1, 0, 1); PG8_STAGE(PG8_SB(0, 0), b2, voffB);
            PG8_BAR; PG8_WAIT_L(0); PG8_MMA(0, 1, At, B1); PG8_BAR;
            PG8_LDA(At, 0, 1); PG8_STAGE(PG8_SA(0, 0), a2, voffA);
            PG8_BAR; PG8_WAIT_L(0); PG8_MMA(1, 0, At, B0); PG8_BAR; PG8_SCHED;
            PG8_STAGE(PG8_SB(0, 1), b2 + hstep, voffB);
            PG8_WAIT_V(6); PG8_BAR; PG8_MMA(1, 1, At, B1); PG8_BAR;
            PG8_LDB(B0, 1, 0); PG8_SCHED; PG8_LDA(At, 1, 0); PG8_STAGE(PG8_SA(0, 1), a2 + hstep, voffA);
            PG8_WAIT_L(8); PG8_BAR; PG8_WAIT_L(0); PG8_MMA(0, 0, At, B0); PG8_BAR; PG8_SCHED;
            PG8_LDB(B1, 1, 1); PG8_STAGE(PG8_SB(1, 0), b3, voffB);
            PG8_BAR; PG8_WAIT_L(0); PG8_MMA(0, 1, At, B1); PG8_BAR;
            PG8_LDA(At, 1, 1); PG8_STAGE(PG8_SA(1, 0), a3, voffA);
            PG8_BAR; PG8_WAIT_L(0); PG8_MMA(1, 0, At, B0); PG8_BAR; PG8_SCHED;
            PG8_STAGE(PG8_SB(1, 1), b3 + hstep, voffB);
            PG8_WAIT_V(6); PG8_BAR; PG8_MMA(1, 1, At, B1); PG8_BAR;
            }
        }
        if constexpr (ALIGN_EPI) { if (wr == 0) PG8_BAR; }
        if constexpr (F8) asm volatile("s_nop 15\n\ts_nop 15" ::: "memory");
        { const int le = fresh_lane(); E(acc, cur, wr, wc, le & 15, le >> 4); }
        S.done(cur);
        if (!has_next) break;
#pragma unroll
        for (int a = 0; a < 2; ++a)
#pragma unroll
            for (int b = 0; b < 2; ++b)
#pragma unroll
                for (int m = 0; m < 4; ++m)
#pragma unroll
                    for (int n = 0; n < 2; ++n) acc[a][b][m][n] = (f32x4){zf, zf, zf, zf};
        cur = nxt; cA = nA; cB = nB; ++ui;
        if constexpr (ALIGN_EPI) { if (wr == 1) PG8_BAR; }
    }
    PG8_WAIT_V(0);
    if constexpr (!ALIGN_EPI) { if (wr == 0) PG8_BAR; }
    PG8_BAR;
#undef PG8_SA
#undef PG8_SB
#undef PG8_STAGE
#undef PG8_LDA
#undef PG8_LDB
#undef PG8_MMA
#undef PG8_WAIT_V
#undef PG8_WAIT_L
#undef PG8_BAR
#undef PG8_SCHED
}

struct EpiInProj {
    static constexpr bool PERM = true;
    bf16_t *U, *RKV, *HY, *LORA, *GL;
    __device__ __forceinline__ void operator()(const f32x4 (&acc)[2][2][4][2], const Unit& u, int wr, int wc, int fr, int fq) const {
        const int pn = u.pn; bf16_t* base; int ld, c0, a0 = 0; bool skip1 = false;
        if (pn == 0) { base = U; ld = 256; c0 = 0; }
        else if (pn <= 6) { base = RKV; ld = 1536; c0 = (pn - 1) * 256; }
        else if (pn <= 9) { base = HY; ld = 768; c0 = (pn - 7) * 256; }
        else if (pn == 10) { base = LORA; ld = 256; c0 = 0; a0 = 1; }
        else { base = GL; ld = 256; c0 = 0; a0 = 2; }
        const int row0 = u.pm * BM + wr * 64 + fr, col = c0 + wc * 32 + 8 * fq;
#pragma unroll
        for (int ai = 0; ai < 2; ++ai)
#pragma unroll
            for (int m = 0; m < 4; ++m) { bf16_t* rowp = base + (size_t)(row0 + ai * HALF + m * 16) * ld + col;
                { f32x4 v0 = acc[ai][0][m][0], v1 = acc[ai][0][m][1];
                  if (a0 == 1) { v0 = act4<1>(v0); v1 = act4<1>(v1); } else if (a0 == 2) { v0 = act4<2>(v0); v1 = act4<2>(v1); }
                  *(u32x4*)(rowp) = pack8(v0, v1); }
                if (!skip1) *(u32x4*)(rowp + HALF) = pack8(acc[ai][1][m][0], acc[ai][1][m][1]); }
    }
};
template <int ACT> struct EpiBf16 {
    static constexpr bool PERM = true;
    bf16_t* O; int ld;
    __device__ __forceinline__ void operator()(const f32x4 (&acc)[2][2][4][2], const Unit& u, int wr, int wc, int fr, int fq) const {
        const int row0 = u.pm * BM + wr * 64 + fr, col = u.pn * BM + wc * 32 + 8 * fq;
#pragma unroll
        for (int ai = 0; ai < 2; ++ai)
#pragma unroll
            for (int m = 0; m < 4; ++m) { bf16_t* rowp = O + (size_t)(row0 + ai * HALF + m * 16) * ld + col;
#pragma unroll
                for (int bj = 0; bj < 2; ++bj) *(u32x4*)(rowp + bj * HALF) = pack8(act4<ACT>(acc[ai][bj][m][0]), act4<ACT>(acc[ai][bj][m][1])); }
    }
};
template <int MODE> struct EpiComb {
    static constexpr bool PERM = true;
    bf16_t* O; const bf16_t* G; int ld; int ldg; int glin;
    bf16_t* OL; int olin;
    __device__ __forceinline__ void operator()(const f32x4 (&acc)[2][2][4][2], const Unit& u, int wr, int wc, int fr, int fq) const {
        const int row0 = u.pm * BM + wr * 64 + fr, col = u.pn * BM + wc * 32 + 8 * fq; const int lg = ldg ? ldg : ld;
        constexpr bool RG = (MODE == 0 || MODE == 1 || MODE == 4), RO = (MODE == 1 || MODE == 3);
#pragma unroll
        for (int ai = 0; ai < 2; ++ai) {
            u32x4 gv[4][2], ov[4][2];
#pragma unroll
            for (int m = 0; m < 4; ++m) { const size_t off = (size_t)(row0 + ai * HALF + m * 16) * ld + col, offg = (size_t)(row0 + ai * HALF + m * 16) * lg + col;
#pragma unroll
                for (int bj = 0; bj < 2; ++bj) {
                    if (RG) gv[m][bj] = glin ? ((const u32x4*)G)[((size_t)(u.pm * (lg / BM) + glin - 1 + u.pn) * 16 + ai * 8 + m * 2 + bj) * 512 + (wr * 4 + wc) * 64 + fq * 16 + fr] : *(const u32x4*)(G + offg + bj * HALF);
                    if (RO) ov[m][bj] = (olin & 1) ? ((const u32x4*)OL)[((size_t)(u.pm * (ld / BM) + u.pn) * 16 + ai * 8 + m * 2 + bj) * 512 + (wr * 4 + wc) * 64 + fq * 16 + fr] : *(const u32x4*)(O + off + bj * HALF); } }
#pragma unroll
            for (int m = 0; m < 4; ++m) { const size_t off = (size_t)(row0 + ai * HALF + m * 16) * ld + col;
#pragma unroll
                for (int bj = 0; bj < 2; ++bj) { f32x4 v0 = acc[ai][bj][m][0], v1 = acc[ai][bj][m][1];
                    if (RG) { f32x4 g0, g1; unpack8(gv[m][bj], g0, g1);
                        if (MODE == 4) { v0 = g0 * act4<2>(v0); v1 = g1 * act4<2>(v1); } else { v0 = v0 * g0; v1 = v1 * g1; } }
                    if (RO) { f32x4 o0, o1; unpack8(ov[m][bj], o0, o1); v0 = v0 + o0; v1 = v1 + o1; }
                    if (olin & 2) ((u32x4*)OL)[((size_t)(u.pm * (ld / BM) + u.pn) * 16 + ai * 8 + m * 2 + bj) * 512 + (wr * 4 + wc) * 64 + fq * 16 + fr] = pack8(v0, v1);
                    else *(u32x4*)(O + off + bj * HALF) = pack8(v0, v1); } }
            asm volatile("" ::: "memory"); }
    }
};
struct EpiF32 {
    static constexpr bool PERM = false;
    float* C; int ldc;
    __device__ __forceinline__ void operator()(const f32x4 (&acc)[2][2][4][2], const Unit& u, int wr, int wc, int fr, int fq) const {
        const int row0 = u.pm * BM + wr * 64 + fr, col0 = u.pn * BM + wc * 32 + 4 * fq;
#pragma unroll
        for (int ai = 0; ai < 2; ++ai)
#pragma unroll
            for (int m = 0; m < 4; ++m) { float* rowp = C + (size_t)(row0 + ai * HALF + m * 16) * ldc + col0;
#pragma unroll
                for (int bj = 0; bj < 2; ++bj)
#pragma unroll
                    for (int n = 0; n < 2; ++n) *(f32x4*)(rowp + bj * HALF + n * 16) = acc[ai][bj][m][n]; }
    }
};
struct EpiSwiGLU {
    static constexpr bool PERM = true;
    bf16_t* O; int ld;
    __device__ __forceinline__ void operator()(const f32x4 (&acc)[2][2][4][2], const Unit& u, int wr, int wc, int fr, int fq) const {
        const int row0 = u.pm * BM + wr * 64 + fr, col = u.pn * HALF + wc * 32 + 8 * fq;
#pragma unroll
        for (int ai = 0; ai < 2; ++ai)
#pragma unroll
            for (int m = 0; m < 4; ++m) { f32x4 v[2];
#pragma unroll
                for (int n = 0; n < 2; ++n) { const f32x4 gt = acc[ai][0][m][n], up = acc[ai][1][m][n];
#pragma unroll
                    for (int j = 0; j < 4; ++j) v[n][j] = gt[j] * sigmoidf_(gt[j]) * up[j]; }
                *(u32x4*)(O + (size_t)(row0 + ai * HALF + m * 16) * ld + col) = pack8(v[0], v[1]); }
    }
};
struct EpiSig8 {
    static constexpr bool PERM = true;
    bf16_t* O; int ld; float s;
    __device__ __forceinline__ void operator()(const f32x4 (&acc)[2][2][4][2], const Unit& u, int wr, int wc, int fr, int fq) const {
        const int tid = (wr * 4 + wc) * 64 + fq * 16 + fr; u32x4* Ot = (u32x4*)O + (size_t)(u.pm * (ld / BM) + u.pn) * 16 * 512 + tid;
#pragma unroll
        for (int ai = 0; ai < 2; ++ai)
#pragma unroll
            for (int m = 0; m < 4; ++m)
#pragma unroll
                for (int bj = 0; bj < 2; ++bj) Ot[(ai * 8 + m * 2 + bj) * 512] = pack8(act4<2>(acc[ai][bj][m][0] * s), act4<2>(acc[ai][bj][m][1] * s));
    }
};
struct EpiF8Out {
    static constexpr bool PERM = true;
    unsigned char* O; int ld; float s;
    __device__ __forceinline__ void operator()(const f32x4 (&acc)[2][2][4][2], const Unit& u, int wr, int wc, int fr, int fq) const {
        const int row0 = u.pm * BM + wr * 64 + fr, col = u.pn * BM + wc * 32 + 8 * fq;
#pragma unroll
        for (int ai = 0; ai < 2; ++ai)
#pragma unroll
            for (int m = 0; m < 4; ++m) { unsigned char* rowp = O + (size_t)(row0 + ai * HALF + m * 16) * ld + col;
#pragma unroll
                for (int bj = 0; bj < 2; ++bj) { const f32x4 v0 = acc[ai][bj][m][0], v1 = acc[ai][bj][m][1]; u32x2 w;
                    w.x = cvt4_fp8(v0[0], v0[1], v0[2], v0[3], s); w.y = cvt4_fp8(v1[0], v1[1], v1[2], v1[3], s); *(u32x2*)(rowp + bj * HALF) = w; } }
    }
};
struct EpiSwiGLU8 {
    static constexpr bool PERM = true;
    unsigned char* O; int ld;
    __device__ __forceinline__ void operator()(const f32x4 (&acc)[2][2][4][2], const Unit& u, int wr, int wc, int fr, int fq) const {
        const int row0 = u.pm * BM + wr * 64 + fr, col = u.pn * HALF + wc * 32 + 8 * fq;
#pragma unroll
        for (int ai = 0; ai < 2; ++ai)
#pragma unroll
            for (int m = 0; m < 4; ++m) { f32x4 v[2];
#pragma unroll
                for (int n = 0; n < 2; ++n) { const f32x4 gt = acc[ai][0][m][n], up = acc[ai][1][m][n];
#pragma unroll
                    for (int j = 0; j < 4; ++j) { const float gj = gt[j] * (1.f / 8192.f); v[n][j] = gj * sigmoidf_(gj) * up[j]; } }
                u32x2 w; w.x = cvt4_fp8(v[0][0], v[0][1], v[0][2], v[0][3], 1.f / 1024.f); w.y = cvt4_fp8(v[1][0], v[1][1], v[1][2], v[1][3], 1.f / 1024.f);
                *(u32x2*)(O + (size_t)(row0 + ai * HALF + m * 16) * ld + col) = w; }
    }
};
}

constexpr int DM = 1024, NBATCH = 8, SEQL = 4096, CTXL = 256, NLAYER = 2;
constexpr int ML = NBATCH * SEQL, MC = NBATCH * CTXL, MT = ML + MC;
constexpr int IN_COLS = 6016, INP_N = 3072;
constexpr int FFH = 2816, EXH = 3584, NEXP = 8, EXQ = 3584;
constexpr int MOE_CAP = 2 * ML + NEXP * 256;
constexpr int NCHAIN = 68;
constexpr int NWAVES = 8, NTHR = 512;

constexpr size_t KiB = 1024, MiB = 1u << 20;
constexpr size_t WS_CTL = 0, CTL_ZERO_BYTES = 128 * KiB;
constexpr size_t WS_MODV = 256 * KiB;
constexpr size_t WS_S5TAB = 768 * KiB;
constexpr size_t WS_MOEMETA = 1408 * KiB;
constexpr size_t WS_HFILTC = 2304 * KiB;
constexpr size_t WS_W_LORA = 3328 * KiB;
constexpr size_t WS_W_IN = 4 * MiB;
constexpr size_t WS_W_GATE = 16 * MiB;
constexpr size_t WS_W_BR = 28 * MiB;
constexpr size_t WS_W_OUT = 32 * MiB;
constexpr size_t WS_W_GLU = 36 * MiB;
constexpr size_t WS_W_G2 = 36 * MiB + 256 * KiB;
constexpr size_t WS_W_FGU = 37 * MiB;
constexpr size_t WS_W_FD = 48 * MiB;
constexpr size_t WS_S5TAB2 = 53 * MiB + 512 * KiB;
constexpr size_t WS_H = 54 * MiB;
constexpr size_t WS_U = 122 * MiB;
constexpr size_t WS_RKV = 139 * MiB;
constexpr size_t WS_LORA = 241 * MiB;
constexpr size_t WS_GL = 258 * MiB;
constexpr size_t WS_HY = 275 * MiB;
constexpr size_t WS_HYT = 326 * MiB;
constexpr size_t WS_HFILT = 374 * MiB;
constexpr size_t WS_KSPEC = 390 * MiB;
constexpr size_t WS_E = 422 * MiB;
constexpr size_t WS_CIN = 430 * MiB + 512 * KiB;
constexpr size_t WS_YPRE = 439 * MiB;
constexpr size_t WS_S5OUT = 456 * MiB;
constexpr size_t WS_HYOT = 473 * MiB;
constexpr size_t WS_HYOUT = 489 * MiB;
constexpr size_t WS_RWOUT = 506 * MiB;
constexpr size_t WS_CBON = 540 * MiB;
constexpr size_t WS_CTXX = 542 * MiB + 256 * KiB;
constexpr size_t WS_YD = 550 * MiB + 256 * KiB;
constexpr size_t WS_END = 619 * MiB;
constexpr size_t WS_XS_A = 4 * MiB, WS_XS_B = 601 * MiB; constexpr int XS_ROWS_A = 25600;
constexpr size_t WS_H8 = 413 * MiB;
constexpr size_t WS_RWG = WS_RWOUT;
constexpr size_t WS_RA = WS_HY;
constexpr size_t WS_SC = WS_RA + 104 * MiB;
constexpr size_t RA_UNIT = 24832;
constexpr size_t WS_G = WS_U;
constexpr size_t WS_MB = WS_HYT;
constexpr size_t WS_YF = WS_HYT + 68 * MiB;
constexpr size_t WS_ACT = WS_U;
constexpr size_t WS_XB = 88 * MiB;
constexpr size_t WS_ACTQ = 154 * MiB;
constexpr size_t WS_YB = 385 * MiB;
constexpr size_t WS_MOEW = 517 * MiB;
static_assert(WS_W_FD + (size_t)1024 * FFH * 2 <= WS_H, "W");
static_assert(WS_RA + (size_t)4 * 8 * 2 * NCHAIN * RA_UNIT <= WS_SC && WS_SC + (size_t)4 * 8 * 2 * NCHAIN * 8192 <= WS_E, "RA");
static_assert(WS_G + (size_t)MT * 3072 * 2 <= WS_HYT && WS_MB + (size_t)MT * 1024 * 2 <= WS_YF, "G/MB");
static_assert(WS_YF + (size_t)MT * 1024 * 2 <= WS_HYOT, "YF");
static_assert(WS_ACT + (size_t)MT * FFH * 2 <= WS_HYT, "ACT");
static_assert((size_t)ML * 1024 + WS_H <= WS_XB && WS_XB + (size_t)MOE_CAP * 1024 <= WS_ACTQ && WS_ACTQ + (size_t)MOE_CAP * EXQ <= WS_YB && WS_YB + (size_t)MOE_CAP * 1024 * 2 <= WS_MOEW, "MoE buffers");
static_assert(WS_MOEW + (size_t)8 * 7168 * 1024 + (size_t)8 * 1024 * 3584 <= WS_END, "MOEW");
static_assert(WS_YD + (size_t)2 * MT * 512 * 2 <= WS_END, "YD");
static_assert(WS_SC + (size_t)4 * 8 * 2 * NCHAIN * 8192 <= WS_H8 && WS_H8 + (size_t)MT * 1024 <= WS_S5OUT, "H8");
constexpr int CW_BAR = 4096;
constexpr int CW_MOECNT = 16384;

constexpr int LDS_BYTES = 147456;
constexpr int LDS_XB = LDS_BYTES - 16;

#define XB_TMO      128
#define XB_XCNT(j)  (256  + 64 * (j))
#define XB_XSUB(j)  (1280 + 64 * (j))
#define XB_XGEN(j)  (2304 + 64 * (j))
#define XB_TOP      3328
#define XB_TOPGEN   3392
#define XCD_BAR_WORDS 3456
#define XB_SPIN_CAP (1u << 18)

__device__ __forceinline__ unsigned xb_ld(unsigned* p)              { return __hip_atomic_load(p, __ATOMIC_RELAXED, __HIP_MEMORY_SCOPE_AGENT); }
__device__ __forceinline__ unsigned xb_add(unsigned* p, unsigned v) { return __hip_atomic_fetch_add(p, v, __ATOMIC_RELAXED, __HIP_MEMORY_SCOPE_AGENT); }
__device__ __forceinline__ unsigned xb_xcc_id() { return (unsigned)__builtin_amdgcn_s_getreg((3 << 11) | 20) & 0xFu; }
#define XB_SPIN(cond, bar) do { unsigned _sp = 0; while (cond) { __builtin_amdgcn_s_sleep(1); \
    if ((++_sp & 255u) == 0u) { if (xb_ld(&(bar)[XB_TMO])) break; if (_sp > XB_SPIN_CAP) { atomicAdd(&(bar)[XB_TMO], 1u); break; } } } } while (0)

struct XcdBarrier { unsigned* bar; unsigned x; volatile LAS unsigned* st; };

__device__ __forceinline__ XcdBarrier xcd_barrier_post(unsigned* bar, volatile LAS unsigned* st, int wave_s) {
    XcdBarrier b; b.bar = bar; b.x = xb_xcc_id(); b.st = st;
    if (wave_s == 0 && fresh_lane() == 0) (void)xb_add(&bar[XB_XCNT(b.x)], 1u);
    return b;
}
__device__ __forceinline__ void xcd_barrier_complete(unsigned* bar, unsigned x, unsigned& nloc, unsigned& nx) {
    const unsigned G = gridDim.x * gridDim.y * gridDim.z;
    unsigned sum, cnt, mine, sp = 0u;
    for (;;) {
        sum = 0u; cnt = 0u; mine = 0u;
#pragma unroll
        for (unsigned j = 0; j < 16; ++j) { const unsigned c = xb_ld(&bar[XB_XCNT(j)]); sum += c; cnt += (c > 0u) ? 1u : 0u; mine = (j == x) ? c : mine; }
        if (sum == G) break;
        __builtin_amdgcn_s_sleep(1);
        if ((++sp & 255u) == 0u) { if (xb_ld(&bar[XB_TMO])) break; if (sp > XB_SPIN_CAP) { atomicAdd(&bar[XB_TMO], 1u); break; } }
    }
    nloc = mine > 0u ? mine : 1u; nx = cnt > 0u ? cnt : 1u;
}
__device__ __forceinline__ void xcd_barrier(const XcdBarrier& b, int wave_s, unsigned* bar) {
    asm volatile("s_waitcnt vmcnt(0)" ::: "memory");
    __syncthreads();
    if (wave_s == 0 && fresh_lane() == 0) {
        __builtin_amdgcn_s_waitcnt(0);
        unsigned nloc = b.st[0], nx = b.st[1];
        if (nloc == 0u) { xcd_barrier_complete(bar, b.x, nloc, nx); b.st[0] = nloc; b.st[1] = nx; }
        const unsigned old = xb_add(&bar[XB_XSUB(b.x)], 1u);
        const unsigned gen = old / nloc;
        if (old + 1u == (gen + 1u) * nloc) {
            __builtin_amdgcn_fence(__ATOMIC_RELEASE, "agent");
            asm volatile("s_waitcnt vmcnt(0)" ::: "memory");
            const unsigned og = xb_add(&bar[XB_TOP], 1u);
            const unsigned tg = og / nx;
            if (og + 1u == (tg + 1u) * nx) xb_add(&bar[XB_TOPGEN], 1u);
            else XB_SPIN(xb_ld(&bar[XB_TOPGEN]) == tg, bar);
            __builtin_amdgcn_fence(__ATOMIC_ACQUIRE, "agent");
            xb_add(&bar[XB_XGEN(b.x)], 1u);
            asm volatile("s_waitcnt vmcnt(0)" ::: "memory");
        } else {
            XB_SPIN(xb_ld(&bar[XB_XGEN(b.x)]) == gen, bar);
            __builtin_amdgcn_fence(__ATOMIC_ACQUIRE, "agent");
            asm volatile("s_waitcnt vmcnt(0)" ::: "memory");
        }
    }
    __syncthreads();
}
__device__ __forceinline__ void block_self_sync() {
    asm volatile("s_waitcnt vmcnt(0)" ::: "memory");
    __syncthreads();
    __builtin_amdgcn_fence(__ATOMIC_ACQUIRE, "agent");
    asm volatile("s_waitcnt vmcnt(0)" ::: "memory");
    __syncthreads();
}

struct Params { const float* in[49]; float* out; unsigned char* ws; int ph_lo, ph_hi; };
#define CAS __attribute__((address_space(4)))
struct KA { const CAS unsigned char* p;
    __device__ __forceinline__ const float* in(int i) const { return *(const float* const CAS*)(p + 8 * i); }
    __device__ __forceinline__ float* out() const { return *(float* const CAS*)(p + 8 * 49); }
    __device__ __forceinline__ unsigned char* ws() const { return *(unsigned char* const CAS*)(p + 8 * 50); }
    __device__ __forceinline__ int ph_lo() const { return *(const int CAS*)(p + 8 * 51); }
    __device__ __forceinline__ int ph_hi() const { return *(const int CAS*)(p + 8 * 51 + 4); } };
static_assert(sizeof(Params) == 8 * 51 + 8, "Params layout");
enum { I_X = 0, I_C, I_CTX, I_CCTX, I_MODW, I_MODB, I_NORMG, I_INW, I_S5LRE, I_S5LIM, I_S5STEP, I_S5BRE, I_S5BIM, I_S5CRE, I_S5CIM, I_S5D, I_S5GLU,
       I_RWCONV, I_RWW0, I_RWW2, I_RWA0, I_RWA2, I_RWG2, I_RWKK, I_RWKA, I_RWRK, I_RWLNW, I_RWLNB, I_HYCONVW, I_HYCONVB, I_HYFW1, I_HYFB1, I_HYFF1, I_HYFW2, I_HYFB2, I_HYFF2,
       I_HYFW3, I_HYBIAS, I_BRS5, I_BRRW, I_BRHY, I_OUTW, I_FFNWG, I_FFNWU, I_FFNWD, I_MOER, I_MOEWG, I_MOEWU, I_MOEWD };

struct Frame { LAS unsigned char* lds; int tid, lane, wave, bid, G, gw, NGW; };
#define LDS_WAIT() asm volatile("s_waitcnt lgkmcnt(0)" ::: "memory")

__device__ __forceinline__ void wt_item(const float* W, int ldn, int k0, int n0, bf16_t* dst, int ldd, LAS float* scr, int lane) {
    { float tv[32];
#pragma unroll
      for (int i = 0; i < 32; ++i) tv[i] = W[(size_t)(k0 + 2 * i + (lane >> 5)) * ldn + n0 + (lane & 31)];
#pragma unroll
      for (int i = 0; i < 32; ++i) scr[(2 * i + (lane >> 5)) * 33 + (lane & 31)] = tv[i]; }
    LDS_WAIT();
    const int c = lane & 7;
#pragma unroll
    for (int j = 0; j < 4; ++j) { const int n = (lane >> 3) + 8 * j; const LAS float* s = scr + (8 * c) * 33 + n;
        u32x4 o; o.x = cvt_pk_bf16(s[0 * 33], s[1 * 33]); o.y = cvt_pk_bf16(s[2 * 33], s[3 * 33]); o.z = cvt_pk_bf16(s[4 * 33], s[5 * 33]); o.w = cvt_pk_bf16(s[6 * 33], s[7 * 33]);
        *(u32x4*)(dst + (size_t)n * ldd + 8 * c) = o; }
    LDS_WAIT();
}
__device__ __forceinline__ void wt_job(int r, const float* W, int ldn, int nbc, int nbeg, bf16_t* D, int ldd, int drow0, int il, int krow0, LAS float* scr, int lane) {
    const int kb = r / nbc, nb = r % nbc, rel = 32 * nb;
    const int drow = drow0 + (il ? 256 * (rel / 128) + (rel % 128) : rel);
    wt_item(W + (size_t)krow0 * ldn, ldn, 64 * kb, nbeg + rel, D + (size_t)drow * ldd + 64 * kb, ldd, scr, lane);
}

__device__ __forceinline__ void wt_item8(const float* W, int ldn, int k0, int n0, unsigned char* dst, int ldd, LAS float* scr, int lane) {
    { float tv[32];
#pragma unroll
      for (int i = 0; i < 32; ++i) tv[i] = W[(size_t)(k0 + 2 * i + (lane >> 5)) * ldn + n0 + (lane & 31)];
#pragma unroll
      for (int i = 0; i < 32; ++i) scr[(2 * i + (lane >> 5)) * 33 + (lane & 31)] = tv[i]; }
    LDS_WAIT();
    const int c = lane & 7;
#pragma unroll
    for (int j = 0; j < 4; ++j) { const int n = (lane >> 3) + 8 * j; const LAS float* s = scr + (8 * c) * 33 + n;
        u32x2 o; o.x = cvt4_fp8(s[0 * 33], s[1 * 33], s[2 * 33], s[3 * 33], 512.f); o.y = cvt4_fp8(s[4 * 33], s[5 * 33], s[6 * 33], s[7 * 33], 512.f);
        *(u32x2*)(dst + (size_t)n * ldd + 8 * c) = o; }
    LDS_WAIT();
}
__device__ __forceinline__ void wt_job8(int r, const float* W, int ldn, int nbc, int nbeg, unsigned char* D, int ldd, int drow0, int il, int krow0, LAS float* scr, int lane) {
    const int kb = r / nbc, nb = r % nbc, rel = 32 * nb;
    const int drow = drow0 + (il ? 256 * (rel / 128) + (rel % 128) : rel);
    wt_item8(W + (size_t)krow0 * ldn, ldn, 64 * kb, nbeg + rel, D + (size_t)drow * ldd + 64 * kb, ldd, scr, lane);
}

__device__ __forceinline__ void p0_prologue(const Frame& F, const KA& P) {
    unsigned char* ws = P.ws();
    {
        LAS float* sc = (LAS float*)F.lds;
        LAS float* part = (LAS float*)(F.lds + 40960);
        for (int i = F.tid; i < 9 * 1024; i += NTHR) { const float v = (i < 8192) ? P.in(I_C)[i] : P.in(I_CCTX)[i - 8192]; sc[i] = v * sigmoidf_(v); }
        __syncthreads();
        const int colbase = F.bid * 48;
        if (F.tid < 384 && colbase < 12288) {
            const int c4 = F.tid % 12, kq = F.tid / 12, col = colbase + 4 * c4, l = col / 6144, j = col % 6144;
            const f32x4* W = (const f32x4*)(P.in(I_MODW) + (size_t)l * 1024 * 6144 + j);
            f32x4 a[9];
#pragma unroll
            for (int r = 0; r < 9; ++r) a[r] = (f32x4){0.f, 0.f, 0.f, 0.f};
#pragma unroll 1
            for (int half = 0; half < 4; ++half) {
                f32x4 wv[8]; const f32x4* Wh = W + (size_t)(kq + 256 * half) * 1536;
#pragma unroll
                for (int u = 0; u < 8; ++u) wv[u] = Wh[(size_t)(32 * u) * 1536];
#pragma unroll
                for (int u = 0; u < 8; ++u) { const int k = kq + 32 * (8 * half + u);
#pragma unroll
                    for (int r = 0; r < 9; ++r) a[r] += wv[u] * sc[r * 1024 + k]; }
            }
#pragma unroll
            for (int r = 0; r < 9; ++r) *(LAS f32x4*)(part + (kq * 9 + r) * 48 + 4 * c4) = a[r];
        }
        __syncthreads();
        if (F.tid < 432 && colbase < 12288) { const int r = F.tid / 48, cl = F.tid % 48, col = colbase + cl, l = col / 6144, j = col % 6144; float s = P.in(I_MODB)[l * 6144 + j];
#pragma unroll 8
            for (int kq = 0; kq < 32; ++kq) s += part[(kq * 9 + r) * 48 + cl];
            ((float*)(ws + WS_MODV))[((size_t)l * 9 + r) * 6144 + j] = s; }
        __syncthreads();
    }
    if (F.gw < 64) {
        const int ldg = F.gw, p = F.lane;
        const float lr = P.in(I_S5LRE)[ldg * 64 + p], li = P.in(I_S5LIM)[ldg * 64 + p], step = expf(P.in(I_S5STEP)[ldg]);
        const float mag = expf(lr * step), ang = li * step, ar = mag * cosf(ang), ai = mag * sinf(ang);
        const float den = lr * lr + li * li, nr = ar - 1.0f, ni = ai;
        const float qr = (nr * lr + ni * li) / den, qi = (ni * lr - nr * li) / den;
        float* T = (float*)(ws + WS_S5TAB) + (size_t)ldg * 2304;
        T[p] = ar; T[64 + p] = ai;
        float pr = ar, pi = ai;
#pragma unroll
        for (int s = 0; s < 6; ++s) { const float t = pr * pr - pi * pi; pi = 2.f * pr * pi; pr = t; }
        T[128 + p] = pr; T[192 + p] = pi;
        const float* br = P.in(I_S5BRE) + ((size_t)ldg * 64 + p) * 16; const float* bi = P.in(I_S5BIM) + ((size_t)ldg * 64 + p) * 16;
#pragma unroll
        for (int i = 0; i < 16; ++i) { T[256 + p * 16 + i] = qr * br[i] - qi * bi[i]; T[1280 + p * 16 + i] = qr * bi[i] + qi * br[i]; }
        bf16_t* T2 = (bf16_t*)(ws + WS_S5TAB2) + (size_t)ldg * 4096;
        const float* cre = P.in(I_S5CRE) + (size_t)ldg * 1024; const float* cim = P.in(I_S5CIM) + (size_t)ldg * 1024;
#pragma unroll
        for (int i = 0; i < 16; ++i) { T2[p * 16 + i] = f2bf(qr * br[i] - qi * bi[i]); T2[(64 + p) * 16 + i] = f2bf(qr * bi[i] + qi * br[i]);
            T2[2048 + i * 128 + 2 * p] = f2bf(cre[i * 64 + p]); T2[2048 + i * 128 + 2 * p + 1] = f2bf(-cim[i * 64 + p]); }
    }
    LAS float* scr = (LAS float*)(F.lds + F.wave * 16384);
    constexpr int PER_LAYER = 896 + 384 + 192 + 1536 + 128 + 256 + 128 + 512 + 32 + 32 + 64;
    constexpr int NITEMS = 2 * PER_LAYER + 3 * 1408;
    for (int it = F.gw; it < NITEMS; it += F.NGW) {
        int r = it;
        if (r < 2 * PER_LAYER) {
            const int l = r / PER_LAYER; r -= l * PER_LAYER;
            const float* inw = P.in(I_INW) + (size_t)l * 1024 * IN_COLS;
            bf16_t* Win = (bf16_t*)(ws + WS_W_IN) + (size_t)l * INP_N * 1024; unsigned char* Wg = ws + WS_W_GATE + (size_t)l * 3072 * 1024;
            bf16_t* Wbr = (bf16_t*)(ws + WS_W_BR + (size_t)l * 2 * MiB);
            if (r < 896) { wt_job(r, inw, IN_COLS, 56, 0, Win, 1024, 0, 0, 0, scr, F.lane); continue; } r -= 896;
            if (r < 384) { wt_job(r, inw, IN_COLS, 24, 2176, Win, 1024, 1792, 0, 0, scr, F.lane); continue; } r -= 384;
            if (r < 192) { wt_job(r, inw, IN_COLS, 12, 1792, Win, 1024, 2560, 0, 0, scr, F.lane); continue; } r -= 192;
            if (r < 1536) { wt_job8(r, inw, IN_COLS, 96, 2944, Wg, 1024, 0, 0, 0, scr, F.lane); continue; } r -= 1536;
            if (r < 128) { wt_job(r, P.in(I_BRS5) + (size_t)l * 256 * 1024, 1024, 32, 0, Wbr, 256, 0, 0, 0, scr, F.lane); continue; } r -= 128;
            if (r < 256) { wt_job(r, P.in(I_BRRW) + (size_t)l * 512 * 1024, 1024, 32, 0, Wbr + 1024 * 256, 512, 0, 0, 0, scr, F.lane); continue; } r -= 256;
            if (r < 128) { wt_job(r, P.in(I_BRHY) + (size_t)l * 256 * 1024, 1024, 32, 0, Wbr + 1024 * 256 + 1024 * 512, 256, 0, 0, 0, scr, F.lane); continue; } r -= 128;
            if (r < 512) { wt_job(r, P.in(I_OUTW) + (size_t)l * 1024 * 1024, 1024, 32, 0, (bf16_t*)(ws + WS_W_OUT) + (size_t)l * 1024 * 1024, 1024, 0, 0, 0, scr, F.lane); continue; } r -= 512;
            if (r < 32) { wt_job(r, P.in(I_S5GLU) + (size_t)l * 256 * 256, 256, 8, 0, (bf16_t*)(ws + WS_W_GLU) + (size_t)l * 256 * 256, 256, 0, 0, 0, scr, F.lane); continue; } r -= 32;
            if (r >= 32) { r -= 32;
                const int dd = r >> 5, which = (r >> 4) & 1, it2 = r & 15;
                wt_job(it2, (which ? P.in(I_RWA2) : P.in(I_RWW2)) + (size_t)(l * 2 + dd) * 64 * 512, 512, 16, 0, (bf16_t*)(ws + WS_W_LORA) + (size_t)((l * 2 + dd) * 2 + which) * 512 * 64, 64, 0, 0, 0, scr, F.lane);
                continue; }
            { bf16_t* G2 = (bf16_t*)(ws + WS_W_G2) + (size_t)l * 512 * 256;
              wt_job(r, P.in(I_RWG2) + (size_t)l * 128 * 512, 512, 16, 0, G2, 256, 0, 0, 0, scr, F.lane);
              const int nb = r % 16, kb = r / 16;
              for (int i = F.lane; i < 32 * 8; i += 64) *(u32x4*)(G2 + (size_t)(32 * nb + (i >> 3)) * 256 + 128 + 64 * kb + (i & 7) * 8) = (u32x4){0u, 0u, 0u, 0u}; }
            continue;
        }
        r -= 2 * PER_LAYER;
        if (r < 1408) { wt_job(r, P.in(I_FFNWG), FFH, 88, 0, (bf16_t*)(ws + WS_W_FGU), 1024, 0, 1, 0, scr, F.lane); continue; } r -= 1408;
        if (r < 1408) { wt_job(r, P.in(I_FFNWU), FFH, 88, 0, (bf16_t*)(ws + WS_W_FGU), 1024, 128, 1, 0, scr, F.lane); continue; } r -= 1408;
        wt_job(r, P.in(I_FFNWD), 1024, 32, 0, (bf16_t*)(ws + WS_W_FD), FFH, 0, 0, 0, scr, F.lane);
    }
}
__device__ __forceinline__ void moe_convert_quarter(const Frame& F, const KA& P, int q, int which) {
    LAS float* scr = (LAS float*)(F.lds + F.wave * 16384);
    unsigned char* Wgu = P.ws() + WS_MOEW; unsigned char* Wd = Wgu + (size_t)8 * 2 * EXQ * 1024;
    constexpr int NGU = (EXQ / 32) * 16, ND = 32 * (EXQ / 64);
#pragma unroll 1
    for (int it = F.gw; it < 8 * (2 * NGU + ND); it += F.NGW) {
        const int e = it / (2 * NGU + ND); int r = it % (2 * NGU + ND);
        const float* wg = P.in(I_MOEWG) + (size_t)e * 1024 * EXH; const float* wu = P.in(I_MOEWU) + (size_t)e * 1024 * EXH; const float* wd = P.in(I_MOEWD) + (size_t)e * EXH * 1024;
        if (r < NGU) { if (which & 1) wt_job8(r, wg, EXH, EXQ / 32, q * EXQ, Wgu + (size_t)e * 2 * EXQ * 1024, 1024, 0, 1, 0, scr, F.lane); continue; } r -= NGU;
        if (r < NGU) { if (which & 1) wt_job8(r, wu, EXH, EXQ / 32, q * EXQ, Wgu + (size_t)e * 2 * EXQ * 1024, 1024, 128, 1, 0, scr, F.lane); continue; } r -= NGU;
        if (which & 2) wt_job8(r, wd, 1024, 32, 0, Wd + (size_t)e * 1024 * EXQ, EXQ, 0, 0, q * EXQ, scr, F.lane);
    }
}

template <int MODE_Y, bool ROUTE>
__device__ __forceinline__ void resid_norm_row(const Frame& F, const KA& P, int row, const void* xin, bool xin_bf, const float* Yp, const f32x4 (&pa)[4], const f32x4 (&pb)[4], const f32x4 (&psh)[4], void* xout, bool xout_bf,
                                               bf16_t* Hout, f32x4 (&hv)[4], int s0 = 0, int s1 = 0, float g0 = 0.f, float g1 = 0.f) {
    f32x4 v[4];
    if (xin_bf) { const bf16_t* xb = (const bf16_t*)xin + 4 * F.lane;
#pragma unroll
        for (int j = 0; j < 4; ++j) { const u32x2 a = *(const u32x2*)(xb + 256 * j); v[j] = (f32x4){bflo(a.x), bfhi(a.x), bflo(a.y), bfhi(a.y)}; } }
    else { const f32x4* xr = (const f32x4*)(xin) + F.lane;
#pragma unroll
        for (int j = 0; j < 4; ++j) v[j] = xr[64 * j]; }
    if (MODE_Y != 0) {
        f32x4 y[4];
        if (MODE_Y == 1) { const bf16_t* yr = (const bf16_t*)(Yp) + 4 * F.lane;
#pragma unroll
            for (int j = 0; j < 4; ++j) { const u32x2 a = *(const u32x2*)(yr + 256 * j); y[j] = (f32x4){bflo(a.x), bfhi(a.x), bflo(a.y), bfhi(a.y)}; } }
        else {
            const unsigned char* yb = P.ws() + WS_YB;
#pragma unroll
            for (int j = 0; j < 4; ++j) { const int a = *(const int*)(yb + (size_t)s0 * 1024 + 4 * F.lane + 256 * j), b = *(const int*)(yb + (size_t)s1 * 1024 + 4 * F.lane + 256 * j);
                y[j] = (f32x4){g0 * __builtin_amdgcn_cvt_f32_fp8(a, 0) + g1 * __builtin_amdgcn_cvt_f32_fp8(b, 0), g0 * __builtin_amdgcn_cvt_f32_fp8(a, 1) + g1 * __builtin_amdgcn_cvt_f32_fp8(b, 1),
                               g0 * __builtin_amdgcn_cvt_f32_fp8(a, 2) + g1 * __builtin_amdgcn_cvt_f32_fp8(b, 2), g0 * __builtin_amdgcn_cvt_f32_fp8(a, 3) + g1 * __builtin_amdgcn_cvt_f32_fp8(b, 3)}; }
        }
        float s = 0.f;
#pragma unroll
        for (int j = 0; j < 4; ++j) s += (y[j].x * y[j].x + y[j].y * y[j].y) + (y[j].z * y[j].z + y[j].w * y[j].w);
        const float rs = rsqrtf(wave_sum(s) * (1.f / 1024.f) + 1e-6f);
#pragma unroll
        for (int j = 0; j < 4; ++j) v[j] = v[j] + pa[j] * (y[j] * rs);
    }
    if (xout) {
        if (xout_bf) { bf16_t* xo = (bf16_t*)xout + 4 * F.lane;
#pragma unroll
            for (int j = 0; j < 4; ++j) { u32x2 w; w.x = cvt_pk_bf16(v[j].x, v[j].y); w.y = cvt_pk_bf16(v[j].z, v[j].w); *(u32x2*)(xo + 256 * j) = w; } }
        else { f32x4* xo = (f32x4*)(xout) + F.lane;
#pragma unroll
            for (int j = 0; j < 4; ++j) xo[64 * j] = v[j]; } }
    if (Hout) {
        float s = 0.f;
#pragma unroll
        for (int j = 0; j < 4; ++j) s += (v[j].x * v[j].x + v[j].y * v[j].y) + (v[j].z * v[j].z + v[j].w * v[j].w);
        const float rs = rsqrtf(wave_sum(s) * (1.f / 1024.f) + 1e-6f);
#pragma unroll
        for (int j = 0; j < 4; ++j) { const f32x4 h = (v[j] * rs) * pb[j] + psh[j]; hv[j] = h;
            if (ROUTE) *(unsigned*)((unsigned char*)Hout + 4 * F.lane + 256 * j) = cvt4_fp8(h.x, h.y, h.z, h.w, 16.f);
            else { u32x2 w; w.x = cvt_pk_bf16(h.x, h.y); w.y = cvt_pk_bf16(h.z, h.w); *(u32x2*)(Hout + 4 * F.lane + 256 * j) = w; } }
    }
}

template <int MODE_Y, bool ROUTE>
__device__ __forceinline__ void phase_resid_norm(const Frame& F, const KA& P, int lmod_gate, int lmod_norm, const float* xin_lat, const float* xin_ctx, const float* Y, int gate_i, const float* gpost,
                                                 float* xout_lat, float* xout_ctx, const float* gpre, int shift_i, bf16_t* Hout, int nrows, const float* router, int xi_mode = 0, int xo_mode = 0) {
    const float* modv_g = (const float*)(P.ws() + WS_MODV) + (size_t)lmod_gate * 9 * 6144; const float* modv_n = (const float*)(P.ws() + WS_MODV) + (size_t)lmod_norm * 9 * 6144;
    LAS int* lcnt = (LAS int*)F.lds;
    int my_e = 0, my_r0 = 0, my_r1 = 0; float my_g0 = 0.f, my_g1 = 0.f;
    LAS float* rl = (LAS float*)(F.lds + 1024);
    if (ROUTE) { if (F.tid < 16) lcnt[F.tid] = 0;
        for (int i = F.tid; i < 8 * 1024; i += NTHR) rl[(i & 7) * 1024 + (i >> 3)] = router[i];
        __syncthreads(); }
    const int RPW = (nrows + F.NGW - 1) / F.NGW, r0 = F.gw * RPW, r1 = (r0 + RPW < nrows) ? r0 + RPW : nrows;
    int jrow = 0, cur_mod = -1;
    f32x4 pa[4], pb[4], psh[4];
#pragma unroll
    for (int j = 0; j < 4; ++j) { pa[j] = (f32x4){0.f, 0.f, 0.f, 0.f}; pb[j] = pa[j]; psh[j] = pa[j]; }
    const int* toks_c = (const int*)(P.ws() + WS_MOEMETA) + (size_t)ML * 2; const float* tokg_c = (const float*)(P.ws() + WS_MOEMETA) + (size_t)ML * 4;
    int ns0 = 0, ns1 = 0; float ng0 = 0.f, ng1 = 0.f;
    if (MODE_Y == 2 && r0 < r1) { ns0 = toks_c[r0 * 2]; ns1 = toks_c[r0 * 2 + 1]; ng0 = tokg_c[r0 * 2]; ng1 = tokg_c[r0 * 2 + 1]; }
    for (int row = r0; row < r1; ++row, ++jrow) {
        const int cs0 = ns0, cs1 = ns1; const float cg0 = ng0 * (1.f / 32.f), cg1 = ng1 * (1.f / 32.f);
        if (MODE_Y == 2) { const int rn = (row + 1 < r1) ? row + 1 : row; ns0 = toks_c[rn * 2]; ns1 = toks_c[rn * 2 + 1]; ng0 = tokg_c[rn * 2]; ng1 = tokg_c[rn * 2 + 1]; }
        const bool isc = row >= ML; const int modrow = isc ? 8 : row / SEQL;
        if (modrow != cur_mod) { cur_mod = modrow;
            if (MODE_Y != 0) { const f32x4* gt = (const f32x4*)(modv_g + (size_t)modrow * 6144 + gate_i * 1024) + F.lane; const f32x4* gp = (const f32x4*)(gpost) + F.lane;
#pragma unroll
                for (int j = 0; j < 4; ++j) pa[j] = gt[64 * j] * gp[64 * j]; }
            if (Hout) { const f32x4* gp = (const f32x4*)(gpre) + F.lane; const f32x4* sh = (const f32x4*)(modv_n + (size_t)modrow * 6144 + shift_i * 1024) + F.lane; const f32x4* sc = sh + 256;
#pragma unroll
                for (int j = 0; j < 4; ++j) { pb[j] = gp[64 * j] * (sc[64 * j] + 1.0f); psh[j] = sh[64 * j]; } } }
        const unsigned char* xs_row = P.ws() + (row < XS_ROWS_A ? WS_XS_A + (size_t)row * 2048 : WS_XS_B + (size_t)(row - XS_ROWS_A) * 2048);
        const void* xin = isc ? (const void*)(xin_ctx + (size_t)(row - ML) * 1024) : xi_mode == 0 ? (const void*)(xin_lat + (size_t)row * 1024) : xi_mode == 1 ? (const void*)((const unsigned char*)xin_lat + (size_t)row * 2048) : (const void*)xs_row;
        void* xout = isc ? (xout_ctx ? (void*)(xout_ctx + (size_t)(row - ML) * 1024) : nullptr) : !xout_lat ? nullptr : xo_mode == 0 ? (void*)(xout_lat + (size_t)row * 1024) : xo_mode == 1 ? (void*)((unsigned char*)xout_lat + (size_t)row * 2048) : (void*)xs_row;
        const bool xin_bf = !isc && xi_mode != 0, xout_bf = !isc && xo_mode != 0;
        f32x4 hv[4];
        resid_norm_row<MODE_Y, ROUTE>(F, P, row, xin, xin_bf, Y ? (const float*)((const bf16_t*)Y + (size_t)row * 1024) : nullptr, pa, pb, psh, xout, xout_bf, Hout ? Hout + (size_t)row * (ROUTE ? 512 : 1024) : nullptr, hv, cs0, cs1, cg0, cg1);
        if (ROUTE) {
            float lg[8];
#pragma unroll
            for (int e = 0; e < 8; ++e) lg[e] = 0.f;
#pragma unroll
            for (int j = 0; j < 4; ++j)
#pragma unroll
                for (int e = 0; e < 8; ++e) { const f32x4 rv = *(const LAS f32x4*)(rl + e * 1024 + 4 * F.lane + 256 * j);
                    lg[e] += (hv[j].x * rv.x + hv[j].y * rv.y) + (hv[j].z * rv.z + hv[j].w * rv.w); }
#pragma unroll
            for (int e = 0; e < 8; ++e) lg[e] = wave_sum(lg[e]);
            int e0 = 0; float b0 = lg[0];
#pragma unroll
            for (int e = 1; e < 8; ++e) if (lg[e] > b0) { b0 = lg[e]; e0 = e; }
            int e1 = -1; float b1 = -3.0e38f;
#pragma unroll
            for (int e = 0; e < 8; ++e) if (e != e0 && lg[e] > b1) { b1 = lg[e]; e1 = e; }
            const float g0 = 1.0f / (1.0f + __expf(b1 - b0)), g1 = 1.0f - g0;
            int r0 = 0, r1 = 0;
            if (F.lane == 0) { r0 = __hip_atomic_fetch_add(&lcnt[e0], 1, __ATOMIC_RELAXED, __HIP_MEMORY_SCOPE_WORKGROUP); r1 = __hip_atomic_fetch_add(&lcnt[e1], 1, __ATOMIC_RELAXED, __HIP_MEMORY_SCOPE_WORKGROUP); }
            r0 = __builtin_amdgcn_readfirstlane(r0); r1 = __builtin_amdgcn_readfirstlane(r1);
            if (F.lane == jrow) { my_e = e0 | (e1 << 8); my_r0 = r0; my_r1 = r1; my_g0 = g0; my_g1 = g1; }
        }
    }
    if (ROUTE) {
        __syncthreads();
        unsigned* gcnt = (unsigned*)(P.ws() + WS_CTL) + CW_MOECNT;
        if (F.tid < 8) lcnt[8 + F.tid] = (int)atomicAdd(&gcnt[64 * F.tid], (unsigned)lcnt[F.tid]);
        __syncthreads();
        const int row = r0 + F.lane;
        if (F.lane < jrow && row < nrows) {
            int* toke = (int*)(P.ws() + WS_MOEMETA); int* toks = toke + (size_t)ML * 2; float* tokg = (float*)(P.ws() + WS_MOEMETA) + (size_t)ML * 4;
            const int e0 = my_e & 255, e1 = my_e >> 8;
            toke[row * 2] = e0; toke[row * 2 + 1] = e1; toks[row * 2] = my_r0 + lcnt[8 + e0]; toks[row * 2 + 1] = my_r1 + lcnt[8 + e1]; tokg[row * 2] = my_g0; tokg[row * 2 + 1] = my_g1;
        }
        __syncthreads();
    }
}

__device__ __forceinline__ void phase_h8(const Frame& F, const KA& P, int nrows) {
    if (F.bid < 128) return;
    const bf16_t* H = (const bf16_t*)(P.ws() + WS_H); unsigned char* H8 = P.ws() + WS_H8;
    const int nw = (F.G - 128) * NWAVES;
#pragma unroll 4
    for (int row = (F.bid - 128) * NWAVES + F.wave; row < nrows; row += nw) {
        const u32x4* src = (const u32x4*)(H + (size_t)row * 1024) + 2 * F.lane; const u32x4 a = src[0], b = src[1];
        u32x4 o; o.x = cvt4_fp8(bflo(a.x), bfhi(a.x), bflo(a.y), bfhi(a.y), 16.f); o.y = cvt4_fp8(bflo(a.z), bfhi(a.z), bflo(a.w), bfhi(a.w), 16.f);
        o.z = cvt4_fp8(bflo(b.x), bfhi(b.x), bflo(b.y), bfhi(b.y), 16.f); o.w = cvt4_fp8(bflo(b.z), bfhi(b.z), bflo(b.w), bfhi(b.w), 16.f);
        *((u32x4*)(H8 + (size_t)row * 1024) + F.lane) = o;
    }
}

__device__ __forceinline__ void moe_pad_ends(const KA& P, int (&pe)[8]) {
    const unsigned* gcnt = (const unsigned*)(P.ws() + WS_CTL) + CW_MOECNT; int acc = 0;
#pragma unroll
    for (int e = 0; e < 8; ++e) { const int sz = __builtin_amdgcn_readfirstlane((int)__hip_atomic_load(&gcnt[64 * e], __ATOMIC_RELAXED, __HIP_MEMORY_SCOPE_AGENT)); acc += (sz + 255) / 256 * 256; pe[e] = acc; }
}
__device__ __forceinline__ void phase_moe_gather(const Frame& F, const KA& P) {
    int pe[8]; moe_pad_ends(P, pe);
    const int* toke = (const int*)(P.ws() + WS_MOEMETA); int* toks = (int*)(P.ws() + WS_MOEMETA) + (size_t)ML * 2;
    const unsigned char* H = P.ws() + WS_H; unsigned char* XB = P.ws() + WS_XB;
#pragma unroll 4
    for (int row = F.gw; row < ML; row += F.NGW) {
        const u32x4 a = *((const u32x4*)(H + (size_t)row * 1024) + F.lane);
#pragma unroll
        for (int k = 0; k < 2; ++k) {
            const int e = __builtin_amdgcn_readfirstlane(toke[row * 2 + k]); int ps = 0;
#pragma unroll
            for (int j = 1; j < 8; ++j) if (j == e) ps = pe[j - 1];
            const int slot = ps + toks[row * 2 + k];
            *((u32x4*)(XB + (size_t)slot * 1024) + F.lane) = a;
            if (F.lane == 0) toks[row * 2 + k] = slot;
        }
    }
}

__device__ __forceinline__ void phase_hyena_filter_mlp(const Frame& F, const KA& P, int l, int ntok, float* out) {
    LAS float* feats = (LAS float*)F.lds;
    LAS float* h1 = feats + 8 * 36;
    LAS float* h2 = h1 + 8 * 64;
    const float* w1 = P.in(I_HYFW1) + (size_t)l * 33 * 64; const float* b1 = P.in(I_HYFB1) + l * 64; const float* f1 = P.in(I_HYFF1) + l * 64;
    const float* w2 = P.in(I_HYFW2) + (size_t)l * 64 * 64; const float* b2 = P.in(I_HYFB2) + l * 64; const float* f2 = P.in(I_HYFF2) + l * 64;
    const float* w3 = P.in(I_HYFW3) + (size_t)l * 64 * 1024;
    const int pl = F.tid >> 6, j = F.tid & 63;
    const float TWO_PI = 6.283185307179586f;
    for (int u = F.bid; u < ntok / 8; u += F.G) {
        const int pos = u * 8 + pl; const float t = (float)pos / (float)(ntok - 1); const float w = (TWO_PI / (float)ntok) * (float)pos;
        if (j < 33) { float v;
            if (j == 0) v = t;
            else { const int b = (j - 1) & 15; const float f = 1e-4f + (float)b * ((15.0f - 1e-4f) / 15.0f); const float a = f * w; v = (j <= 16) ? cosf(a) : -sinf(a); }
            feats[pl * 36 + j] = v; }
        __syncthreads();
        { float s = b1[j];
          for (int i = 0; i < 33; ++i) s += feats[pl * 36 + i] * w1[i * 64 + j];
          h1[pl * 64 + j] = sinf(f1[j] * s); }
        __syncthreads();
        { float s = b2[j];
          for (int i = 0; i < 64; ++i) s += h1[pl * 64 + i] * w2[i * 64 + j];
          h2[pl * 64 + j] = sinf(f2[j] * s); }
        __syncthreads();
#pragma unroll
        for (int half = 0; half < 2; ++half) {
            const int oc = F.tid + 512 * half;
            float a[8];
#pragma unroll
            for (int p = 0; p < 8; ++p) a[p] = 0.f;
#pragma unroll 1
            for (int i0 = 0; i0 < 64; i0 += 16) { float wv[16];
#pragma unroll
                for (int k = 0; k < 16; ++k) wv[k] = w3[(i0 + k) * 1024 + oc];
#pragma unroll
                for (int k = 0; k < 16; ++k)
#pragma unroll
                    for (int p = 0; p < 8; ++p) a[p] += h2[p * 64 + i0 + k] * wv[k]; }
            const int ch = oc & 255; const float ra = -15.350567286626973f, rb = -3.0701134573253946f;
            const float rate = fabsf(ra + (float)ch * ((rb - ra) / 255.0f));
            float* o = out + (size_t)oc * ntok + u * 8;
#pragma unroll
            for (int p = 0; p < 8; ++p) { const float tt = (float)(u * 8 + p) / (float)(ntok - 1); o[p] = a[p] * __expf(-tt * rate); }
        }
        __syncthreads();
    }
}

constexpr int FN = 8192;
__device__ __forceinline__ f32x2 cmul(f32x2 a, f32x2 b) { return (f32x2){a.x * b.x - a.y * b.y, a.x * b.y + a.y * b.x}; }
__device__ __forceinline__ f32x2 cmulc(f32x2 a, f32x2 b) { return (f32x2){a.x * b.x + a.y * b.y, a.y * b.x - a.x * b.y}; }
__device__ __forceinline__ void fft_make_twiddles(LAS f32x2* TW, int tid) {
    for (int k = tid; k < FN / 2; k += NTHR) {
        const int q = k >> 10, r = k & 1023; const float a = (float)r * (6.283185307179586f / 8192.0f);
        const float a2 = a * a;
        const float s = a + a * a2 * (-1.6666654611e-1f + a2 * (8.3321608736e-3f + a2 * (-1.9515295891e-4f)));
        const float c = 1.0f - 0.5f * a2 + a2 * a2 * (4.166664568298827e-2f + a2 * (-1.388731625493765e-3f + a2 * 2.443315711809948e-5f));
        const float R = 0.70710678118654752f;
        float cr, sr;
        if (q == 0) { cr = c; sr = s; } else if (q == 1) { cr = R * (c - s); sr = R * (c + s); } else if (q == 2) { cr = -s; sr = c; } else { cr = -R * (c + s); sr = R * (c - s); }
        TW[k] = (f32x2){cr, -sr};
        if ((k & 15) == 0 && k < 512) TW[FN / 2 + (k >> 4)] = (f32x2){cr, -sr};
    }
}
__device__ __forceinline__ void pw16(const f32x2 w, f32x2 (&p)[16]) {
    p[0] = (f32x2){1.f, 0.f}; p[1] = w; p[2] = cmul(w, w); p[4] = cmul(p[2], p[2]); p[8] = cmul(p[4], p[4]);
    p[3] = cmul(p[2], w); p[5] = cmul(p[4], w); p[6] = cmul(p[4], p[2]); p[7] = cmul(p[4], p[3]);
#pragma unroll
    for (int k = 1; k < 8; ++k) p[8 + k] = cmul(p[8], p[k]);
}
#define XI(e) ((e) + ((e) >> 5))
constexpr int FFT_X_BYTES = (FN + FN / 32) * 8;
__device__ __forceinline__ f32x2 tw_get(const LAS f32x2* TW, int idx) { const f32x2 w = TW[idx & (FN / 2 - 1)]; return (idx & (FN / 2)) ? (f32x2){-w.x, -w.y} : w; }
template <int K> __device__ __forceinline__ f32x2 w16c() {
    constexpr float c[8] = {1.f, 0.92387953251f, 0.70710678119f, 0.38268343237f, 0.f, -0.38268343237f, -0.70710678119f, -0.92387953251f};
    constexpr float s[8] = {0.f, -0.38268343237f, -0.70710678119f, -0.92387953251f, -1.f, -0.92387953251f, -0.70710678119f, -0.38268343237f};
    return (f32x2){c[K], s[K]}; }
template <int H, int B, int J> __device__ __forceinline__ void bf_dif(f32x2 (&x)[16]) { const f32x2 a = x[B + J], c = x[B + J + H]; x[B + J] = a + c; x[B + J + H] = cmul(a - c, w16c<J * (8 / H)>()); }
template <int H, int B, int J> __device__ __forceinline__ void bf_dit(f32x2 (&x)[16]) { const f32x2 a = x[B + J], c = cmulc(x[B + J + H], w16c<J * (8 / H)>()); x[B + J] = a + c; x[B + J + H] = a - c; }
template <int H, int B, int J> struct Bf16Loop {
    static __device__ __forceinline__ void dif(f32x2 (&x)[16]) { bf_dif<H, B, J>(x); if constexpr (J + 1 < H) Bf16Loop<H, B, J + 1>::dif(x); else if constexpr (B + 2 * H < 16) Bf16Loop<H, B + 2 * H, 0>::dif(x); }
    static __device__ __forceinline__ void dit(f32x2 (&x)[16]) { bf_dit<H, B, J>(x); if constexpr (J + 1 < H) Bf16Loop<H, B, J + 1>::dit(x); else if constexpr (B + 2 * H < 16) Bf16Loop<H, B + 2 * H, 0>::dit(x); }
};
__device__ __forceinline__ void dif16(f32x2 (&x)[16]) { Bf16Loop<8, 0, 0>::dif(x); Bf16Loop<4, 0, 0>::dif(x); Bf16Loop<2, 0, 0>::dif(x); Bf16Loop<1, 0, 0>::dif(x); }
__device__ __forceinline__ void dit16(f32x2 (&x)[16]) { Bf16Loop<1, 0, 0>::dit(x); Bf16Loop<2, 0, 0>::dit(x); Bf16Loop<4, 0, 0>::dit(x); Bf16Loop<8, 0, 0>::dit(x); }
__device__ __forceinline__ constexpr int rev4(int r) { return ((r & 1) << 3) | ((r & 2) << 1) | ((r & 4) >> 1) | ((r & 8) >> 3); }
__device__ __forceinline__ void fft_dif(LAS f32x2* X, const LAS f32x2* TW, int tid) {
    f32x2 x[16];
#pragma unroll
    for (int j = 0; j < 16; ++j) x[j] = X[XI(tid + 512 * j)];
    dif16(x);
    { f32x2 pw[16]; pw16(TW[tid], pw);
#pragma unroll
      for (int r = 1; r < 16; ++r) x[r] = cmul(x[r], pw[rev4(r)]); }
#pragma unroll
    for (int r = 0; r < 16; ++r) X[XI(tid + 512 * r)] = x[r];
    __syncthreads();
    { const int base = (tid >> 5) * 512 + (tid & 31), ip = tid & 31;
#pragma unroll
      for (int j = 0; j < 16; ++j) x[j] = X[XI(base + 32 * j)];
      dif16(x);
      { f32x2 pw[16]; pw16(TW[FN / 2 + ip], pw);
#pragma unroll
        for (int r = 1; r < 16; ++r) x[r] = cmul(x[r], pw[rev4(r)]); }
#pragma unroll
      for (int r = 0; r < 16; ++r) X[XI(base + 32 * r)] = x[r]; }
    __syncthreads();
    if (tid < 256) { const int base = 33 * tid;
        f32x2 y[16];
#pragma unroll
        for (int j = 0; j < 16; ++j) { const f32x2 a = X[base + j], c = X[base + 16 + j]; x[j] = a + c; y[j] = cmul(a - c, tw_get(TW, 256 * j)); }
        dif16(x); dif16(y);
#pragma unroll
        for (int j = 0; j < 16; ++j) { X[base + j] = x[j]; X[base + 16 + j] = y[j]; } }
    __syncthreads();
}
__device__ __forceinline__ void fft_dit_inv(LAS f32x2* X, const LAS f32x2* TW, int tid) {
    f32x2 x[16];
    if (tid < 256) { const int base = 33 * tid; f32x2 y[16];
#pragma unroll
        for (int j = 0; j < 16; ++j) { x[j] = X[base + j]; y[j] = X[base + 16 + j]; }
        dit16(x); dit16(y);
#pragma unroll
        for (int j = 0; j < 16; ++j) { const f32x2 c = cmulc(y[j], tw_get(TW, 256 * j)); X[base + j] = x[j] + c; X[base + 16 + j] = x[j] - c; } }
    __syncthreads();
    { const int base = (tid >> 5) * 512 + (tid & 31), ip = tid & 31;
#pragma unroll
      for (int r = 0; r < 16; ++r) x[r] = X[XI(base + 32 * r)];
      { f32x2 pw[16]; pw16(TW[FN / 2 + ip], pw);
#pragma unroll
        for (int r = 1; r < 16; ++r) x[r] = cmulc(x[r], pw[rev4(r)]); }
      dit16(x);
#pragma unroll
      for (int j = 0; j < 16; ++j) X[XI(base + 32 * j)] = x[j]; }
    __syncthreads();
#pragma unroll
    for (int r = 0; r < 16; ++r) x[r] = X[XI(tid + 512 * r)];
    { f32x2 pw[16]; pw16(TW[tid], pw);
#pragma unroll
      for (int r = 1; r < 16; ++r) x[r] = cmulc(x[r], pw[rev4(r)]); }
    dit16(x);
#pragma unroll
    for (int j = 0; j < 16; ++j) X[XI(tid + 512 * j)] = x[j];
    __syncthreads();
}

__device__ __forceinline__ void phase_hyena_filter_fft(const Frame& F, const KA& P) {
    LAS f32x2* X = (LAS f32x2*)F.lds; LAS f32x2* TW = (LAS f32x2*)(F.lds + FFT_X_BYTES);
    fft_make_twiddles(TW, F.tid);
    const float* hf = (const float*)(P.ws() + WS_HFILT); f32x2* KS = (f32x2*)(P.ws() + WS_KSPEC);
    for (int u = F.bid; u < 512; u += F.G) {
        const int o = u >> 8, ch = u & 255;
        const float* fw = hf + ((size_t)(o * 2 + 0) * 256 + ch) * 4096; const float* bw = hf + ((size_t)(o * 2 + 1) * 256 + ch) * 4096;
        __syncthreads();
        { float fv[8], bv[8];
#pragma unroll
          for (int k = 0; k < 8; ++k) { const int i = F.tid + NTHR * k; fv[k] = fw[i]; bv[k] = bw[i == 0 ? 0 : 4096 - i]; }
#pragma unroll
          for (int k = 0; k < 8; ++k) { const int i = F.tid + NTHR * k; X[XI(i)] = (f32x2){fv[k], 0.f}; X[XI(4096 + i)] = (f32x2){i == 0 ? 0.f : bv[k], 0.f}; } }
        __syncthreads();
        fft_dif(X, TW, F.tid);
        for (int i = F.tid; i < FN; i += NTHR) KS[(size_t)u * FN + i] = X[XI(i)];
    }
    __syncthreads();
}

__device__ __forceinline__ void phase_hyena_transpose_in(const Frame& F, const KA& P, int l) {
    constexpr int LD = 768;
    LAS bf16_t* T = (LAS bf16_t*)F.lds;
    const bf16_t* HY = (const bf16_t*)(P.ws() + WS_HY); bf16_t* HYT = (bf16_t*)(P.ws() + WS_HYT);
    const float* cw = P.in(I_HYCONVW) + (size_t)l * 3 * 768; const float* cb = P.in(I_HYCONVB) + (size_t)l * 768;
    LAS float* WL = (LAS float*)(F.lds + 64 * LD * 2);
    for (int i = F.tid; i < 4 * 768; i += NTHR) WL[i] = (i < 3 * 768) ? cw[i] : cb[i - 3 * 768];
    for (int u = F.bid; u < NBATCH * 64; u += F.G) {
        const int b = u >> 6, gr = u & 63; const size_t row0 = (size_t)b * SEQL + gr * 64;
        __syncthreads();
        { u32x4 tv[12];
#pragma unroll
          for (int k = 0; k < 12; ++k) { const int i = F.tid + NTHR * k, t = i / 96, c8 = i % 96; tv[k] = *(const u32x4*)(HY + (row0 + t) * 768 + c8 * 8); }
#pragma unroll
          for (int k = 0; k < 12; ++k) { const int i = F.tid + NTHR * k, t = i / 96, c8 = i % 96; *(LAS u32x4*)(T + t * LD + ((c8 ^ ((t >> 3) & 7)) * 8)) = tv[k]; } }
        __syncthreads();
#pragma unroll 2
        for (int i = F.tid; i < 768 * 8; i += NTHR) {
            const int piece = i & 7, c = i >> 3, t0 = piece * 8;
            const float w0 = WL[c], w1 = WL[768 + c], w2 = WL[1536 + c], bb = WL[2304 + c];
            float x[10];
#pragma unroll
            for (int k = 0; k < 10; ++k) { const int t = t0 - 1 + k; x[k] = (t >= 0 && t < 64) ? bf2f(T[t * LD + ((((c >> 3) ^ ((t >> 3) & 7)) << 3) | (c & 7))]) : 0.f; }
            float y[8];
#pragma unroll
            for (int k = 0; k < 8; ++k) y[k] = w0 * x[k] + w1 * x[k + 1] + w2 * x[k + 2] + bb;
            u32x4 o; o.x = cvt_pk_bf16(y[0], y[1]); o.y = cvt_pk_bf16(y[2], y[3]); o.z = cvt_pk_bf16(y[4], y[5]); o.w = cvt_pk_bf16(y[6], y[7]);
            *(u32x4*)(HYT + ((size_t)b * 768 + c) * SEQL + gr * 64 + t0) = o;
        }
    }
    __syncthreads();
}
__device__ __forceinline__ void phase_hyena_transpose_out(const Frame& F, const KA& P) {
    constexpr int LD = 72;
    LAS bf16_t* T = (LAS bf16_t*)F.lds;
    const bf16_t* HYOT = (const bf16_t*)(P.ws() + WS_HYOT); bf16_t* HYOUT = (bf16_t*)(P.ws() + WS_HYOUT);
    for (int u = F.bid; u < NBATCH * 64; u += F.G) {
        const int b = u >> 6, gr = u & 63;
        __syncthreads();
        { u32x4 tv[4];
#pragma unroll
          for (int k = 0; k < 4; ++k) { const int i = F.tid + NTHR * k, ch = i >> 3, p = i & 7; tv[k] = *(const u32x4*)(HYOT + ((size_t)b * 256 + ch) * SEQL + gr * 64 + p * 8); }
#pragma unroll
          for (int k = 0; k < 4; ++k) { const int i = F.tid + NTHR * k, ch = i >> 3, p = i & 7; *(LAS u32x4*)(T + ch * LD + p * 8) = tv[k]; } }
        __syncthreads();
        for (int i = F.tid; i < 64 * 32; i += NTHR) { const int t = i & 63, c8 = i >> 6;
            unsigned w[4];
#pragma unroll
            for (int k = 0; k < 4; ++k) w[k] = (unsigned)T[(c8 * 8 + 2 * k) * LD + t] | ((unsigned)T[(c8 * 8 + 2 * k + 1) * LD + t] << 16);
            *(u32x4*)(HYOUT + ((size_t)b * SEQL + gr * 64 + t) * 256 + c8 * 8) = (u32x4){w[0], w[1], w[2], w[3]}; }
    }
    __syncthreads();
}

__device__ __forceinline__ void phase_hyena_main(const Frame& F, const KA& P, int l) {
    LAS f32x2* X = (LAS f32x2*)F.lds; LAS f32x2* TW = (LAS f32x2*)(F.lds + FFT_X_BYTES);
    fft_make_twiddles(TW, F.tid);
    const bf16_t* HYT = (const bf16_t*)(P.ws() + WS_HYT); bf16_t* HYOT = (bf16_t*)(P.ws() + WS_HYOT); const f32x2* KS = (const f32x2*)(P.ws() + WS_KSPEC);
    const float inv = 1.0f / (float)FN;
    const int t0 = F.tid * 8;
    for (int u = F.bid; u < 4 * 256; u += F.G) {
        const int bp = u >> 8, ch = u & 255, b0 = 2 * bp, b1 = 2 * bp + 1;
        const float bias0 = __int_as_float(__builtin_amdgcn_readfirstlane(__float_as_int(P.in(I_HYBIAS)[(size_t)l * 512 + ch])));
        const float bias1 = __int_as_float(__builtin_amdgcn_readfirstlane(__float_as_int(P.in(I_HYBIAS)[(size_t)l * 512 + 256 + ch])));
        const bf16_t* r0 = HYT + ((size_t)b0 * 768 + ch) * SEQL + t0; const bf16_t* r1 = HYT + ((size_t)b1 * 768 + ch) * SEQL + t0;
        f32x4 va0, va1, vb0, vb1;
        const u32x4 gx1a = *(const u32x4*)(r0 + (size_t)256 * SEQL), gx1b = *(const u32x4*)(r1 + (size_t)256 * SEQL);
        unpack8(*(const u32x4*)(r0), va0, va1); unpack8(*(const u32x4*)(r1), vb0, vb1);
        f32x2 ksv[16];
        { const f32x2* ks = KS + (size_t)(0 * 256 + ch) * FN;
#pragma unroll
          for (int k = 0; k < 16; ++k) ksv[k] = ks[F.tid + NTHR * k]; }
        __syncthreads();
#pragma unroll
        for (int k = 0; k < 4; ++k) { X[XI(t0 + k)] = (f32x2){va0[k], vb0[k]}; X[XI(t0 + 4 + k)] = (f32x2){va1[k], vb1[k]}; }
#pragma unroll
        for (int k = 0; k < 8; ++k) X[XI(4096 + t0 + k)] = (f32x2){0.f, 0.f};
        __syncthreads();
        fft_dif(X, TW, F.tid);
#pragma unroll
        for (int k = 0; k < 16; ++k) { const int i = F.tid + NTHR * k; X[XI(i)] = cmul(X[XI(i)], ksv[k]) * inv; }
        { const f32x2* ks = KS + (size_t)(1 * 256 + ch) * FN;
#pragma unroll
          for (int k = 0; k < 16; ++k) ksv[k] = ks[F.tid + NTHR * k]; }
        __syncthreads();
        fft_dit_inv(X, TW, F.tid);
        f32x4 za0, za1, zb0, zb1;
        { f32x4 xa0, xa1, xb0, xb1; unpack8(gx1a, xa0, xa1); unpack8(gx1b, xb0, xb1);
#pragma unroll
          for (int k = 0; k < 4; ++k) { const f32x2 y = X[XI(t0 + k)], y2 = X[XI(t0 + 4 + k)];
              za0[k] = xa0[k] * fmaf(va0[k], bias0, y.x); zb0[k] = xb0[k] * fmaf(vb0[k], bias0, y.y);
              za1[k] = xa1[k] * fmaf(va1[k], bias0, y2.x); zb1[k] = xb1[k] * fmaf(vb1[k], bias0, y2.y); } }
        const u32x4 gx2a = *(const u32x4*)(r0 + (size_t)512 * SEQL), gx2b = *(const u32x4*)(r1 + (size_t)512 * SEQL);
        __syncthreads();
#pragma unroll
        for (int k = 0; k < 4; ++k) { X[XI(t0 + k)] = (f32x2){za0[k], zb0[k]}; X[XI(t0 + 4 + k)] = (f32x2){za1[k], zb1[k]}; }
#pragma unroll
        for (int k = 0; k < 8; ++k) X[XI(4096 + t0 + k)] = (f32x2){0.f, 0.f};
        __syncthreads();
        fft_dif(X, TW, F.tid);
#pragma unroll
        for (int k = 0; k < 16; ++k) { const int i = F.tid + NTHR * k; X[XI(i)] = cmul(X[XI(i)], ksv[k]) * inv; }
        __syncthreads();
        fft_dit_inv(X, TW, F.tid);
        { f32x4 xa0, xa1, xb0, xb1; unpack8(gx2a, xa0, xa1); unpack8(gx2b, xb0, xb1);
          f32x4 oa0, oa1, ob0, ob1;
#pragma unroll
          for (int k = 0; k < 4; ++k) { const f32x2 y = X[XI(t0 + k)], y2 = X[XI(t0 + 4 + k)];
              oa0[k] = xa0[k] * fmaf(za0[k], bias1, y.x); ob0[k] = xb0[k] * fmaf(zb0[k], bias1, y.y);
              oa1[k] = xa1[k] * fmaf(za1[k], bias1, y2.x); ob1[k] = xb1[k] * fmaf(zb1[k], bias1, y2.y); }
          *(u32x4*)(HYOT + ((size_t)b0 * 256 + ch) * SEQL + t0) = pack8(oa0, oa1); *(u32x4*)(HYOT + ((size_t)b1 * 256 + ch) * SEQL + t0) = pack8(ob0, ob1); }
    }
    __syncthreads();
}
__device__ __forceinline__ void phase_hyena_ctx(const Frame& F, const KA& P, int l) {
    LAS float* Z = (LAS float*)F.lds;
    const int half = F.tid >> 8, t = F.tid & 255;
    LAS float* z = Z + half * 2048; LAS float* gf = z + 256;
    const bf16_t* HY = (const bf16_t*)(P.ws() + WS_HY); bf16_t* HYOUT = (bf16_t*)(P.ws() + WS_HYOUT);
    const float* hfc = (const float*)(P.ws() + WS_HFILTC);
    const float* cw = P.in(I_HYCONVW) + (size_t)l * 3 * 768; const float* cb = P.in(I_HYCONVB) + (size_t)l * 768;
    for (int u0 = F.bid * 2; u0 < NBATCH * 256; u0 += F.G * 2) {
        const int u = u0 + half, b = u >> 8, ch = u & 255; const size_t row0 = (size_t)ML + b * CTXL;
        float s[3];
#pragma unroll
        for (int k = 0; k < 3; ++k) { const int c = k * 256 + ch; float a = cb[c];
#pragma unroll
            for (int j = 0; j < 3; ++j) { const int tt = t - 1 + j; if (tt >= 0 && tt < CTXL) a += cw[j * 768 + c] * bf2f(HY[(row0 + tt) * 768 + c]); }
            s[k] = a; }
        float zc = s[0];
#pragma unroll
        for (int o = 0; o < 2; ++o) {
            __syncthreads();
            z[t] = zc; gf[255 + t] = hfc[((size_t)(o * 2 + 0) * 256 + ch) * 256 + t]; if (t > 0) gf[255 - t] = hfc[((size_t)(o * 2 + 1) * 256 + ch) * 256 + t];
            __syncthreads();
            float y0 = 0.f, y1 = 0.f, y2 = 0.f, y3 = 0.f; const LAS float* gp = gf + 255 + t;
#pragma unroll 8
            for (int q = 0; q < CTXL; q += 4) { const f32x4 z4 = *(const LAS f32x4*)(z + q);
                y0 += gp[-q] * z4.x; y1 += gp[-q - 1] * z4.y; y2 += gp[-q - 2] * z4.z; y3 += gp[-q - 3] * z4.w; }
            const float y = (y0 + y1) + (y2 + y3);
            const float bias = P.in(I_HYBIAS)[(size_t)l * 512 + o * 256 + ch];
            zc = s[1 + o] * (y + zc * bias);
        }
        HYOUT[(row0 + t) * 256 + ch] = f2bf(zc);
    }
    __syncthreads();
}

__device__ __forceinline__ int chain_row(int b, int d, int c) {
    if (c < 4) { const int j = d ? 3 - c : c; return ML + b * CTXL + 64 * j; }
    const int j = d ? 67 - c : c - 4; return b * SEQL + 64 * j;
}
__device__ __forceinline__ void ld8bf(const bf16_t* p, float (&o)[8]) { const u32x4 w = *(const u32x4*)p; o[0] = bflo(w.x); o[1] = bfhi(w.x); o[2] = bflo(w.y); o[3] = bfhi(w.y); o[4] = bflo(w.z); o[5] = bfhi(w.z); o[6] = bflo(w.w); o[7] = bfhi(w.w); }
__device__ __forceinline__ void ld8f(const float* p, float (&o)[8]) { const f32x4 a = *(const f32x4*)p, b = *(const f32x4*)(p + 4); o[0] = a.x; o[1] = a.y; o[2] = a.z; o[3] = a.w; o[4] = b.x; o[5] = b.y; o[6] = b.z; o[7] = b.w; }
__device__ __forceinline__ void lds_ld8(const LAS float* p, float (&o)[8]) { const f32x4 a = *(const LAS f32x4*)p, b = *(const LAS f32x4*)(p + 4); o[0] = a.x; o[1] = a.y; o[2] = a.z; o[3] = a.w; o[4] = b.x; o[5] = b.y; o[6] = b.z; o[7] = b.w; }
__device__ __forceinline__ void lds_st8(LAS float* p, const float (&o)[8]) { *(LAS f32x4*)p = (f32x4){o[0], o[1], o[2], o[3]}; *(LAS f32x4*)(p + 4) = (f32x4){o[4], o[5], o[6], o[7]}; }
#define WAVE_LDS_SYNC() do { asm volatile("s_waitcnt lgkmcnt(0)" ::: "memory"); } while (0)

__device__ __forceinline__ float gelu_as(float v) {
    const float t = __builtin_amdgcn_rcpf(fabsf(v) * 0.2316418882f + 1.0f);
    float q = t * 0.5307027145f + (-0.7265760135f); q = q * t + 0.7107068705f; q = q * t + (-0.142248368f); q = q * t + 0.127414796f; q = q * t;
    const float m = v * (q * __builtin_amdgcn_exp2f((v * v) * (-0.72134752044f)));
    return v < 0.f ? m : v - m;
}
typedef float f32x16s __attribute__((ext_vector_type(16)));
constexpr int HBP = 68;
struct S5Tab { float ar, ai; u32x4 bfr[4], cf[4]; };
template <bool OUT>
__device__ __forceinline__ void s5_tab_load(S5Tab& t, const KA& P, int l, int d, int g, int lane) {
    const int ldg = (l * 2 + d) * 16 + g, r = lane & 31, hb = lane >> 5;
    const float* tab = (const float*)(P.ws() + WS_S5TAB) + (size_t)ldg * 2304;
    t.ar = tab[lane]; t.ai = tab[64 + lane];
    const bf16_t* T2 = (const bf16_t*)(P.ws() + WS_S5TAB2) + (size_t)ldg * 4096;
#pragma unroll
    for (int tn = 0; tn < 4; ++tn) t.bfr[tn] = *(const u32x4*)(T2 + (32 * tn + r) * 16 + 8 * hb);
#pragma unroll
    for (int q = 0; q < 4; ++q) t.cf[q] = OUT ? *(const u32x4*)(T2 + 2048 + (lane & 15) * 128 + 32 * q + 8 * (lane >> 4)) : (u32x4){0u, 0u, 0u, 0u};
}
template <bool OUT>
__device__ __forceinline__ void s5_task(const S5Tab& t, const KA& P, int d, int g, int rowbase, float& hr, float& hi, LAS unsigned* HB, LAS float* yt, int lane) {
    const int r = lane & 31, hb = lane >> 5, p = lane;
    const float ar = t.ar, ai = t.ai;
    const bf16_t* U = (const bf16_t*)(P.ws() + WS_U);
#pragma unroll 1
    for (int hf = 0; hf < 2; ++hf) {
        const int sr = 32 * hf + r, tr = d ? 63 - sr : sr;
        const u32x4 afr = *(const u32x4*)(U + (size_t)(rowbase + tr) * 256 + g * 16 + 8 * hb);
        f32x16s acc[4];
#pragma unroll
        for (int tn = 0; tn < 4; ++tn) {
#pragma unroll
            for (int i = 0; i < 16; ++i) acc[tn][i] = 0.f;
            acc[tn] = __builtin_amdgcn_mfma_f32_32x32x16_bf16(__builtin_bit_cast(bf16x8, afr), __builtin_bit_cast(bf16x8, t.bfr[tn]), acc[tn], 0, 0, 0); }
        asm volatile("s_waitcnt lgkmcnt(0)" ::: "memory");
#pragma unroll
        for (int i = 0; i < 16; ++i) { const int s = 8 * (i >> 2) + 4 * hb + (i & 3);
            HB[s * HBP + r] = cvt_pk_bf16(acc[0][i], acc[2][i]); HB[s * HBP + 32 + r] = cvt_pk_bf16(acc[1][i], acc[3][i]); }
        asm volatile("s_waitcnt lgkmcnt(0)" ::: "memory");
#pragma unroll 8
        for (int s = 0; s < 32; ++s) { const unsigned w = HB[s * HBP + p];
            const float nr = ar * hr - ai * hi + bflo(w), ni = ar * hi + ai * hr + bfhi(w); hr = nr; hi = ni;
            if (OUT) HB[s * HBP + p] = cvt_pk_bf16(hr, hi); }
        if (OUT) {
            asm volatile("s_waitcnt lgkmcnt(0)" ::: "memory");
#pragma unroll
            for (int tm = 0; tm < 2; ++tm) { f32x4 y = (f32x4){0.f, 0.f, 0.f, 0.f};
#pragma unroll
                for (int q = 0; q < 4; ++q) y = __builtin_amdgcn_mfma_f32_16x16x32_bf16(__builtin_bit_cast(bf16x8, *(const LAS u32x4*)(HB + (16 * tm + (lane & 15)) * HBP + 16 * q + 4 * (lane >> 4))), __builtin_bit_cast(bf16x8, t.cf[q]), y, 0, 0, 0);
#pragma unroll
                for (int j = 0; j < 4; ++j) { const int s = 32 * hf + 16 * tm + 4 * (lane >> 4) + j, t = d ? 63 - s : s;
                    yt[t * 68 + (g & 3) * 16 + (lane & 15)] = y[j]; } }
        }
    }
}
__device__ __forceinline__ void phase_s5_local(const Frame& F, const KA& P, int l) {
    f32x2* E = (f32x2*)(P.ws() + WS_E);
    LAS unsigned* HB = (LAS unsigned*)(F.lds + F.wave * (32 * HBP * 4));
    const int dg = F.gw & 31, d = dg >> 4, g = dg & 15;
    S5Tab tb; s5_tab_load<false>(tb, P, l, d, g, fresh_lane());
    for (int bc = F.gw >> 5; bc < NBATCH * NCHAIN; bc += F.NGW >> 5) {
        const int lane = fresh_lane();
        const int c = bc % NCHAIN, b = bc / NCHAIN;
        float hr = 0.f, hi = 0.f;
        s5_task<false>(tb, P, d, g, chain_row(b, d, c), hr, hi, HB, nullptr, lane);
        E[((size_t)(((b * 2 + d) * 16 + g) * NCHAIN + c)) * 64 + lane] = (f32x2){hr, hi};
    }
    __syncthreads();
}
__device__ __forceinline__ void phase_s5_carry(const Frame& F, const KA& P, int l) {
    const f32x2* E = (const f32x2*)(P.ws() + WS_E); f32x2* CIN = (f32x2*)(P.ws() + WS_CIN);
    LAS f32x2* XS = (LAS f32x2*)F.lds;
    const int p = F.lane, w = F.wave, n = (w < 4) ? 9 : 8, c0 = (w < 4) ? 9 * w : 36 + 8 * (w - 4);
    for (int bdg = F.bid; bdg < NBATCH * 32; bdg += F.G) {
        const int d = (bdg >> 4) & 1, g = bdg & 15;
        const float* tab = (const float*)(P.ws() + WS_S5TAB) + (size_t)((l * 2 + d) * 16 + g) * 2304;
        const float tr = tab[128 + p], ti = tab[192 + p];
        f32x2 e[9];
#pragma unroll
        for (int k = 0; k < 9; ++k) { const int c = (c0 + k < NCHAIN) ? c0 + k : NCHAIN - 1; e[k] = E[((size_t)bdg * NCHAIN + c) * 64 + p]; }
        float lr[9], li[9]; float cr = 0.f, ci = 0.f;
#pragma unroll
        for (int k = 0; k < 9; ++k) { lr[k] = cr; li[k] = ci;
            if (k < n) { const float nr = tr * cr - ti * ci + e[k].x, ni = tr * ci + ti * cr + e[k].y; cr = nr; ci = ni; } }
        __syncthreads();
        XS[w * 64 + p] = (f32x2){cr, ci};
        __syncthreads();
        const float t2r = tr * tr - ti * ti, t2i = 2.f * tr * ti, t4r = t2r * t2r - t2i * t2i, t4i = 2.f * t2r * t2i, t8r = t4r * t4r - t4i * t4i, t8i = 2.f * t4r * t4i;
        const float t9r = t8r * tr - t8i * ti, t9i = t8r * ti + t8i * tr;
        float hr = 0.f, hi = 0.f;
#pragma unroll
        for (int v = 0; v < 7; ++v) if (v < w) { const float ar = (v < 4) ? t9r : t8r, ai = (v < 4) ? t9i : t8i; const f32x2 bv = XS[v * 64 + p];
            const float nr = ar * hr - ai * hi + bv.x, ni = ar * hi + ai * hr + bv.y; hr = nr; hi = ni; }
        float pr = hr, pi = hi;
#pragma unroll
        for (int k = 0; k < 9; ++k) if (k < n) { CIN[((size_t)bdg * NCHAIN + c0 + k) * 64 + p] = (f32x2){pr + lr[k], pi + li[k]};
            const float nr = tr * pr - ti * pi, ni = tr * pi + ti * pr; pr = nr; pi = ni; }
    }
}
__device__ __forceinline__ void phase_s5_out(const Frame& F, const KA& P, int l) {
    LAS unsigned* HB = (LAS unsigned*)(F.lds + F.wave * (32 * HBP * 4));
    LAS float* yt2 = (LAS float*)(F.lds + 8 * (32 * HBP * 4));
    const bf16_t* U = (const bf16_t*)(P.ws() + WS_U); const f32x2* CIN = (const f32x2*)(P.ws() + WS_CIN); bf16_t* YPRE = (bf16_t*)(P.ws() + WS_YPRE);
    const int d = F.wave & 1;
    const int gq = F.bid & 3, g = gq * 4 + (F.wave >> 1);
    S5Tab tb; s5_tab_load<true>(tb, P, l, d, g, fresh_lane());
    for (int bt = F.bid >> 2; bt < NBATCH * NCHAIN; bt += F.G >> 2) {
        const int lane = fresh_lane(), tid = F.wave * 64 + lane;
        const int tc = bt % NCHAIN, b = bt / NCHAIN;
        const bool isc = tc < 4; const int j = isc ? tc : tc - 4; const int rowbase = isc ? ML + b * CTXL + 64 * j : b * SEQL + 64 * j;
        const int c = isc ? (d ? 3 - j : j) : (d ? 67 - j : 4 + j);
        __syncthreads();
        const f32x2 h0 = CIN[((size_t)(((b * 2 + d) * 16 + g) * NCHAIN + c)) * 64 + lane];
        float hr = h0.x, hi = h0.y;
        const int ft = tid >> 3, fcs = tid & 7;
        const u32x4 fu = *(const u32x4*)(U + (size_t)(rowbase + ft) * 256 + gq * 64 + fcs * 8);
        float Dv[8]; ld8f(P.in(I_S5D) + (size_t)l * 256 + gq * 64 + fcs * 8, Dv);
        __syncthreads();
        s5_task<true>(tb, P, d, g, rowbase, hr, hi, HB, yt2 + d * (64 * 68), lane);
        __syncthreads();
        { const int t = ft, cs = fcs;
          f32x4 u0, u1; unpack8(fu, u0, u1);
          f32x4 y0, y1;
#pragma unroll
          for (int k = 0; k < 4; ++k) { float a = yt2[t * 68 + cs * 8 + k] + yt2[64 * 68 + t * 68 + cs * 8 + k] + Dv[k] * u0[k], bq = yt2[t * 68 + cs * 8 + 4 + k] + yt2[64 * 68 + t * 68 + cs * 8 + 4 + k] + Dv[4 + k] * u1[k];
              y0[k] = gelu_as(a); y1[k] = gelu_as(bq); }
          *(u32x4*)(YPRE + (size_t)(rowbase + t) * 256 + gq * 64 + cs * 8) = pack8(y0, y1); }
    }
    __syncthreads();
}

__device__ __forceinline__ float softplusf_(float x) { return fmaxf(x, 0.f) + log1pf(__expf(-fabsf(x))); }
__device__ __forceinline__ void conv8(const bf16_t* X, int ld, size_t row, int col, bool lo, bool hi, const float* cw, int cwld, float (&y)[8]) {
    float x0[8], xm[8], xp[8], w0[8], w1[8], w2[8];
    ld8bf(X + row * ld + col, x0);
    if (lo) ld8bf(X + (row - 1) * ld + col, xm); else { for (int i = 0; i < 8; ++i) xm[i] = 0.f; }
    if (hi) ld8bf(X + (row + 1) * ld + col, xp); else { for (int i = 0; i < 8; ++i) xp[i] = 0.f; }
    ld8f(cw + col, w0); ld8f(cw + cwld + col, w1); ld8f(cw + 2 * cwld + col, w2);
#pragma unroll
    for (int i = 0; i < 8; ++i) y[i] = w0[i] * xm[i] + w1[i] * x0[i] + w2[i] * xp[i];
}
__device__ __forceinline__ void phase_rwkv_naive(const Frame& F, const KA& P, int l) {
    LAS float* Rr = (LAS float*)F.lds; LAS float* Ww = Rr + 4096; LAS float* Kd = Ww + 4096; LAS float* Aa = Kd + 4096; LAS float* Bb = Aa + 4096; LAS float* Vv = Bb + 4096;
    LAS float* Lo = Vv + 2048; LAS float* Yl = Lo;
    const bf16_t* RKV = (const bf16_t*)(P.ws() + WS_RKV); const bf16_t* LORA = (const bf16_t*)(P.ws() + WS_LORA);
    bf16_t* YD = (bf16_t*)(P.ws() + WS_YD); float* CBON = (float*)(P.ws() + WS_CBON);
    const float* cw = P.in(I_RWCONV) + (size_t)l * 3 * 1536;
    for (int ci = F.bid; ci < 256; ci += F.G) {
        const int b = ci >> 5, h = (ci >> 2) & 7, d = (ci >> 1) & 1, vh = ci & 1;
        const int t = F.tid >> 3, cg = F.tid & 7, hc = h * 64 + cg * 8;
        const float* w2p = P.in(I_RWW2) + (size_t)(l * 2 + d) * 64 * 512 + hc; const float* a2p = P.in(I_RWA2) + (size_t)(l * 2 + d) * 64 * 512 + hc;
        float st[8];
#pragma unroll
        for (int i = 0; i < 8; ++i) st[i] = 0.f;
        const int sv = F.tid >> 3, kq = F.tid & 7;
#pragma unroll 1
        for (int c = 0; c < NCHAIN; ++c) {
            const int rowbase = chain_row(b, d, c); const bool isc = c < 4;
            const size_t row = (size_t)rowbase + t;
            int hcx = hc; asm volatile("" : "+v"(hcx));
            bool lo = t > 0, hi = t < 63;
            if (isc) { const int tt = rowbase - (ML + b * CTXL) + t; lo = tt > 0; hi = tt < CTXL - 1; }
            float r8[8], k8[8], v8[8];
            conv8(RKV, 1536, row, hc, lo, hi, cw, 1536, r8); conv8(RKV, 1536, row, 512 + hc, lo, hi, cw, 1536, k8);
            if ((cg >> 2) == vh) { conv8(RKV, 1536, row, 1024 + hc, lo, hi, cw, 1536, v8); lds_st8(Vv + t * 32 + (cg & 3) * 8, v8); }
            lds_st8(Rr + t * 64 + cg * 8, r8);
            float kk[8]; float ss = 0.f;
            { float kkw[8]; ld8f(P.in(I_RWKK) + l * 512 + hcx, kkw);
#pragma unroll
              for (int i = 0; i < 8; ++i) { kk[i] = k8[i] * kkw[i]; ss += kk[i] * kk[i]; } }
            ss = red8(ss); { const float inv = rsqrtf(fmaxf(ss, 1e-24f));
#pragma unroll
              for (int i = 0; i < 8; ++i) kk[i] *= inv; }
            { float na[8];
#pragma unroll
              for (int i = 0; i < 8; ++i) na[i] = -kk[i];
              lds_st8(Aa + t * 64 + cg * 8, na); }
            { float lw[8], la[8]; ld8bf(LORA + row * 256 + d * 64 + cg * 8, lw); ld8bf(LORA + row * 256 + 128 + d * 64 + cg * 8, la);
              lds_st8(Lo + t * 128 + cg * 8, lw); lds_st8(Lo + t * 128 + 64 + cg * 8, la); }
            __syncthreads();
            float wa[8], aa[8];
            ld8f(P.in(I_RWW0) + (l * 2 + d) * 512 + hcx, wa); ld8f(P.in(I_RWA0) + (l * 2 + d) * 512 + hcx, aa);
#pragma unroll 2
            for (int j = 0; j < 64; ++j) { const float lw = Lo[t * 128 + j], la = Lo[t * 128 + 64 + j]; float w2r[8], a2r[8]; ld8f(w2p + (size_t)j * 512, w2r); ld8f(a2p + (size_t)j * 512, a2r);
#pragma unroll
                for (int i = 0; i < 8; ++i) { wa[i] += lw * w2r[i]; aa[i] += la * a2r[i]; } }
            float cb = 0.f;
            { float dec[8], kd[8], bb[8], kaw[8], rkw[8]; ld8f(P.in(I_RWKA) + l * 512 + hcx, kaw); ld8f(P.in(I_RWRK) + l * 512 + hcx, rkw);
#pragma unroll
              for (int i = 0; i < 8; ++i) { const float wl = -softplusf_(-wa[i]) - 0.5f; dec[i] = __expf(-__expf(wl)); const float as = sigmoidf_(aa[i]);
                  kd[i] = k8[i] * (1.0f + (as - 1.0f) * kaw[i]); bb[i] = kk[i] * as; cb += r8[i] * rkw[i] * kd[i]; }
              lds_st8(Ww + t * 64 + cg * 8, dec); lds_st8(Kd + t * 64 + cg * 8, kd); lds_st8(Bb + t * 64 + cg * 8, bb); }
            cb = red8(cb);
            if (cg == 0 && vh == 0) CBON[((size_t)d * MT + row) * 8 + h] = cb;
            __syncthreads();
            if (F.tid < 256) {
#pragma unroll 2
                for (int s = 0; s < 64; ++s) {
                    const int tt = d ? 63 - s : s;
                    float a8[8], w8[8], b8[8], q8[8], rr8[8];
                    lds_ld8(Aa + tt * 64 + kq * 8, a8); lds_ld8(Ww + tt * 64 + kq * 8, w8); lds_ld8(Bb + tt * 64 + kq * 8, b8); lds_ld8(Kd + tt * 64 + kq * 8, q8); lds_ld8(Rr + tt * 64 + kq * 8, rr8);
                    const float vt = Vv[tt * 32 + sv];
                    float sa = 0.f;
#pragma unroll
                    for (int i = 0; i < 8; ++i) sa += st[i] * a8[i];
                    sa = red8(sa);
                    float y = 0.f;
#pragma unroll
                    for (int i = 0; i < 8; ++i) { st[i] = st[i] * w8[i] + sa * b8[i] + vt * q8[i]; y += st[i] * rr8[i]; }
                    y = red8(y);
                    if (kq == 0) Yl[tt * 32 + sv] = y;
                }
            }
            __syncthreads();
            { const int seg = F.tid & 7; const f32x4 y = *(const LAS f32x4*)(Yl + t * 32 + seg * 4);
              u32x2 w; w.x = cvt_pk_bf16(y.x, y.y); w.y = cvt_pk_bf16(y.z, y.w);
              *(u32x2*)(YD + ((size_t)d * MT + row) * 512 + h * 64 + vh * 32 + seg * 4) = w; }
            __syncthreads();
        }
    }
}
__device__ __forceinline__ void phase_rwkv_final(const Frame& F, const KA& P, int l) {
    LAS float* stt = (LAS float*)F.lds;
    const bf16_t* RKV = (const bf16_t*)(P.ws() + WS_RKV); const bf16_t* YD = (const bf16_t*)(P.ws() + WS_YD); const bf16_t* RWG = (const bf16_t*)(P.ws() + WS_RWG);
    const float* CBON = (const float*)(P.ws() + WS_CBON); bf16_t* RWOUT = (bf16_t*)(P.ws() + WS_RWOUT);
    const float* cw = P.in(I_RWCONV) + (size_t)l * 3 * 1536;
    const int c = F.tid, head = c >> 6;
    const float lnw = P.in(I_RWLNW)[l * 512 + c], lnb = P.in(I_RWLNB)[l * 512 + c];
    const float cw0 = cw[1024 + c], cw1 = cw[1536 + 1024 + c], cw2 = cw[3072 + 1024 + c];
    for (int tile = F.bid; tile < MT / 64; tile += F.G) {
        const int rowbase = tile * 64; const bool isc = rowbase >= ML;
        __syncthreads();
#pragma unroll 1
        for (int k = 0; k < 8; ++k) { const int t = F.wave * 8 + k; const size_t row = (size_t)rowbase + t;
            float y0[8], y1[8]; ld8bf(YD + row * 512 + F.lane * 8, y0); ld8bf(YD + ((size_t)MT + row) * 512 + F.lane * 8, y1);
            float s = 0.f;
#pragma unroll
            for (int i = 0; i < 8; ++i) {
#ifdef DBG_SAN2
                if (!(fabsf(y0[i]) < 1e30f)) y0[i] = 0.f; if (!(fabsf(y1[i]) < 1e30f)) y1[i] = 0.f;
#endif
                y0[i] += y1[i]; s += y0[i]; }
            const float mu = red8(s) * (1.0f / 64.0f); float q = 0.f;
#pragma unroll
            for (int i = 0; i < 8; ++i) { const float dd = y0[i] - mu; q += dd * dd; }
            const float rstd = rsqrtf(red8(q) * (1.0f / 64.0f) + 64e-5f);
            if ((F.lane & 7) == 0) { stt[(t * 8 + (F.lane >> 3)) * 2] = mu; stt[(t * 8 + (F.lane >> 3)) * 2 + 1] = rstd; } }
        __syncthreads();
        float xm = 0.f, x0 = bf2f(RKV[(size_t)rowbase * 1536 + 1024 + c]);
        if (isc && (rowbase - ML) % CTXL != 0) xm = bf2f(RKV[(size_t)(rowbase - 1) * 1536 + 1024 + c]);
#pragma unroll 2
        for (int t = 0; t < 64; ++t) { const size_t row = (size_t)rowbase + t;
            bool hi = t < 63; if (isc) hi = ((int)(row - ML) % CTXL) != CTXL - 1;
            const float xp = hi ? bf2f(RKV[(row + 1) * 1536 + 1024 + c]) : 0.f;
            const float v = cw0 * xm + cw1 * x0 + cw2 * xp; xm = x0; x0 = xp;
            float wk0 = bf2f(YD[row * 512 + c]), wk1 = bf2f(YD[((size_t)MT + row) * 512 + c]);
#ifdef DBG_SAN2
            if (!(fabsf(wk0) < 1e30f)) wk0 = 0.f; if (!(fabsf(wk1) < 1e30f)) wk1 = 0.f;
#endif
            const float wkv = wk0 + wk1;
            const float mu = stt[(t * 8 + head) * 2], rstd = stt[(t * 8 + head) * 2 + 1];
            const float cb = CBON[row * 8 + head] + CBON[((size_t)MT + row) * 8 + head];
            const float o = (wkv - mu) * rstd * lnw + lnb + cb * v;
            RWOUT[row * 512 + c] = f2bf(o * bf2f(RWG[row * 512 + c]));
        }
    }
    __syncthreads();
}

typedef float f32x16 __attribute__((ext_vector_type(16)));
constexpr int MP = 72, MSZ = 64 * MP * 2;
__device__ __forceinline__ int mi(int row, int col) { return row * MP + (col ^ (((row >> 3) & 7) << 3)); }
__device__ __forceinline__ int acc_row(int i, int hb) { return 8 * (i >> 2) + 4 * hb + (i & 3); }
__device__ __forceinline__ bf16x8 as_bf16x8(u32x4 w) { return __builtin_bit_cast(bf16x8, w); }
__device__ __forceinline__ unsigned pk_bf16_c(float lo, float hi) { unsigned a = __float_as_uint(lo), b = __float_as_uint(hi);
    a += 0x7fffu + ((a >> 16) & 1u); b += 0x7fffu + ((b >> 16) & 1u); return (a >> 16) | (b & 0xffff0000u); }
__device__ __forceinline__ void mm_tile(f32x16& acc, const LAS bf16_t* A, int row0, const LAS bf16_t* B, int col0, int lane, int q0, int q1) {
    const int r = lane & 31, hb = lane >> 5;
    for (int q = q0; q < q1; ++q) {
        const bf16x8 a = *(const LAS bf16x8*)(A + mi(row0 + r, 16 * q + 8 * hb)), b = *(const LAS bf16x8*)(B + mi(col0 + r, 16 * q + 8 * hb));
        acc = __builtin_amdgcn_mfma_f32_32x32x16_bf16(a, b, acc, 0, 0, 0);
    }
}
__device__ __forceinline__ void st_tile_T(LAS bf16_t* D, int col0, int row0, const f32x16& acc, int lane) {
    const int r = lane & 31, hb = lane >> 5;
#pragma unroll
    for (int g = 0; g < 4; ++g) { u32x2 w; w.x = cvt_pk_bf16(acc[4 * g], acc[4 * g + 1]); w.y = cvt_pk_bf16(acc[4 * g + 2], acc[4 * g + 3]);
        *(LAS u32x2*)(D + mi(col0 + r, row0 + 8 * g + 4 * hb)) = w; }
}
#define TOFF(i) ((8 * ((i) >> 2) + ((i) & 3)) * MP)
__device__ __forceinline__ void tile_base(int row0, int col0, int lane, int (&tb)[4]) {
    const int r = lane & 31, hb = lane >> 5, b0 = (row0 + 4 * hb) * MP + (col0 ^ row0);
#pragma unroll
    for (int g = 0; g < 4; ++g) tb[g] = b0 + (r ^ (8 * g));
}
__device__ __forceinline__ void st_tile_tb(LAS bf16_t* D, const int (&tb)[4], const f32x16& acc) {
#pragma unroll
    for (int i = 0; i < 16; i += 2) { const unsigned w = cvt_pk_bf16(acc[i], acc[i + 1]); D[tb[i >> 2] + TOFF(i)] = (bf16_t)(w & 0xffffu); D[tb[i >> 2] + TOFF(i + 1)] = (bf16_t)(w >> 16); }
}
__device__ __forceinline__ void st_tile(LAS bf16_t* D, int row0, int col0, const f32x16& acc, int lane) { int tb[4]; tile_base(row0, col0, lane, tb); st_tile_tb(D, tb, acc); }
__device__ __forceinline__ void write_permuted(const LAS bf16_t* X, unsigned char* dst, int tid) {
    const int tmq = tid >> 6, lane = tid & 63, tm = tmq >> 2, q = tmq & 3, r = lane & 31, hb = lane >> 5;
    const u32x2 lo = *(const LAS u32x2*)(X + mi(32 * tm + r, 16 * q + 4 * hb)), hi = *(const LAS u32x2*)(X + mi(32 * tm + r, 16 * q + 8 + 4 * hb));
    *(u32x4*)(dst + (size_t)tid * 16) = (u32x4){lo.x, lo.y, hi.x, hi.y};
}

struct RaIn { u32x4 x[9]; u32x4 a[4]; };
__device__ __forceinline__ void ra_unit_decode(int u, int bh, int& c, int& d, int& h, int& b) { c = u % NCHAIN; d = (u / NCHAIN) & 1; h = (u / (2 * NCHAIN)) & 7; b = bh * 4 + u / (16 * NCHAIN); }
__device__ __forceinline__ void ra_prefetch(RaIn& in, const bf16_t* RKV, const bf16_t* LORA, int u, int bh, int tid, int w, int lane) {
    int c, d, h, b; ra_unit_decode(u, bh, c, d, h, b);
    const int rowbase = chain_row(b, d, c); const bool isc = c < 4;
    const int s = tid >> 3, cg = tid & 7, t = d ? 63 - s : s, hc = h * 64 + cg * 8; const size_t row = (size_t)rowbase + t;
    bool lo = t > 0, hi = t < 63;
    if (isc) { const int tt = rowbase - (ML + b * CTXL) + t; lo = tt > 0; hi = tt < CTXL - 1; }
    const u32x4 z = (u32x4){0u, 0u, 0u, 0u};
#pragma unroll
    for (int sec = 0; sec < 3; ++sec) { const bf16_t* p = RKV + row * 1536 + sec * 512 + hc;
        const u32x4 xm = *(const u32x4*)(lo ? p - 1536 : p), xp = *(const u32x4*)(hi ? p + 1536 : p);
        in.x[sec * 3 + 0] = *(const u32x4*)p; in.x[sec * 3 + 1] = lo ? xm : z; in.x[sec * 3 + 2] = hi ? xp : z; }
    const int r = lane & 31, hb = lane >> 5, which = w >> 2, tm = (w >> 1) & 1, sp = 32 * tm + r, tp = d ? 63 - sp : sp;
    const bf16_t* ap = LORA + (size_t)(rowbase + tp) * 256 + which * 128 + d * 64 + 8 * hb;
#pragma unroll
    for (int q = 0; q < 4; ++q) in.a[q] = *(const u32x4*)(ap + 16 * q);
}
__device__ __forceinline__ void conv8_raw(const u32x4 x0v, const u32x4 xmv, const u32x4 xpv, int col, const float* cw, int cwld, float (&y)[8]) {
    f32x4 a0, a1, m0, m1, p0, p1; unpack8(x0v, a0, a1); unpack8(xmv, m0, m1); unpack8(xpv, p0, p1);
    float w0[8], w1[8], w2[8]; ld8f(cw + col, w0); ld8f(cw + cwld + col, w1); ld8f(cw + 2 * cwld + col, w2);
#pragma unroll
    for (int i = 0; i < 4; ++i) { y[i] = w0[i] * m0[i] + w1[i] * a0[i] + w2[i] * p0[i]; y[4 + i] = w0[4 + i] * m1[i] + w1[4 + i] * a1[i] + w2[4 + i] * p1[i]; }
}
__device__ __forceinline__ void conv8_lds(const u32x4 x0v, const u32x4 xmv, const u32x4 xpv, const LAS float* w, int cg, float (&y)[8]) {
    f32x4 a0, a1, m0, m1, p0, p1; unpack8(x0v, a0, a1); unpack8(xmv, m0, m1); unpack8(xpv, p0, p1);
    float w0[8], w1[8], w2[8]; lds_ld8(w + cg * 8, w0); lds_ld8(w + 64 + cg * 8, w1); lds_ld8(w + 128 + cg * 8, w2);
#pragma unroll
    for (int i = 0; i < 4; ++i) { y[i] = w0[i] * m0[i] + w1[i] * a0[i] + w2[i] * p0[i]; y[4 + i] = w0[4 + i] * m1[i] + w1[4 + i] * a1[i] + w2[4 + i] * p1[i]; }
}
__device__ __forceinline__ void phase_rwkv_chunkA(const Frame& F, const KA& P, int l, int bh) {
#define MAT(i) ((LAS bf16_t*)(F.lds + (i) * MSZ))
    LAS float* AAB = (LAS float*)(F.lds + 12 * MSZ);
    LAS float* PTl = AAB + 64 * 68;
    LAS float* LW = (LAS float*)(F.lds + 8 * MSZ);
    LAS float* CP = LW + 4096; LAS float* AS = CP + 4096; LAS float* SEG = AS + 4096; LAS float* SEGX = SEG + 512;
    const bf16_t* RKV = (const bf16_t*)(P.ws() + WS_RKV); const bf16_t* LORA = (const bf16_t*)(P.ws() + WS_LORA);
    bf16_t* YD = (bf16_t*)(P.ws() + WS_YD); float* CBON = (float*)(P.ws() + WS_CBON);
    const float* cw = P.in(I_RWCONV) + (size_t)l * 3 * 1536;
    const int w = F.wave;
    RaIn rin;
    const int hh = F.bid & 7, slot = F.bid >> 3, nslot = F.G >> 3; constexpr int NPH = 4 * 2 * NCHAIN;
    LAS float* WT = (LAS float*)(F.lds + 128512);
    for (int i = F.tid; i < 768; i += NTHR) { float v;
        if (i < 576) { const int sec = i / 192, tap = (i / 64) % 3, ch = i & 63; v = cw[tap * 1536 + sec * 512 + hh * 64 + ch]; }
        else { const int which = (i - 576) >> 6, ch = i & 63; v = (which == 0 ? P.in(I_RWKK) : which == 1 ? P.in(I_RWKA) : P.in(I_RWRK))[l * 512 + hh * 64 + ch]; }
        WT[i] = v; }
#define RA_UNIT_OF(idx) (((((idx) / (2 * NCHAIN)) * 8 + hh) * 2 + (((idx) / NCHAIN) & 1)) * NCHAIN + (idx) % NCHAIN)
    if (slot < NPH) { const int l0 = fresh_lane(); ra_prefetch(rin, RKV, LORA, RA_UNIT_OF(slot), bh, w * 64 + l0, w, l0); }
    for (int uidx = slot; uidx < NPH; uidx += nslot) {
        const int u = RA_UNIT_OF(uidx);
        const int lane = fresh_lane(), tid = w * 64 + lane, r = lane & 31, hb = lane >> 5;
        const int c = u % NCHAIN, d = (u / NCHAIN) & 1, h = (u / (2 * NCHAIN)) & 7, b = bh * 4 + u / (16 * NCHAIN);
        const int rowbase = chain_row(b, d, c); const bool isc = c < 4;
        unsigned char* ra = P.ws() + WS_RA + (size_t)u * RA_UNIT;
        __syncthreads();
        const int p2_which = w >> 2, p2_tm = (w >> 1) & 1, p2_tn = w & 1;
        u32x4 p2a[4], p2b[4]; float p2bias;
        { const int sp = 32 * p2_tm + r, tp = d ? 63 - sp : sp;
          (void)tp;
          const bf16_t* bp = (const bf16_t*)(P.ws() + WS_W_LORA) + ((size_t)((l * 2 + d) * 2 + p2_which) * 512 + h * 64 + 32 * p2_tn + r) * 64 + 8 * hb;
#pragma unroll
          for (int q = 0; q < 4; ++q) { p2a[q] = rin.a[q]; p2b[q] = *(const u32x4*)(bp + 16 * q); }
          p2bias = (p2_which ? P.in(I_RWA0) : P.in(I_RWW0))[(l * 2 + d) * 512 + h * 64 + 32 * p2_tn + r]; }
        const int s = tid >> 3, cg = tid & 7, t = d ? 63 - s : s, hc = h * 64 + cg * 8; const size_t row = (size_t)rowbase + t;
        float kkw[8], kaw[8], rkw[8]; lds_ld8(WT + 576 + cg * 8, kkw); lds_ld8(WT + 640 + cg * 8, kaw); lds_ld8(WT + 704 + cg * 8, rkw);
        bool lo = t > 0, hi = t < 63;
        if (isc) { const int tt = rowbase - (ML + b * CTXL) + t; lo = tt > 0; hi = tt < CTXL - 1; }
        float r8[8], k8[8], kk[8];
        { float v8[8]; conv8_lds(rin.x[6], rin.x[7], rin.x[8], WT + 384, cg, v8);
#pragma unroll
          for (int i = 0; i < 8; ++i) MAT(5)[mi(cg * 8 + i, s)] = f2bf(v8[i]); }
        conv8_lds(rin.x[0], rin.x[1], rin.x[2], WT, cg, r8); conv8_lds(rin.x[3], rin.x[4], rin.x[5], WT + 192, cg, k8);
        (void)lo; (void)hi;
        { float ss = 0.f;
#pragma unroll
          for (int i = 0; i < 8; ++i) { kk[i] = k8[i] * kkw[i]; ss += kk[i] * kk[i]; }
          ss = red8(ss); const float inv = rsqrtf(fmaxf(ss, 1e-24f));
#pragma unroll
          for (int i = 0; i < 8; ++i) kk[i] *= inv; }
        { const int which = p2_which, tm = p2_tm, tn = p2_tn;
          f32x16 acc;
#pragma unroll
          for (int i = 0; i < 16; ++i) acc[i] = 0.f;
#pragma unroll
          for (int q = 0; q < 4; ++q) acc = __builtin_amdgcn_mfma_f32_32x32x16_bf16(as_bf16x8(p2a[q]), as_bf16x8(p2b[q]), acc, 0, 0, 0);
          const float bias = p2bias;
          LAS float* dst = which ? AS : LW;
          LAS float* dp = dst + (32 * tm + 4 * hb) * 64 + 32 * tn + r;
          if (which) {
#pragma unroll
              for (int i = 0; i < 16; ++i) dp[(8 * (i >> 2) + (i & 3)) * 64] = sigmoidf_(acc[i] + bias);
          } else {
#pragma unroll
              for (int i = 0; i < 16; ++i) dp[(8 * (i >> 2) + (i & 3)) * 64] = -0.60653066f * sigmoidf_(acc[i] + bias); } }
        asm volatile("" ::: "memory");
        { const int un = (uidx + nslot < NPH) ? RA_UNIT_OF(uidx + nslot) : u;
          ra_prefetch(rin, RKV, LORA, un, bh, tid, w, lane); }
        __syncthreads();
        { const int k = tid & 63, seg = tid >> 6; float p = 0.f;
#pragma unroll
          for (int i = 0; i < 8; ++i) { p += LW[(8 * seg + i) * 64 + k]; CP[(8 * seg + i) * 64 + k] = p; }
          SEG[seg * 64 + k] = p; }
        __syncthreads();
        if (w == 0) { float a = 0.f;
#pragma unroll
          for (int g = 0; g < 8; ++g) { SEGX[g * 64 + lane] = a; a += SEG[g * 64 + lane]; }
          SEGX[512 + lane] = a; PTl[lane] = __expf(a); }
        __syncthreads();
        { float lw[8], cp[8], as[8], off[8], tot[8];
          lds_ld8(LW + s * 64 + cg * 8, lw); lds_ld8(CP + s * 64 + cg * 8, cp); lds_ld8(AS + s * 64 + cg * 8, as);
          lds_ld8(SEGX + (s >> 3) * 64 + cg * 8, off); lds_ld8(SEGX + 512 + cg * 8, tot);
          float at[8], rt[8], bt[8], kt[8], bhv[8], khv[8]; float cb = 0.f;
#pragma unroll
          for (int i = 0; i < 8; ++i) { const float cum = cp[i] + off[i]; const float e2 = __expf(cum), e1 = __expf(cum - lw[i]), e3 = __expf(-cum), e4 = __expf(tot[i] - cum);
              const float kd = k8[i] * (1.0f + (as[i] - 1.0f) * kaw[i]), bb = kk[i] * as[i];
              at[i] = -kk[i] * e1; rt[i] = r8[i] * e2; bt[i] = bb * e3; kt[i] = kd * e3; bhv[i] = bb * e4; khv[i] = kd * e4; cb += r8[i] * rkw[i] * kd;
              }
          *(LAS u32x4*)(MAT(0) + mi(s, cg * 8)) = pack8((f32x4){at[0], at[1], at[2], at[3]}, (f32x4){at[4], at[5], at[6], at[7]});
          *(LAS u32x4*)(MAT(1) + mi(s, cg * 8)) = pack8((f32x4){rt[0], rt[1], rt[2], rt[3]}, (f32x4){rt[4], rt[5], rt[6], rt[7]});
          *(LAS u32x4*)(MAT(6) + mi(s, cg * 8)) = pack8((f32x4){bt[0], bt[1], bt[2], bt[3]}, (f32x4){bt[4], bt[5], bt[6], bt[7]});
          *(LAS u32x4*)(MAT(7) + mi(s, cg * 8)) = pack8((f32x4){kt[0], kt[1], kt[2], kt[3]}, (f32x4){kt[4], kt[5], kt[6], kt[7]});
#pragma unroll
          for (int i = 0; i < 8; ++i) { MAT(2)[mi(cg * 8 + i, s)] = f2bf(at[i]); MAT(3)[mi(cg * 8 + i, s)] = f2bf(bhv[i]); MAT(4)[mi(cg * 8 + i, s)] = f2bf(khv[i]); }
          cb = red8(cb);
          if (cg == 0) CBON[((size_t)d * MT + row) * 8 + h] = cb; }
        __syncthreads();
        { const int am = w >> 1, tm = w & 1;
          const LAS bf16_t* A = (am < 2) ? MAT(0) : MAT(1); const LAS bf16_t* B = (am & 1) ? MAT(7) : MAT(6);
#pragma unroll
          for (int tn = 0; tn < 2; ++tn) {
              f32x16 acc;
#pragma unroll
              for (int i = 0; i < 16; ++i) acc[i] = 0.f;
              if (!(tm == 0 && tn == 1)) mm_tile(acc, A, 32 * tm, B, 32 * tn, lane, 0, 4);
              const int dl = 32 * tn + r - (32 * tm + 4 * hb) - ((am < 2) ? 0 : 1);
              if (am == 0) { LAS float* dp = AAB + (32 * tn + r) * 68 + 8 * tm + hb;
#pragma unroll
                  for (int i = 0; i < 16; ++i) { const int ci = 8 * (i >> 2) + (i & 3); dp[(i & 3) * 16 + 2 * (i >> 2)] = (dl < ci) ? acc[i] : 0.f; }
              } else { int tb[4]; tile_base(32 * tm, 32 * tn, lane, tb); f32x16 mv;
#pragma unroll
                  for (int i = 0; i < 16; ++i) { const int ci = 8 * (i >> 2) + (i & 3); mv[i] = (dl < ci) ? acc[i] : 0.f; }
                  st_tile_tb(MAT(7 + am), tb, mv); } } }
        __syncthreads();
        f32x16 pre_y, pre_s;
        { float z = 0.f; asm volatile("" : "+v"(z)); pre_y = (f32x16){z, z, z, z, z, z, z, z, z, z, z, z, z, z, z, z}; pre_s = pre_y; }
        if (w < 4) {
            const int cc = tid >> 2, jq = tid & 3; float x[16];
#pragma unroll
            for (int i = 0; i < 16; ++i) x[i] = (4 * i + jq == cc) ? 1.0f : 0.f;
            const LAS float* ap = AAB + jq * 16;
#pragma unroll
            for (int g = 0; g < 16; ++g) {
#pragma unroll
                for (int k = 0; k < 4; ++k) {
                    if (g == 15 && k == 3) continue;
                    const int sst = 4 * g + k;
                    f32x4 a[4];
#pragma unroll
                    for (int q = 0; q < 4; ++q) if (q >= (g >> 2)) a[q] = *(const LAS f32x4*)(ap + sst * 68 + 4 * q);
                    float xs;
                    if (k == 0) xs = dpp_f<0x00>(x[g]); else if (k == 1) xs = dpp_f<0x55>(x[g]); else if (k == 2) xs = dpp_f<0xAA>(x[g]); else xs = dpp_f<0xFF>(x[g]);
#pragma unroll
                    for (int i = 0; i < 16; ++i) if (i >= g) x[i] = fmaf(a[i >> 2][i & 3], xs, x[i]);
                }
            }
#pragma unroll
            for (int i = 0; i < 16; ++i) MAT(11)[mi(4 * i + jq, cc)] = f2bf(x[i]);
        } else {
            const int tm = (w - 4) >> 1, tn = (w - 4) & 1; f32x16 acc;
#pragma unroll
            for (int i = 0; i < 16; ++i) acc[i] = 0.f;
            mm_tile(acc, MAT(8), 32 * tm, MAT(5), 32 * tn, lane, 0, tm ? 4 : 2);
            st_tile_T(MAT(6), 32 * tn, 32 * tm, acc, lane);
#pragma unroll
            for (int i = 0; i < 16; ++i) { pre_y[i] = 0.f; pre_s[i] = 0.f; }
            mm_tile(pre_y, MAT(10), 32 * tm, MAT(5), 32 * tn, lane, 0, tm ? 4 : 2);
            mm_tile(pre_s, MAT(4), 32 * tm, MAT(5), 32 * tn, lane, 0, 4);
        }
        __syncthreads();
        { const int tm = w & 1, tn = w >> 1; f32x16 acc;
#pragma unroll
          for (int i = 0; i < 16; ++i) acc[i] = 0.f;
          mm_tile(acc, MAT(11), 32 * tm, (tn < 2) ? MAT(2) : MAT(6), 32 * (tn & 1), lane, 0, tm ? 4 : 2);
          st_tile_T((tn < 2) ? MAT(7) : MAT(8), 32 * (tn & 1), 32 * tm, acc, lane); }
        __syncthreads();
        if (w < 4) { const int tm = w >> 1, tn = w & 1; f32x16 acc; int tb[4]; tile_base(32 * tm, 32 * tn, lane, tb);
#pragma unroll
            for (int i = 0; i < 16; ++i) acc[i] = bf2f(MAT(1)[tb[i >> 2] + TOFF(i)]);
            mm_tile(acc, MAT(9), 32 * tm, MAT(7), 32 * tn, lane, 0, tm ? 4 : 2);
            st_tile_tb(MAT(11), tb, acc);
        } else { const int tm = (w - 4) >> 1, tn = (w - 4) & 1; f32x16 acc = pre_y;
            mm_tile(acc, MAT(9), 32 * tm, MAT(8), 32 * tn, lane, 0, tm ? 4 : 2);
            u32x4* yd = (u32x4*)((unsigned char*)YD + (size_t)u * 8192 + (size_t)((tm * 2 + tn) * 64 + lane) * 32);
            yd[0] = pack8((f32x4){acc[0], acc[1], acc[2], acc[3]}, (f32x4){acc[4], acc[5], acc[6], acc[7]});
            yd[1] = pack8((f32x4){acc[8], acc[9], acc[10], acc[11]}, (f32x4){acc[12], acc[13], acc[14], acc[15]});
        }
        if (w < 4) { const int tm = w >> 1, tn = w & 1; f32x16 acc;
#pragma unroll
            for (int i = 0; i < 16; ++i) acc[i] = 0.f;
            mm_tile(acc, MAT(3), 32 * tm, MAT(7), 32 * tn, lane, 0, 4);
            st_tile(MAT(10), 32 * tm, 32 * tn, acc, lane);
        } else { const int tm = (w - 4) >> 1, tn = (w - 4) & 1; f32x16 acc = pre_s;
            mm_tile(acc, MAT(3), 32 * tm, MAT(8), 32 * tn, lane, 0, 4);
#ifdef DBG_NANQ
            { float z = 0.f;
#pragma unroll
              for (int i = 0; i < 16; ++i) {
                  if (DBG_NANQ & 1) z += 0.f * bf2f(MAT(11)[mi(32 * tm + acc_row(i, hb), 32 * tn + r)]);
                  if (DBG_NANQ & 2) z += 0.f * acc[i];
              }
              const int ss0 = 32 * tm + acc_row(0, hb), tt0 = d ? 63 - ss0 : ss0;
              bf16_t* yq = YD + ((size_t)d * MT + rowbase + tt0) * 512 + h * 64 + 32 * tn + r; *yq = f2bf(bf2f(*yq) + z); }
#endif
            u32x4* dst = (u32x4*)(ra + 16384 + ((size_t)((tn * 2 + tm) * 64 + lane)) * 32);
            dst[0] = pack8((f32x4){acc[0], acc[1], acc[2], acc[3]}, (f32x4){acc[4], acc[5], acc[6], acc[7]});
            dst[1] = pack8((f32x4){acc[8], acc[9], acc[10], acc[11]}, (f32x4){acc[12], acc[13], acc[14], acc[15]});
        }
        __syncthreads();
        write_permuted(MAT(11), ra, tid);
        write_permuted(MAT(10), ra + 8192, tid);
        if (tid < 64) ((float*)(ra + 24576))[tid] = PTl[tid];
    }
    __syncthreads();
#undef MAT
#undef RA_UNIT_OF
}
constexpr int RB_SLOT = 12800, RB_RING = 12288, RB_NSLOT = 8;
__device__ __forceinline__ void rb_spin(volatile LAS int* w, int need) { unsigned spins = 0; while (*w < need) { __builtin_amdgcn_s_sleep(1); if (++spins > (1u << 22)) break; } asm volatile("" ::: "memory"); }
struct RbOps { u32x4 ogm[2], ogo[2], osl[2]; f32x4 opt[4]; };
__device__ __forceinline__ void rb_read_ops(RbOps& o, const LAS unsigned char* slot, int tk, int lane, int hb) {
#pragma unroll
    for (int s2 = 0; s2 < 2; ++s2) { o.ogm[s2] = *(const LAS u32x4*)(slot + ((tk * 4 + 2 * tk + s2) * 64 + lane) * 16); o.ogo[s2] = *(const LAS u32x4*)(slot + ((tk * 4 + 2 * (1 - tk) + s2) * 64 + lane) * 16); }
    o.osl[0] = *(const LAS u32x4*)(slot + 8192 + (tk * 64 + lane) * 32); o.osl[1] = *(const LAS u32x4*)(slot + 8192 + (tk * 64 + lane) * 32 + 16);
#pragma unroll
    for (int g = 0; g < 4; ++g) o.opt[g] = *(const LAS f32x4*)(slot + 12288 + (32 * tk + 8 * g + 4 * hb) * 4);
}
__device__ __forceinline__ void rb_spin_fast(volatile LAS int* w, int need) { unsigned spins = 0; while (*w < need) { if (++spins > (1u << 24)) break; } asm volatile("" ::: "memory"); }
__device__ __forceinline__ void phase_rwkv_chunkB(const Frame& F, const KA& P, int bh) {
    LAS unsigned char* xb = F.lds;
    volatile LAS int* flg = (volatile LAS int*)(F.lds + 8192);
    if (F.tid < 16) flg[F.tid] = 0;
    __syncthreads();
    const int lane = F.lane, hb = lane >> 5, w = F.wave;
    const int ci = F.bid;
    float z = 0.f; asm volatile("" : "+v"(z));
    f32x16 S = (f32x16){z, z, z, z, z, z, z, z, z, z, z, z, z, z, z, z};
    if (ci < 128) {
    const int bl = ci >> 5, h = (ci >> 2) & 7, d = (ci >> 1) & 1, vh = ci & 1;
    const size_t u0 = (size_t)(((bl * 8 + h) * 2 + d) * NCHAIN);
    const unsigned char* ra = P.ws() + WS_RA + u0 * RA_UNIT;
    if (w >= 2) {
        for (int c = w - 2; c < NCHAIN; c += 6) {
            if (c >= RB_NSLOT) { rb_spin(flg + 10, c - RB_NSLOT + 1); rb_spin(flg + 11, c - RB_NSLOT + 1); }
            const unsigned char* src = ra + (size_t)c * RA_UNIT;
            u32x4 g[8], s4[4];
#pragma unroll
            for (int i = 0; i < 8; ++i) g[i] = *(const u32x4*)(src + 8192 + (size_t)(i * 64 + lane) * 16);
#pragma unroll
            for (int tk = 0; tk < 2; ++tk) { const u32x4* sl = (const u32x4*)(src + 16384 + (size_t)((vh * 2 + tk) * 64 + lane) * 32); s4[2 * tk] = sl[0]; s4[2 * tk + 1] = sl[1]; }
            const float ptv = ((const float*)(src + 24576))[lane];
            LAS unsigned char* slot = F.lds + RB_RING + (c & (RB_NSLOT - 1)) * RB_SLOT;
#pragma unroll
            for (int i = 0; i < 8; ++i) *(LAS u32x4*)(slot + (i * 64 + lane) * 16) = g[i];
#pragma unroll
            for (int tk = 0; tk < 2; ++tk) { *(LAS u32x4*)(slot + 8192 + (tk * 64 + lane) * 32) = s4[2 * tk]; *(LAS u32x4*)(slot + 8192 + (tk * 64 + lane) * 32 + 16) = s4[2 * tk + 1]; }
            *(LAS float*)(slot + 12288 + lane * 4) = ptv;
            asm volatile("s_waitcnt lgkmcnt(0)" ::: "memory");
            if (lane == 0) flg[c & (RB_NSLOT - 1)] = c + 1;
        }
    } else {
    const int tk = w;
    unsigned char* sc = P.ws() + WS_SC + (u0 * 2 + vh) * 4096;
    S = (f32x16){z, z, z, z, z, z, z, z, z, z, z, z, z, z, z, z};
    RbOps opA, opB;
    rb_spin(flg + 0, 1); rb_read_ops(opA, F.lds + RB_RING, tk, lane, hb);
    asm volatile("s_waitcnt lgkmcnt(0)" ::: "memory");
    if (lane == 0) flg[10 + tk] = 1;
#define RB_STEP(cc, CUR, NXT) do { const int c_ = (cc); \
        u32x4 mine[2], other[2]; LAS u32x4* buf = (LAS u32x4*)(xb + (c_ & 1) * 4096); unsigned char* scc = sc + (size_t)c_ * 8192; \
        _Pragma("unroll") for (int s2 = 0; s2 < 2; ++s2) { const int b0 = 8 * s2, q = 2 * tk + s2; \
            const u32x4 wv = (u32x4){cvt_pk_bf16(S[b0], S[b0 + 1]), cvt_pk_bf16(S[b0 + 2], S[b0 + 3]), cvt_pk_bf16(S[b0 + 4], S[b0 + 5]), cvt_pk_bf16(S[b0 + 6], S[b0 + 7])}; \
            mine[s2] = wv; buf[q * 64 + lane] = wv; *(u32x4*)(scc + (size_t)(q * 64 + lane) * 16) = wv; } \
        asm volatile("s_waitcnt lgkmcnt(0)" ::: "memory");                \
        if (lane == 0) flg[8 + tk] = c_ + 1; \
        f32x4 a0, a1, a2, a3; unpack8(CUR.osl[0], a0, a1); unpack8(CUR.osl[1], a2, a3); \
        f32x16 n; \
        _Pragma("unroll") for (int i = 0; i < 4; ++i) { n[i] = a0[i] + CUR.opt[0][i] * S[i]; n[4 + i] = a1[i] + CUR.opt[1][i] * S[4 + i]; n[8 + i] = a2[i] + CUR.opt[2][i] * S[8 + i]; n[12 + i] = a3[i] + CUR.opt[3][i] * S[12 + i]; } \
        _Pragma("unroll") for (int s2 = 0; s2 < 2; ++s2) n = __builtin_amdgcn_mfma_f32_32x32x16_bf16(as_bf16x8(CUR.ogm[s2]), as_bf16x8(mine[s2]), n, 0, 0, 0);     \
        if (c_ + 1 < NCHAIN) { rb_spin(flg + ((c_ + 1) & (RB_NSLOT - 1)), c_ + 2); rb_read_ops(NXT, F.lds + RB_RING + ((c_ + 1) & (RB_NSLOT - 1)) * RB_SLOT, tk, lane, hb); } \
        rb_spin_fast(flg + 8 + (1 - tk), c_ + 1); \
        _Pragma("unroll") for (int s2 = 0; s2 < 2; ++s2) { const int q = 2 * (1 - tk) + s2; other[s2] = buf[q * 64 + lane]; } \
        _Pragma("unroll") for (int s2 = 0; s2 < 2; ++s2) n = __builtin_amdgcn_mfma_f32_32x32x16_bf16(as_bf16x8(CUR.ogo[s2]), as_bf16x8(other[s2]), n, 0, 0, 0); \
        S = n; \
        asm volatile("s_waitcnt lgkmcnt(0)" ::: "memory");                \
        if (lane == 0) flg[10 + tk] = c_ + 2; \
    } while (0)
#pragma unroll 1
    for (int c = 0; c < NCHAIN; c += 2) { RB_STEP(c, opA, opB); RB_STEP(c + 1, opB, opA); }
#undef RB_STEP
    } }
}
struct RcIn { u32x4 yv[2]; u32x4 q[4]; u32x4 s[4]; };
__device__ __forceinline__ void rc_prefetch(RcIn& in, const KA& P, const bf16_t* YD, int u, int bh, int w, int lane) {
    const int r = lane & 31, hb = lane >> 5;
    const int tc = u % NCHAIN, h = (u / NCHAIN) & 7, bl = u / (8 * NCHAIN), b = bh * 4 + bl;
    const bool isc = tc < 4; const int j = isc ? tc : tc - 4; const int rowbase = isc ? ML + b * CTXL + 64 * j : b * SEQL + 64 * j;
    const int d = w >> 2, vh = (w >> 1) & 1, tm = w & 1;
    const int c = isc ? (d ? 3 - j : j) : (d ? 67 - j : 4 + j);
    const size_t uu = (size_t)(((bl * 8 + h) * 2 + d) * NCHAIN + c);
    const unsigned char* ra = P.ws() + WS_RA + uu * RA_UNIT; const unsigned char* sc = P.ws() + WS_SC + (uu * 2 + vh) * 4096;
    { const u32x4* yd = (const u32x4*)((const unsigned char*)YD + uu * 8192 + (size_t)((tm * 2 + vh) * 64 + lane) * 32); in.yv[0] = yd[0]; in.yv[1] = yd[1]; }
#pragma unroll
    for (int q = 0; q < 4; ++q) { in.q[q] = *(const u32x4*)(ra + (size_t)((tm * 4 + q) * 64 + lane) * 16); in.s[q] = *(const u32x4*)(sc + (size_t)(q * 64 + lane) * 16); }
}
__device__ __forceinline__ void phase_rwkv_chunkC(const Frame& F, const KA& P, int l, int bh, bool dummy = false) {
    constexpr int YP = 68;
    LAS float* Ys = (LAS float*)F.lds;
    const bf16_t* RKV = (const bf16_t*)(P.ws() + WS_RKV); const bf16_t* YD = (const bf16_t*)(P.ws() + WS_YD); const bf16_t* RWG = (const bf16_t*)(P.ws() + WS_RWG);
    const float* CBON = (const float*)(P.ws() + WS_CBON); bf16_t* RWOUT = (bf16_t*)(P.ws() + WS_RWOUT);
    const float* cw = P.in(I_RWCONV) + (size_t)l * 3 * 1536;
    const int w = F.wave;
    RcIn cin;
    const int hh = F.bid & 7, slot = F.bid >> 3, nslot = F.G >> 3; constexpr int NPH = 4 * NCHAIN;
    LAS float* WT = (LAS float*)(F.lds + 36864);
    for (int i = F.tid; i < 320; i += NTHR) { const int ch = i & 63;
        WT[i] = (i < 192) ? cw[(i >> 6) * 1536 + 1024 + hh * 64 + ch] : (i < 256) ? P.in(I_RWLNW)[l * 512 + hh * 64 + ch] : P.in(I_RWLNB)[l * 512 + hh * 64 + ch]; }
    __syncthreads();
#define RC_UNIT_OF(idx) ((((idx) / NCHAIN) * 8 + hh) * NCHAIN + (idx) % NCHAIN)
    if (slot < NPH) rc_prefetch(cin, P, YD, RC_UNIT_OF(slot), bh, w, fresh_lane());
    for (int uidx = slot; uidx < NPH; uidx += nslot) {
        const int u = RC_UNIT_OF(uidx);
        const int lane = fresh_lane(), tid = w * 64 + lane, r = lane & 31, hb = lane >> 5;
        const int tc = u % NCHAIN, h = (u / NCHAIN) & 7, bl = u / (8 * NCHAIN), b = bh * 4 + bl;
        const bool isc = tc < 4; const int j = isc ? tc : tc - 4; const int rowbase = isc ? ML + b * CTXL + 64 * j : b * SEQL + 64 * j;
        const int ft = tid >> 3, fcg = tid & 7, fhc = h * 64 + fcg * 8; const size_t frow = (size_t)rowbase + ft;
        float v8[8], lnw[8], lnb[8], g8[8]; float cb;
        { bool lo = ft > 0, hi = ft < 63;
          if (isc) { const int tt = rowbase - (ML + b * CTXL) + ft; lo = tt > 0; hi = tt < CTXL - 1; }
          { float x0[8], xm[8], xp[8], w0[8], w1[8], w2[8];
            ld8bf(RKV + frow * 1536 + 1024 + fhc, x0);
            if (lo) ld8bf(RKV + (frow - 1) * 1536 + 1024 + fhc, xm); else { for (int i = 0; i < 8; ++i) xm[i] = 0.f; }
            if (hi) ld8bf(RKV + (frow + 1) * 1536 + 1024 + fhc, xp); else { for (int i = 0; i < 8; ++i) xp[i] = 0.f; }
            lds_ld8(WT + fcg * 8, w0); lds_ld8(WT + 64 + fcg * 8, w1); lds_ld8(WT + 128 + fcg * 8, w2);
#pragma unroll
            for (int i = 0; i < 8; ++i) v8[i] = w0[i] * xm[i] + w1[i] * x0[i] + w2[i] * xp[i]; }
          cb = CBON[frow * 8 + h] + CBON[((size_t)MT + frow) * 8 + h];
          lds_ld8(WT + 192 + fcg * 8, lnw); lds_ld8(WT + 256 + fcg * 8, lnb); ld8bf(RWG + frow * 512 + fhc, g8); }
        __syncthreads();
        { const int d = w >> 2, vh = (w >> 1) & 1, tm = w & 1;
          f32x16 y;
#pragma unroll
          for (int i = 0; i < 1; ++i) { f32x4 y0, y1, y2, y3; unpack8(cin.yv[0], y0, y1); unpack8(cin.yv[1], y2, y3);
#pragma unroll
              for (int k = 0; k < 4; ++k) { y[k] = y0[k]; y[4 + k] = y1[k]; y[8 + k] = y2[k]; y[12 + k] = y3[k]; } }
#pragma unroll
          for (int q = 0; q < 4; ++q) y = __builtin_amdgcn_mfma_f32_32x32x16_bf16(as_bf16x8(cin.q[q]), as_bf16x8(cin.s[q]), y, 0, 0, 0);
          rc_prefetch(cin, P, YD, (uidx + nslot < NPH) ? RC_UNIT_OF(uidx + nslot) : u, bh, w, lane);
          { LAS float* yp0 = Ys + (d * 64 + (d ? 63 - 32 * tm - 4 * hb : 32 * tm + 4 * hb)) * YP + 32 * vh + r; const int ys = d ? -YP : YP;
#pragma unroll
            for (int i = 0; i < 16; ++i) yp0[(8 * (i >> 2) + (i & 3)) * ys] = y[i]; } }
        __syncthreads();
        { const int t = ft, cg = fcg, hc = fhc; const size_t row = frow;
          float wk[8], a1[8];
          lds_ld8(Ys + t * YP + cg * 8, wk); lds_ld8(Ys + (64 + t) * YP + cg * 8, a1);
          float s = 0.f;
#pragma unroll
          for (int i = 0; i < 8; ++i) { wk[i] += a1[i]; s += wk[i]; }
          const float mu = red8(s) * (1.0f / 64.0f); float q2 = 0.f;
#pragma unroll
          for (int i = 0; i < 8; ++i) { const float dd = wk[i] - mu; q2 += dd * dd; }
          const float rstd = rsqrtf(red8(q2) * (1.0f / 64.0f) + 64e-5f);
          f32x4 o0, o1;
#pragma unroll
          for (int i = 0; i < 4; ++i) { o0[i] = ((wk[i] - mu) * rstd * lnw[i] + lnb[i] + cb * v8[i]) * g8[i]; o1[i] = ((wk[4 + i] - mu) * rstd * lnw[4 + i] + lnb[4 + i] + cb * v8[4 + i]) * g8[4 + i]; }
          if (dummy) *(u32x4*)((bf16_t*)(P.ws() + WS_U) + (row & 16383) * 512 + hc) = pack8(o0, o1);
          else *(u32x4*)(RWOUT + row * 512 + hc) = pack8(o0, o1); }
    }
    __syncthreads();
}

#ifndef PROBE
#define PROBE 0
#endif
#define PREP(k) for (int _rep = 0; _rep < ((PROBE == (k)) ? 2 : 1); ++_rep)
#ifndef GEN
#define GEN 0xffffffff
#endif
#ifndef EN
#define EN 0xffffffff
#endif
#ifndef MK_PER_PHASE
#define MK_PER_PHASE 0
#endif
constexpr int MAX_PHASES = 35;

__device__ __forceinline__ void ka_opq(KA& P, Frame& F, int& ph) { asm volatile("" : "+s"(P.p), "+s"(F.wave), "+s"(F.bid), "+s"(F.G), "+s"(ph)); F.gw = F.bid * NWAVES + F.wave; F.NGW = F.G * NWAVES; }
__global__ void __launch_bounds__(NTHR, 2) mega_fwd(Params P_unused) {
    KA P; P.p = (const CAS unsigned char*)__builtin_amdgcn_kernarg_segment_ptr();
    extern __shared__ __attribute__((aligned(16))) unsigned char lds_raw[];
    Frame F; F.lds = (LAS unsigned char*)lds_raw;
    F.wave = __builtin_amdgcn_readfirstlane((int)threadIdx.x >> 6); F.lane = fresh_lane(); F.tid = F.wave * 64 + F.lane; F.bid = blockIdx.x; F.G = gridDim.x; F.gw = F.bid * NWAVES + F.wave; F.NGW = F.G * NWAVES;
    #define ws (P.ws())
    if (F.tid == 0) *(LAS u32x4*)(F.lds + LDS_XB) = (u32x4){0u, 0u, 0u, 0u};
    __syncthreads();
    XcdBarrier bar; bar.bar = (unsigned*)(ws + WS_CTL) + CW_BAR; bar.x = 0; bar.st = nullptr;
    const bool use_bar = (P.ph_hi() - P.ph_lo()) > 1;
    if (use_bar) bar = xcd_barrier_post((unsigned*)(ws + WS_CTL) + CW_BAR, (volatile LAS unsigned*)(F.lds + LDS_XB), F.wave);
    int ph = 0;
#define PH_ON (ka_opq(P, F, ph), F.lane = fresh_lane(), F.tid = F.wave * 64 + F.lane, (ph >= P.ph_lo() && ph < P.ph_hi()))
#define PH_END do { if (PH_ON && (ph + 1) < P.ph_hi()) xcd_barrier(bar, F.wave, (unsigned*)(ws + WS_CTL) + CW_BAR); ++ph; } while (0)

    bf16_t* H = (bf16_t*)(ws + WS_H);
    float* YF = (float*)(ws + WS_YF);
    float* CTXX = (float*)(ws + WS_CTXX);

    if (PROBE == 30 && use_bar) { for (int i = 0; i < 40; ++i) xcd_barrier(bar, F.wave, (unsigned*)(ws + WS_CTL) + CW_BAR); }
    if (PH_ON) { PREP(20) { PREP(34) { if (EN & 1) p0_prologue(F, P); __syncthreads(); } } }
    PH_END;

#pragma unroll 1
    for (int l = 0; l < NLAYER; ++l) {
        const float* ng = P.in(I_NORMG) + (size_t)l * 4 * 1024;
        const int Mrows = (l == 0) ? MT : ML;
        if (PH_ON) {
            if (l == 0) {
                if (EN & 4096) phase_resid_norm<0, false>(F, P, 0, 0, P.in(I_X), P.in(I_CTX), nullptr, 0, nullptr, nullptr, nullptr, ng, 0, H, MT, nullptr);
                __syncthreads();
                PREP(20) { PREP(35) { if (EN & 8192) phase_hyena_filter_mlp(F, P, 0, SEQL, (float*)(ws + WS_HFILT));
                if (EN & 8192) phase_hyena_filter_mlp(F, P, 0, CTXL, (float*)(ws + WS_HFILTC)); } }
            }
        }
        if (l == 0) PH_END;
        if (PH_ON) {
            if (l == 1) { if (EN & 8192) phase_hyena_filter_mlp(F, P, 1, SEQL, (float*)(ws + WS_HFILT)); __syncthreads(); }
            PREP(1) {
            pg8::Gemm g{H, (const bf16_t*)(ws + WS_W_IN) + (size_t)l * INP_N * 1024, MT, INP_N, 1024}; pg8::StaticOrder S; S.init(MT, INP_N, F.G, F.bid);
            pg8::EpiInProj E{(bf16_t*)(ws + WS_U), (bf16_t*)(ws + WS_RKV), (bf16_t*)(ws + WS_HY), (bf16_t*)(ws + WS_LORA), (bf16_t*)(ws + WS_GL)};
            if (GEN & 1) pg8::gemm_phase(F.lds, g, S, E, F.wave);
            }
        }
        PH_END;
        if (PH_ON) { PREP(20) { PREP(31) { if (EN & 4) phase_hyena_transpose_in(F, P, l); } PREP(32) { if (EN & 8) phase_s5_local(F, P, l); } PREP(33) { if (EN & 16) phase_hyena_filter_fft(F, P); } } }
        PH_END;
        if (PH_ON) { PREP(21) { if (EN & 32) phase_s5_carry(F, P, l); __syncthreads(); } PREP(7) { if (EN & 64) phase_hyena_main(F, P, l); } PREP(21) { if ((EN & 128) && l == 0) phase_hyena_ctx(F, P, l); } }
        PH_END;
        if (PH_ON) { PREP(3) { phase_s5_out(F, P, l); } PREP(21) { phase_hyena_transpose_out(F, P); }
            __syncthreads();
            { pg8::Gemm g{(const bf16_t*)(ws + WS_GL), (const bf16_t*)(ws + WS_W_G2) + (size_t)l * 512 * 256, MT, 512, 256}; pg8::StaticOrder S; S.init(MT, 512, F.G, F.bid);
              pg8::EpiBf16<0> E{(bf16_t*)(ws + WS_RWG), 512}; pg8::gemm_phase(F.lds, g, S, E, F.wave); }
            __syncthreads();
            PREP(2) { phase_rwkv_chunkA(F, P, l, 0); } }
        PH_END;
        if (PH_ON) { PREP(36) { phase_rwkv_chunkB(F, P, 0); }
            __syncthreads();
            pg8::Gemm g{(const bf16_t*)(ws + WS_YPRE), (const bf16_t*)(ws + WS_W_GLU) + (size_t)l * 256 * 256, MT, 256, 256}; pg8::StaticOrder S; S.init(MT, 256, F.G, (F.bid + 128) % F.G);
            pg8::EpiComb<4> E{(bf16_t*)(ws + WS_S5OUT), (const bf16_t*)(ws + WS_YPRE), 256, 0};
            pg8::gemm_phase(F.lds, g, S, E, F.wave); }
        PH_END;
        if (PH_ON) { if (PROBE == 25) phase_rwkv_chunkC(F, P, l, 0, true); phase_rwkv_chunkC(F, P, l, 0); }
        PH_END;
        if (PH_ON) { PREP(2) { phase_rwkv_chunkA(F, P, l, 1); } }
        PH_END;
        if (PH_ON) { PREP(36) { phase_rwkv_chunkB(F, P, 1); } PREP(29) { phase_h8(F, P, Mrows); } }
        PH_END;
        if (PH_ON) { if (PROBE == 25) phase_rwkv_chunkC(F, P, l, 1, true); phase_rwkv_chunkC(F, P, l, 1); }
        PH_END;
        if (PH_ON) {
            pg8::Gemm g{(const bf16_t*)(ws + WS_H8), (const bf16_t*)(ws + WS_W_GATE + (size_t)l * 3072 * 1024), Mrows, 3072, 512}; pg8::StaticOrder S; S.init(Mrows, 3072, F.G, F.bid);
            pg8::EpiSig8 E{(bf16_t*)(ws + WS_G), 3072, 1.f / 8192.f}; PREP(27) { pg8::gemm_phase<pg8::EpiSig8, pg8::StaticOrder, true>(F.lds, g, S, E, F.wave); }
        }
        PH_END;
        if (PH_ON) {
            const bf16_t* Wbr = (const bf16_t*)(ws + WS_W_BR + (size_t)l * 2 * MiB);
            const bf16_t* G3 = (const bf16_t*)(ws + WS_G); bf16_t* MB = (bf16_t*)(ws + WS_MB);
            pg8::StaticOrder S; S.init(Mrows, 1024, F.G, F.bid);
            PREP(26) {
            { pg8::Gemm g{(const bf16_t*)(ws + WS_S5OUT), Wbr, Mrows, 1024, 256}; pg8::EpiComb<0> E{MB, G3, 1024, 3072, 1, (bf16_t*)(ws + WS_YD), 2}; pg8::gemm_phase(F.lds, g, S, E, F.wave); }
            block_self_sync();
            { pg8::Gemm g{(const bf16_t*)(ws + WS_RWOUT), Wbr + 1024 * 256, Mrows, 1024, 512}; pg8::EpiComb<1> E{MB, G3, 1024, 3072, 1 + 4, (bf16_t*)(ws + WS_YD), 3}; pg8::gemm_phase(F.lds, g, S, E, F.wave); }
            block_self_sync();
            { pg8::Gemm g{(const bf16_t*)(ws + WS_HYOUT), Wbr + 1024 * 256 + 1024 * 512, Mrows, 1024, 256}; pg8::EpiComb<1> E{MB, G3, 1024, 3072, 1 + 8, (bf16_t*)(ws + WS_YD), 1}; pg8::gemm_phase(F.lds, g, S, E, F.wave); }
            if (PROBE == 26 && _rep == 0) block_self_sync();
            }
        }
        PH_END;
        if (PH_ON) {
            pg8::Gemm g{(const bf16_t*)(ws + WS_MB), (const bf16_t*)(ws + WS_W_OUT) + (size_t)l * 1024 * 1024, Mrows, 1024, 1024}; pg8::StaticOrder S; S.init(Mrows, 1024, F.G, F.bid);
            pg8::EpiBf16<0> E{(bf16_t*)YF, 1024}; PREP(24) { if (GEN & 256) pg8::gemm_phase(F.lds, g, S, E, F.wave); }
        }
        PH_END;
        if (PH_ON) {
            if (l == 0) { if (PROBE == 22) { phase_resid_norm<1, false>(F, P, 0, 0, P.in(I_X), P.in(I_CTX), YF, 2, ng + 1024, (float*)(ws + WS_U), (float*)(ws + WS_U + 129 * MiB), ng + 2048, 3, nullptr, MT, nullptr); __syncthreads(); }
                          if (EN & 4096) phase_resid_norm<1, false>(F, P, 0, 0, P.in(I_X), P.in(I_CTX), YF, 2, ng + 1024, P.out(), CTXX, ng + 2048, 3, H, MT, nullptr, 0, 1); }
            else        { if (EN & 4096) phase_resid_norm<1, true>(F, P, 1, 1, P.out(), CTXX, YF, 2, ng + 1024, P.out(), CTXX, ng + 2048, 3, H, ML, P.in(I_MOER), 1, 2); }
        }
        PH_END;
        if (l == 0) {
            if (PH_ON) {
                pg8::Gemm g{H, (const bf16_t*)(ws + WS_W_FGU), MT, 2 * FFH, 1024}; pg8::StaticOrder S; S.init(MT, 2 * FFH, F.G, F.bid);
                pg8::EpiSwiGLU E{(bf16_t*)(ws + WS_ACT), FFH}; PREP(5) { if (GEN & 512) pg8::gemm_phase(F.lds, g, S, E, F.wave); }
            }
            PH_END;
            if (PH_ON) {
                pg8::Gemm g{(const bf16_t*)(ws + WS_ACT), (const bf16_t*)(ws + WS_W_FD), MT, 1024, FFH}; pg8::StaticOrder S; S.init(MT, 1024, F.G, F.bid);
                pg8::EpiBf16<0> E{(bf16_t*)YF, 1024}; PREP(24) { if (GEN & 1024) pg8::gemm_phase(F.lds, g, S, E, F.wave); }
            }
            PH_END;
            if (PH_ON) {
                if (EN & 4096) phase_resid_norm<1, false>(F, P, 0, 1, P.out(), CTXX, YF, 5, ng + 3072, P.out(), CTXX, P.in(I_NORMG) + (size_t)4 * 1024, 0, H, MT, nullptr, 1, 1);
            }
            PH_END;
        } else {
            unsigned char* Wgu = ws + WS_MOEW; unsigned char* Wd = Wgu + (size_t)8 * 2 * EXQ * 1024;
            if (PH_ON) { if (EN & 16384) phase_moe_gather(F, P); __syncthreads(); PREP(23) { if (EN & 32768) moe_convert_quarter(F, P, 0, 3); } }
            PH_END;
            if (PH_ON) {
                pg8::MoeOrder S; moe_pad_ends(P, S.pe); S.init(S.pe[7], 2 * EXQ, F.G, F.bid); S.estride = (size_t)2 * EXQ * 1024;
                pg8::Gemm g{(const bf16_t*)(ws + WS_XB), (const bf16_t*)Wgu, S.pe[7], 2 * EXQ, 512};
                pg8::EpiSwiGLU8 E{ws + WS_ACTQ, EXQ}; PREP(10) { if (GEN & 2048) pg8::gemm_phase<pg8::EpiSwiGLU8, pg8::MoeOrder, true>(F.lds, g, S, E, F.wave); }
            }
            PH_END;
            if (PH_ON) {
                pg8::MoeOrder S; moe_pad_ends(P, S.pe); S.init(S.pe[7], 1024, F.G, F.bid); S.estride = (size_t)1024 * EXQ;
                pg8::Gemm g{(const bf16_t*)(ws + WS_ACTQ), (const bf16_t*)Wd, S.pe[7], 1024, EXQ / 2};
                pg8::EpiF8Out E{ws + WS_YB, 1024, 1.f / 128.f}; PREP(28) { if (GEN & 4096) pg8::gemm_phase<pg8::EpiF8Out, pg8::MoeOrder, true>(F.lds, g, S, E, F.wave); }
            }
            PH_END;
            if (PH_ON) if (EN & 4096) phase_resid_norm<2, false>(F, P, 1, 1, P.out(), nullptr, nullptr, 5, ng + 3072, P.out(), nullptr, nullptr, 0, nullptr, ML, nullptr, 2, 0);
            PH_END;
        }
    }
#undef PH_ON
#undef PH_END
}

#undef ws
extern "C" void kernel_launch(void* const* d_in, const int* in_sizes, int n_in, void* d_out, int out_size, void* d_ws, size_t ws_size, hipStream_t stream) {
    static int grid = 0;
    if (grid == 0) {
        if (n_in != 49 || in_sizes[0] != ML * DM || out_size != ML * DM || ws_size < WS_END) {
            fprintf(stderr, "kernel_launch: unexpected problem: n_in %d in0 %d out %d ws %zu (need %zu); nothing launched\n", n_in, n_in > 0 ? in_sizes[0] : -1, out_size, ws_size, (size_t)WS_END); grid = -1; return; }
        int dev = 0, cus = 0, per_cu = 0;
        if (hipGetDevice(&dev) != hipSuccess || hipDeviceGetAttribute(&cus, hipDeviceAttributeMultiprocessorCount, dev) != hipSuccess) { grid = -1; return; }
        if (hipFuncSetAttribute((const void*)mega_fwd, hipFuncAttributeMaxDynamicSharedMemorySize, LDS_BYTES) != hipSuccess) { fprintf(stderr, "kernel_launch: hipFuncSetAttribute failed\n"); grid = -1; return; }
        if (hipOccupancyMaxActiveBlocksPerMultiprocessor(&per_cu, (const void*)mega_fwd, NTHR, LDS_BYTES) != hipSuccess || per_cu < 1) { fprintf(stderr, "kernel_launch: occupancy query reports %d\n", per_cu); }
        (void)hipGetLastError();
        grid = cus;
        if (grid > 256) grid = 256;
    }
    if (grid < 0) return;
    if (hipMemsetAsync((char*)d_ws + WS_CTL, 0, CTL_ZERO_BYTES, stream) != hipSuccess) return;
    Params p{};
    for (int i = 0; i < 49; ++i) p.in[i] = (const float*)d_in[i];
    p.out = (float*)d_out; p.ws = (unsigned char*)d_ws;
#if MK_PER_PHASE
    for (int k = 0; k < MAX_PHASES; ++k) { p.ph_lo = k; p.ph_hi = k + 1; hipLaunchKernelGGL(mega_fwd, dim3(grid), dim3(NTHR), LDS_BYTES, stream, p); }
#else
    p.ph_lo = 0; p.ph_hi = MAX_PHASES;
    hipLaunchKernelGGL(mega_fwd, dim3(grid), dim3(NTHR), LDS_BYTES, stream, p);
#endif
}
```
